# Optimizing an MI355X kernel written in HIP

```python
import jax, jax.numpy as jnp
from jax import lax
import numpy as np

D_MODEL = 2048
BATCH = 1
SEQ = 8192
DEPTH = 4

CHUNK = 64

D_MIX = D_MODEL
D_CONV = D_MIX // 2
D_LRU = D_MIX - D_CONV
CONV_WIDTH = 31
LRU_CONV_WIDTH = 4
LRU_HEADS = 8
LRU_HEAD_DIM = D_LRU // LRU_HEADS
LRU_C = 8.0
D_IN = 2 * D_CONV + D_CONV + D_LRU + D_LRU
RMS_EPS = 1e-6
LN_EPS = 1e-5

kernel_name = "hybrid_conformer_conv_rglru_trunk"


def rms_norm(x, g):
    xf = x.astype(jnp.float32)
    y = xf * lax.rsqrt(jnp.mean(xf * xf, axis=-1, keepdims=True) + RMS_EPS)
    return (y * g.astype(jnp.float32)).astype(x.dtype)


def layer_norm(x, g, b):
    xf = x.astype(jnp.float32)
    mu = jnp.mean(xf, axis=-1, keepdims=True)
    xc = xf - mu
    var = jnp.mean(xc * xc, axis=-1, keepdims=True)
    y = xc * lax.rsqrt(var + LN_EPS)
    return (y * g.astype(jnp.float32) + b.astype(jnp.float32)).astype(x.dtype)


def causal_depthwise_conv(x, w, b):
    k = w.shape[0]
    out = lax.conv_general_dilated(
        x, w[:, None, :].astype(x.dtype), window_strides=(1,), padding=[(k - 1, 0)],
        dimension_numbers=("NWC", "WIO", "NWC"), feature_group_count=x.shape[-1])
    return out + b.astype(x.dtype)


def block_diag_linear(x, w, b):
    bsz, s, _ = x.shape
    xh = x.reshape(bsz, s, LRU_HEADS, LRU_HEAD_DIM)
    y = jnp.einsum("bshi,hij->bshj", xh, w.astype(x.dtype))
    return y.reshape(bsz, s, D_LRU) + b.astype(x.dtype)


def conformer_conv_branch(v, gate, dw_w, dw_b, ln_g, ln_b):
    c = v * jax.nn.sigmoid(gate)
    c = causal_depthwise_conv(c, dw_w, dw_b)
    c = layer_norm(c, ln_g, ln_b)
    return jax.nn.silu(c)


def rglru_branch(xl, conv_w, conv_b, wa, ba, wx, bx, lam):
    xc = causal_depthwise_conv(xl, conv_w, conv_b)
    xf = xc.astype(jnp.float32)
    r = jax.nn.sigmoid(block_diag_linear(xc, wa, ba).astype(jnp.float32))
    i = jax.nn.sigmoid(block_diag_linear(xc, wx, bx).astype(jnp.float32))
    log_a = LRU_C * r * jax.nn.log_sigmoid(lam.astype(jnp.float32))
    a = jnp.exp(log_a)
    mult = jnp.sqrt(-jnp.expm1(2.0 * log_a))
    bterm = mult * (i * xf)

    def combine(left, right):
        a1, b1 = left
        a2, b2 = right
        return a1 * a2, a2 * b1 + b2

    _, h = lax.associative_scan(combine, (a, bterm), axis=1)
    return h.astype(xl.dtype)


def setup_inputs(seed: int = 0) -> dict:
    key = jax.random.key(seed)
    ks = jax.random.split(key, 20)
    f32 = jnp.float32
    x = jax.random.normal(ks[0], (BATCH, SEQ, D_MODEL), f32)
    norm_g = 1.0 + 0.02 * jax.random.normal(ks[1], (DEPTH, D_MODEL), f32)
    w_in = jax.random.normal(ks[2], (DEPTH, D_MODEL, D_IN), f32) * D_MODEL ** -0.5
    conv_dw_w = jax.random.normal(ks[3], (DEPTH, CONV_WIDTH, D_CONV), f32) * CONV_WIDTH ** -0.5
    conv_dw_b = 0.02 * jax.random.normal(ks[4], (DEPTH, D_CONV), f32)
    conv_ln_g = 1.0 + 0.02 * jax.random.normal(ks[5], (DEPTH, D_CONV), f32)
    conv_ln_b = 0.02 * jax.random.normal(ks[6], (DEPTH, D_CONV), f32)
    lru_conv_w = jax.random.normal(ks[7], (DEPTH, LRU_CONV_WIDTH, D_LRU), f32) * LRU_CONV_WIDTH ** -0.5
    lru_conv_b = 0.02 * jax.random.normal(ks[8], (DEPTH, D_LRU), f32)
    lru_wa = jax.random.normal(ks[9], (DEPTH, LRU_HEADS, LRU_HEAD_DIM, LRU_HEAD_DIM), f32) * LRU_HEAD_DIM ** -0.5
    lru_ba = 0.02 * jax.random.normal(ks[10], (DEPTH, D_LRU), f32)
    lru_wx = jax.random.normal(ks[11], (DEPTH, LRU_HEADS, LRU_HEAD_DIM, LRU_HEAD_DIM), f32) * LRU_HEAD_DIM ** -0.5
    lru_bx = 0.02 * jax.random.normal(ks[12], (DEPTH, D_LRU), f32)
    a_c = jax.random.uniform(ks[13], (DEPTH, D_LRU), f32, 0.9, 0.999)
    p = a_c ** (1.0 / LRU_C)
    lru_lambda = jnp.log(p) - jnp.log1p(-p)
    w_out = jax.random.normal(ks[14], (DEPTH, D_MIX, D_MODEL), f32) * D_MIX ** -0.5
    final_g = 1.0 + 0.02 * jax.random.normal(ks[15], (D_MODEL,), f32)
    return {"x": x, "norm_g": norm_g, "w_in": w_in,
            "conv_dw_w": conv_dw_w, "conv_dw_b": conv_dw_b, "conv_ln_g": conv_ln_g, "conv_ln_b": conv_ln_b,
            "lru_conv_w": lru_conv_w, "lru_conv_b": lru_conv_b, "lru_wa": lru_wa, "lru_ba": lru_ba,
            "lru_wx": lru_wx, "lru_bx": lru_bx, "lru_lambda": lru_lambda,
            "w_out": w_out, "final_g": final_g}


def reference(x, norm_g, w_in, conv_dw_w, conv_dw_b, conv_ln_g, conv_ln_b,
              lru_conv_w, lru_conv_b, lru_wa, lru_ba, lru_wx, lru_bx, lru_lambda,
              w_out, final_g):
    splits = [D_CONV, 2 * D_CONV, 3 * D_CONV, 3 * D_CONV + D_LRU]
    for l in range(DEPTH):
        h = rms_norm(x, norm_g[l])
        u = jnp.einsum("bsd,de->bse", h, w_in[l].astype(h.dtype))
        glu_v, glu_g, z_conv, x_lru, z_lru = jnp.split(u, splits, axis=-1)
        y_conv = conformer_conv_branch(glu_v, glu_g, conv_dw_w[l], conv_dw_b[l],
                                       conv_ln_g[l], conv_ln_b[l]) * jax.nn.silu(z_conv)
        y_lru = rglru_branch(x_lru, lru_conv_w[l], lru_conv_b[l], lru_wa[l], lru_ba[l],
                             lru_wx[l], lru_bx[l], lru_lambda[l]) * jax.nn.silu(z_lru)
        y = jnp.concatenate([y_conv, y_lru], axis=-1)
        x = x + jnp.einsum("bse,ed->bsd", y, w_out[l].astype(y.dtype))
    return rms_norm(x, final_g)
```

```cpp
#include <hip/hip_runtime.h>
#include <cstdio>
#include <cstdint>

#ifndef MK_ONE_LAUNCH
#define MK_ONE_LAUNCH 0
#endif

#define LAS __attribute__((address_space(3)))
#define GAS __attribute__((address_space(1)))
typedef unsigned short bf16_t;
typedef short bf16x8 __attribute__((ext_vector_type(8)));
typedef float f32x4 __attribute__((ext_vector_type(4)));
typedef float f32x2 __attribute__((ext_vector_type(2)));
typedef unsigned u32x4 __attribute__((ext_vector_type(4)));
typedef unsigned u32x2 __attribute__((ext_vector_type(2)));

constexpr int S = 8192, D = 2048, DEPTH = 4, DC = 1024, DL = 1024, DIN = 5120, NHEAD = 8, HD = 128, CW = 31, LW = 4;
constexpr int UW = 4096;
constexpr float RMS_EPS = 1e-6f, LN_EPS = 1e-5f;
constexpr int NTHREADS = 512, NWAVES = 8;
constexpr int LDS_BYTES = 147456;
constexpr int SCH = 64, NSCH = S / SCH;

constexpr size_t MiB = 1u << 20;
constexpr size_t WS_CTL = 0, CTL_ZERO_BYTES = 1 * MiB;
constexpr size_t WS_WINT = 2 * MiB;
constexpr size_t WS_WOUTT = 82 * MiB;
constexpr size_t WS_XB = 114 * MiB;
constexpr size_t WS_U = 146 * MiB;
constexpr size_t WS_Y = 210 * MiB;
constexpr size_t WS_SSQ = 242 * MiB;
constexpr size_t WS_PS = 243 * MiB;
constexpr size_t WS_HS = 243 * MiB + 512 * 1024;
constexpr size_t WS_UF = 244 * MiB;
constexpr size_t WS_LA = 404 * MiB;
constexpr size_t WS_LB = 436 * MiB;
constexpr size_t WS_END = 468 * MiB;

#define MAKE_RSRC(p, bytes) __builtin_amdgcn_make_buffer_rsrc((void*)(p), 0, (int)(bytes), 0x00020000)
__device__ __forceinline__ unsigned f2bf(float f) { unsigned u = __builtin_bit_cast(unsigned, f); return (u + 0x7fffu + ((u >> 16) & 1u)) >> 16; }
__device__ __forceinline__ unsigned pk2(float lo, float hi) { return f2bf(lo) | (f2bf(hi) << 16); }
__device__ __forceinline__ float bflo(unsigned w) { return __builtin_bit_cast(float, w << 16); }
__device__ __forceinline__ float bfhi(unsigned w) { return __builtin_bit_cast(float, w & 0xffff0000u); }
__device__ __forceinline__ float bf2f(bf16_t b) { return __builtin_bit_cast(float, (unsigned)b << 16); }
__device__ __forceinline__ float sigm(float x) { return 1.f / (1.f + __expf(-x)); }
__device__ __forceinline__ float siluf(float x) { return x * sigm(x); }
__device__ __forceinline__ float wave_sum(float v) {
#pragma unroll
    for (int o = 1; o < 64; o <<= 1) v += __shfl_xor(v, o);
    return v;
}
__device__ __forceinline__ float neg_expm1(float x) {
    if (x > -0.35f) { float p = 1.f + x * (1.f / 8.f); p = 1.f + x * (1.f / 7.f) * p; p = 1.f + x * (1.f / 6.f) * p; p = 1.f + x * (1.f / 5.f) * p; p = 1.f + x * 0.25f * p; p = 1.f + x * (1.f / 3.f) * p; p = 1.f + x * 0.5f * p; return -x * p; }
    return 1.f - __expf(x);
}
__device__ __forceinline__ float log_sigmoid(float x) { return fminf(x, 0.f) - log1pf(expf(-fabsf(x))); }
__host__ __device__ __forceinline__ int src_col(int np) { if (np < 2048) { const int p = np >> 8, j = np & 255; return j < 128 ? 128 * p + j : 1024 + 128 * p + (j - 128); } return np; }

#define XB_TMO      128
#define XB_XCNT(j)  (256  + 64 * (j))
#define XB_XSUB(j)  (1280 + 64 * (j))
#define XB_XGEN(j)  (2304 + 64 * (j))
#define XB_TOP      3328
#define XB_TOPGEN   3392
#define XCD_BAR_WORDS 3456
#define XB_SPIN_CAP (1u << 18)
__device__ __forceinline__ unsigned xb_ld(unsigned* p)              { return __hip_atomic_load(p, __ATOMIC_RELAXED, __HIP_MEMORY_SCOPE_AGENT); }
__device__ __forceinline__ unsigned xb_add(unsigned* p, unsigned v) { return __hip_atomic_fetch_add(p, v, __ATOMIC_RELAXED, __HIP_MEMORY_SCOPE_AGENT); }
__device__ __forceinline__ unsigned xb_xcc_id() { return (unsigned)__builtin_amdgcn_s_getreg((3 << 11) | 20) & 0xFu; }
#define XB_SPIN(cond, bar) do { unsigned _sp = 0; while (cond) { __builtin_amdgcn_s_sleep(1); \
    if ((++_sp & 255u) == 0u) { if (xb_ld(&(bar)[XB_TMO])) break; if (_sp > XB_SPIN_CAP) { atomicAdd(&(bar)[XB_TMO], 1u); break; } } } } while (0)
struct XcdBarrier { unsigned* bar; unsigned x; volatile LAS unsigned* st; };
__device__ __forceinline__ XcdBarrier xcd_barrier_post(unsigned* bar, volatile LAS unsigned* st) {
    XcdBarrier b; b.bar = bar; b.x = xb_xcc_id(); b.st = st;
    if (threadIdx.x == 0) (void)xb_add(&bar[XB_XCNT(b.x)], 1u);
    return b;
}
__device__ __forceinline__ void xcd_barrier_complete(unsigned* bar, unsigned x, unsigned& nloc, unsigned& nx) {
    const unsigned G = gridDim.x * gridDim.y * gridDim.z;
    unsigned sum, cnt, mine, sp = 0u;
    for (;;) {
        sum = 0u; cnt = 0u; mine = 0u;
#pragma unroll
        for (unsigned j = 0; j < 16; ++j) { const unsigned c = xb_ld(&bar[XB_XCNT(j)]); sum += c; cnt += (c > 0u) ? 1u : 0u; mine = (j == x) ? c : mine; }
        if (sum == G) break;
        __builtin_amdgcn_s_sleep(1);
        if ((++sp & 255u) == 0u) { if (xb_ld(&bar[XB_TMO])) break; if (sp > XB_SPIN_CAP) { atomicAdd(&bar[XB_TMO], 1u); break; } }
    }
    nloc = mine > 0u ? mine : 1u; nx = cnt > 0u ? cnt : 1u;
}
__device__ __forceinline__ void xcd_barrier(const XcdBarrier& b) {
    asm volatile("s_waitcnt vmcnt(0)" ::: "memory");
    __syncthreads();
    if (threadIdx.x == 0) {
        unsigned* bar = b.bar;
        __builtin_amdgcn_s_waitcnt(0);
        unsigned nloc = b.st[0], nx = b.st[1];
        if (nloc == 0u) { xcd_barrier_complete(bar, b.x, nloc, nx); b.st[0] = nloc; b.st[1] = nx; }
        const unsigned old = xb_add(&bar[XB_XSUB(b.x)], 1u);
        const unsigned gen = old / nloc;
        if (old + 1u == (gen + 1u) * nloc) {
            __builtin_amdgcn_fence(__ATOMIC_RELEASE, "agent");
            asm volatile("s_waitcnt vmcnt(0)" ::: "memory");
            const unsigned og = xb_add(&bar[XB_TOP], 1u);
            const unsigned tg = og / nx;
            if (og + 1u == (tg + 1u) * nx) xb_add(&bar[XB_TOPGEN], 1u);
            else XB_SPIN(xb_ld(&bar[XB_TOPGEN]) == tg, bar);
            __builtin_amdgcn_fence(__ATOMIC_ACQUIRE, "agent");
            xb_add(&bar[XB_XGEN(b.x)], 1u);
            asm volatile("s_waitcnt vmcnt(0)" ::: "memory");
        } else {
            XB_SPIN(xb_ld(&bar[XB_XGEN(b.x)]) == gen, bar);
            __builtin_amdgcn_fence(__ATOMIC_ACQUIRE, "agent");
            asm volatile("s_waitcnt vmcnt(0)" ::: "memory");
        }
    }
    __syncthreads();
}

struct Frame {
    LAS unsigned char* lds;
    int tid, lane, wave, bid, G;
    const float *x, *norm_g, *w_in, *cdw_w, *cdw_b, *cln_g, *cln_b, *lcw, *lcb, *wa, *ba, *wx, *bx, *lam, *w_out, *final_g;
    float* out;
    bf16_t *WinT, *WoutT, *XB, *U, *Y;
    float *SSQ, *PS, *HS, *UF, *LA, *LB;
};

#define PHASE_TID(F) do { int _t = threadIdx.x; asm volatile("" : "+v"(_t)); (F).tid = _t; (F).lane = _t & 63; (F).wave = __builtin_amdgcn_readfirstlane(_t >> 6); } while (0)
__device__ __forceinline__ void transpose_item(const float* W, int K, int N, bf16_t* WT, int dst_row0, int src_col0, const float* gk, LAS float* scr, int k0, int lane) {
#pragma unroll 8
    for (int i = 0; i < 32; ++i) { const int kk = 2 * i + (lane >> 5); float v = W[(size_t)(k0 + kk) * N + src_col0 + (lane & 31)]; if (gk) v *= gk[k0 + kk]; scr[kk * 33 + (lane & 31)] = v; }
    asm volatile("s_waitcnt lgkmcnt(0)" ::: "memory");
    const int c = lane & 7;
#pragma unroll
    for (int j = 0; j < 4; ++j) { const int n = (lane >> 3) + 8 * j; const LAS float* s = scr + (8 * c) * 33 + n;
        u32x4 o; o.x = pk2(s[0 * 33], s[1 * 33]); o.y = pk2(s[2 * 33], s[3 * 33]); o.z = pk2(s[4 * 33], s[5 * 33]); o.w = pk2(s[6 * 33], s[7 * 33]);
        *(u32x4*)(WT + (size_t)(dst_row0 + n) * K + k0 + 8 * c) = o; }
    asm volatile("s_waitcnt lgkmcnt(0)" ::: "memory");
}
__device__ __forceinline__ void p_prologue(Frame& F) {
    PHASE_TID(F);
    LAS float* scr = (LAS float*)(F.lds + F.wave * 16384);
    const int gw = F.bid * NWAVES + F.wave, NGW = F.G * NWAVES;
    constexpr int I_IN = (D / 64) * (DIN / 32), I_OUT = (D / 64) * (D / 32), I_L = I_IN + I_OUT;
    for (int it = gw; it < DEPTH * I_L; it += NGW) {
        const int l = it / I_L; int r = it % I_L;
        if (r < I_IN) { const int kb = r / (DIN / 32), nb = r % (DIN / 32);
            transpose_item(F.w_in + (size_t)l * D * DIN, D, DIN, F.WinT + (size_t)l * DIN * D, 32 * nb, src_col(32 * nb), F.norm_g + l * D, scr, 64 * kb, F.lane);
        } else { r -= I_IN; const int kb = r / (D / 32), nb = r % (D / 32);
            transpose_item(F.w_out + (size_t)l * D * D, D, D, F.WoutT + (size_t)l * D * D, 32 * nb, 32 * nb, nullptr, scr, 64 * kb, F.lane); }
    }
    for (int m = gw; m < S; m += NGW) {
        const f32x4* xr = (const f32x4*)(F.x + (size_t)m * D) + F.lane; u32x2* ob = (u32x2*)(F.XB + (size_t)m * D) + F.lane; float s = 0.f;
#pragma unroll
        for (int j = 0; j < 8; ++j) { const f32x4 v = xr[64 * j]; s += (v.x * v.x + v.y * v.y) + (v.z * v.z + v.w * v.w); u32x2 w; w.x = pk2(v.x, v.y); w.y = pk2(v.z, v.w); ob[64 * j] = w; }
        s = wave_sum(s);
        if (F.lane < 8) F.SSQ[F.lane * S + m] = F.lane == 0 ? s : 0.f;
    }
}

__device__ __forceinline__ void p_sgemm(Frame& F, const bf16_t* A, const bf16_t* Bt, int M, int N, int K, float* C, int ldc) {
    PHASE_TID(F);
    LAS bf16_t* As = (LAS bf16_t*)F.lds; LAS bf16_t* Bs = As + 128 * 40;
    const int tid = F.tid, lane = F.lane, wid = F.wave, wr = wid >> 2, wc = wid & 3, fr = lane & 15, fq = lane >> 4;
    const int r = tid >> 2, c8 = (tid & 3) * 8;
    const int nN = N / 128, items = (M / 128) * nN;
    for (int it = F.bid; it < items; it += F.G) {
        const int m0 = (it / nN) * 128, n0 = (it % nN) * 128;
        f32x4 acc[4][2];
#pragma unroll
        for (int m = 0; m < 4; ++m)
#pragma unroll
            for (int n = 0; n < 2; ++n) acc[m][n] = (f32x4){0.f, 0.f, 0.f, 0.f};
        const bf16_t* ap = A + (size_t)(m0 + r) * K + c8; const bf16_t* bp = Bt + (size_t)(n0 + r) * K + c8;
        for (int k0 = 0; k0 < K; k0 += 32) {
            const u32x4 va = *(const u32x4*)(ap + k0), vb = *(const u32x4*)(bp + k0);
            __syncthreads();
            *(LAS u32x4*)(As + r * 40 + c8) = va; *(LAS u32x4*)(Bs + r * 40 + c8) = vb;
            __syncthreads();
            bf16x8 a[4], b[2];
#pragma unroll
            for (int m = 0; m < 4; ++m) a[m] = *(const LAS bf16x8*)(As + (wr * 64 + m * 16 + fr) * 40 + fq * 8);
#pragma unroll
            for (int n = 0; n < 2; ++n) b[n] = *(const LAS bf16x8*)(Bs + (wc * 32 + n * 16 + fr) * 40 + fq * 8);
#pragma unroll
            for (int m = 0; m < 4; ++m)
#pragma unroll
                for (int n = 0; n < 2; ++n) acc[m][n] = __builtin_amdgcn_mfma_f32_16x16x32_bf16(b[n], a[m], acc[m][n], 0, 0, 0);
        }
#pragma unroll
        for (int m = 0; m < 4; ++m)
#pragma unroll
            for (int n = 0; n < 2; ++n) *(f32x4*)(C + (size_t)(m0 + wr * 64 + m * 16 + fr) * ldc + n0 + wc * 32 + n * 16 + 4 * fq) = acc[m][n];
    }
    __syncthreads();
}

__device__ __forceinline__ void p_epi1(Frame& F) {
    PHASE_TID(F);
    const long total = (long)S * (UW / 8);
    for (long g = (long)F.bid * NTHREADS + F.tid; g < total; g += (long)F.G * NTHREADS) {
        const int row = (int)(g / (UW / 8)), j0 = (int)(g % (UW / 8)) * 8;
        float ss = 0.f;
#pragma unroll
        for (int p = 0; p < 8; ++p) ss += F.SSQ[p * S + row];
        const float rstd = 1.f / sqrtf(ss * (1.f / D) + RMS_EPS);
        const float* ur = F.UF + (size_t)row * DIN;
        float o[8];
        if (j0 < 1024) { const int p = j0 >> 7, jj = j0 & 127; const float* vp = ur + 256 * p + jj; const float* gp = vp + 128;
#pragma unroll
            for (int e = 0; e < 8; ++e) { const float v = vp[e] * rstd, gt = gp[e] * rstd; o[e] = v * sigm(gt); }
        } else { const float* sp = ur + 1024 + j0;
            const bool act = (j0 < 2048) || (j0 >= 3072);
#pragma unroll
            for (int e = 0; e < 8; ++e) { const float v = sp[e] * rstd; o[e] = act ? siluf(v) : v; }
        }
        u32x4 w; w.x = pk2(o[0], o[1]); w.y = pk2(o[2], o[3]); w.z = pk2(o[4], o[5]); w.w = pk2(o[6], o[7]);
        *(u32x4*)(F.U + (size_t)row * UW + j0) = w;
    }
}

template <int NV> __device__ __forceinline__ void block_sum(float (&v)[NV], LAS float* red  , int wave, int lane) {
#pragma unroll
    for (int i = 0; i < NV; ++i) { const float s = wave_sum(v[i]); if (lane == 0) red[i * 8 + wave] = s; }
    __syncthreads();
#pragma unroll
    for (int i = 0; i < NV; ++i) { const LAS f32x4* p = (const LAS f32x4*)(red + i * 8); const f32x4 a = p[0], b = p[1]; v[i] = ((a.x + a.y) + (a.z + a.w)) + ((b.x + b.y) + (b.z + b.w)); }
    __syncthreads();
}
constexpr int CT = 16;
__device__ __forceinline__ void conv_item(Frame& F, int l, int item) {
    LAS unsigned char* cs = F.lds;
    LAS float* red = (LAS float*)(F.lds + 62 * 2048);
    const int t0 = item * 32, c0 = 2 * F.tid;
    for (int q = F.tid; q < 62 * 128; q += NTHREADS) { const int row = q >> 7, c16 = q & 127, s = t0 - 30 + row; u32x4 v = (u32x4){0u, 0u, 0u, 0u};
        if (s >= 0) v = *(const u32x4*)(F.U + (size_t)s * UW + c16 * 8);
        *(LAS u32x4*)(cs + row * 2048 + c16 * 16) = v; }
    __syncthreads();
    float w0[31], w1[31];
    const auto rw = MAKE_RSRC(F.cdw_w + (size_t)l * CW * DC, CW * DC * 4);
#pragma unroll
    for (int j = 0; j < 31; ++j) { const f32x2 t = __builtin_bit_cast(f32x2, __builtin_amdgcn_raw_buffer_load_b64(rw, c0 * 4, (30 - j) * DC * 4, 0)); w0[j] = t.x; w1[j] = t.y; }
    const f32x2 bias = *(const f32x2*)(F.cdw_b + l * DC + c0);
    const f32x2 lg = *(const f32x2*)(F.cln_g + l * DC + c0), lb = *(const f32x2*)(F.cln_b + l * DC + c0);
    const auto ru = MAKE_RSRC(F.U, (size_t)S * UW * 2); const auto ry = MAKE_RSRC(F.Y, (size_t)S * D * 2);
#pragma unroll 1
    for (int hb = 0; hb < 32 / CT; ++hb) {
        float a0[CT], a1[CT];
#pragma unroll
        for (int i = 0; i < CT; ++i) { a0[i] = bias.x; a1[i] = bias.y; }
        const LAS unsigned char* cp = cs + (hb * CT) * 2048 + F.tid * 4;
#pragma unroll
        for (int si = 0; si < CT + 30; ++si) {
            const unsigned cw = *(const LAS unsigned*)(cp + si * 2048);
            const float x0 = bflo(cw), x1 = bfhi(cw);
#pragma unroll
            for (int i = 0; i < CT; ++i) { const int j = i + 30 - si; if (j >= 0 && j <= 30) { a0[i] += w0[j] * x0; a1[i] += w1[j] * x1; } }
        }
        float sv[CT];
#pragma unroll
        for (int i = 0; i < CT; ++i) sv[i] = a0[i] + a1[i];
        block_sum<CT>(sv, red, F.wave, F.lane);
#pragma unroll
        for (int i = 0; i < CT; ++i) { const float mean = sv[i] * (1.f / DC); a0[i] -= mean; a1[i] -= mean; sv[i] = a0[i] * a0[i] + a1[i] * a1[i]; }
        block_sum<CT>(sv, red, F.wave, F.lane);
#pragma unroll
        for (int i = 0; i < CT; ++i) {
            const int t = t0 + hb * CT + i;
            const float rstd = 1.f / sqrtf(sv[i] * (1.f / DC) + LN_EPS);
            const unsigned zw = __builtin_amdgcn_raw_buffer_load_b32(ru, (1024 + c0) * 2, t * (UW * 2), 0);
            const float y0 = siluf(a0[i] * rstd * lg.x + lb.x) * bflo(zw), y1 = siluf(a1[i] * rstd * lg.y + lb.y) * bfhi(zw);
            __builtin_amdgcn_raw_buffer_store_b32(pk2(y0, y1), ry, c0 * 2, t * (D * 2), 0);
        }
    }
    __syncthreads();
}
__device__ __forceinline__ void lru_ab_item(Frame& F, int l, int item) {
    LAS float* xcs = (LAS float*)F.lds;
    const int cidx = item >> 3, h = item & 7, t0 = cidx * SCH, ch0 = h * HD;
    {
        const int t = F.tid >> 3, cb = (F.tid & 7) * 16;
        const float* cwp = F.lcw + (size_t)l * LW * DL + ch0 + cb; const float* cbp = F.lcb + l * DL + ch0 + cb;
        float acc[16];
#pragma unroll
        for (int e = 0; e < 16; ++e) acc[e] = cbp[e];
#pragma unroll
        for (int k = 0; k < 4; ++k) { const int s = t0 + t - 3 + k;
            if (s >= 0) { const u32x4* up = (const u32x4*)(F.U + (size_t)s * UW + 2048 + ch0 + cb); const u32x4 q0 = up[0], q1 = up[1];
                const unsigned qq[8] = {q0.x, q0.y, q0.z, q0.w, q1.x, q1.y, q1.z, q1.w};
#pragma unroll
                for (int e = 0; e < 8; ++e) { acc[2 * e] += cwp[(size_t)k * DL + 2 * e] * bflo(qq[e]); acc[2 * e + 1] += cwp[(size_t)k * DL + 2 * e + 1] * bfhi(qq[e]); } } }
#pragma unroll
        for (int e = 0; e < 16; ++e) xcs[t * 128 + cb + e] = acc[e];
    }
    __syncthreads();
    const int ch = F.tid & 127, tg = F.tid >> 7;
    const float* wap = F.wa + ((size_t)(l * NHEAD + h) * HD) * HD + ch; const float* wxp = F.wx + ((size_t)(l * NHEAD + h) * HD) * HD + ch;
    float ar[16], ai[16];
#pragma unroll
    for (int i = 0; i < 16; ++i) { ar[i] = 0.f; ai[i] = 0.f; }
#pragma unroll 2
    for (int k = 0; k < HD; ++k) { const float war = wap[(size_t)k * HD], wxr = wxp[(size_t)k * HD];
#pragma unroll
        for (int i = 0; i < 16; ++i) { const float xv = xcs[(tg * 16 + i) * 128 + k]; ar[i] += xv * war; ai[i] += xv * wxr; } }
    const int gch = ch0 + ch;
    const float bar_ = F.ba[l * DL + gch], bxr = F.bx[l * DL + gch], c8 = 8.f * log_sigmoid(F.lam[l * DL + gch]);
#pragma unroll
    for (int i = 0; i < 16; ++i) { const int t = tg * 16 + i;
        const float r = sigm(ar[i] + bar_), ig = sigm(ai[i] + bxr), la = c8 * r, a = __expf(la), mult = sqrtf(neg_expm1(2.f * la));
        F.LA[(size_t)(t0 + t) * DL + gch] = a; F.LB[(size_t)(t0 + t) * DL + gch] = mult * (ig * xcs[t * 128 + ch]); }
    __syncthreads();
}
__device__ __forceinline__ void p_mix1(Frame& F, int l) {
    PHASE_TID(F);
    constexpr int NCONV = S / 32, NLRU = NSCH * NHEAD;
    for (int it = F.bid; it < NCONV; it += F.G) { PHASE_TID(F); conv_item(F, l, it); }
    for (int it = F.bid; it < NLRU; it += F.G) { PHASE_TID(F); lru_ab_item(F, l, it); }
}
__device__ __forceinline__ void p_scan1(Frame& F) {
    PHASE_TID(F);
    for (int it = F.bid; it < NSCH * 2; it += F.G) { const int cidx = it >> 1, ch = (it & 1) * 512 + F.tid, t0 = cidx * SCH; float P = 1.f, H = 0.f;
#pragma unroll 8
        for (int i = 0; i < SCH; ++i) { const float a = F.LA[(size_t)(t0 + i) * DL + ch], b = F.LB[(size_t)(t0 + i) * DL + ch]; H = a * H + b; P *= a; }
        F.PS[cidx * DL + ch] = P; F.HS[cidx * DL + ch] = H; }
}
__device__ __forceinline__ void p_scan2(Frame& F) {
    PHASE_TID(F);
    for (int it = F.bid; it < NSCH * 2; it += F.G) { const int cidx = it >> 1, ch = (it & 1) * 512 + F.tid, t0 = cidx * SCH; float H = 0.f;
        for (int c = 0; c < cidx; ++c) H = F.PS[c * DL + ch] * H + F.HS[c * DL + ch];
#pragma unroll 8
        for (int i = 0; i < SCH; ++i) { const float a = F.LA[(size_t)(t0 + i) * DL + ch], b = F.LB[(size_t)(t0 + i) * DL + ch]; H = a * H + b;
            const float z = bf2f(F.U[(size_t)(t0 + i) * UW + 3072 + ch]); F.Y[(size_t)(t0 + i) * D + DC + ch] = (bf16_t)f2bf(H * z); } }
}
__device__ __forceinline__ void p_epi2(Frame& F, int l) {
    PHASE_TID(F);
    const int gw = F.bid * NWAVES + F.wave, NGW = F.G * NWAVES; const float* xold = (l == 0) ? F.x : F.out;
    for (int m = gw; m < S; m += NGW) {
        const f32x4* xr = (const f32x4*)(xold + (size_t)m * D) + F.lane; const f32x4* ur = (const f32x4*)(F.UF + (size_t)m * D) + F.lane;
        f32x4* orow = (f32x4*)(F.out + (size_t)m * D) + F.lane; u32x2* ob = (u32x2*)(F.XB + (size_t)m * D) + F.lane; float s = 0.f;
#pragma unroll
        for (int j = 0; j < 8; ++j) { const f32x4 v = xr[64 * j] + ur[64 * j]; s += (v.x * v.x + v.y * v.y) + (v.z * v.z + v.w * v.w); orow[64 * j] = v; u32x2 w; w.x = pk2(v.x, v.y); w.y = pk2(v.z, v.w); ob[64 * j] = w; }
        s = wave_sum(s);
        if (F.lane < 8) F.SSQ[F.lane * S + m] = F.lane == 0 ? s : 0.f;
    }
}
__device__ __forceinline__ void p_final(Frame& F) {
    PHASE_TID(F);
    const int gw = F.bid * NWAVES + F.wave, NGW = F.G * NWAVES;
    for (int m = gw; m < S; m += NGW) {
        float ss = 0.f;
#pragma unroll
        for (int p = 0; p < 8; ++p) ss += F.SSQ[p * S + m];
        const float rstd = 1.f / sqrtf(ss * (1.f / D) + RMS_EPS);
        f32x4* orow = (f32x4*)(F.out + (size_t)m * D) + F.lane; const f32x4* gr = (const f32x4*)F.final_g + F.lane;
#pragma unroll
        for (int j = 0; j < 8; ++j) orow[64 * j] = orow[64 * j] * rstd * gr[64 * j];
    }
}

constexpr int PH_PER_LAYER = 7, NPH = 1 + DEPTH * PH_PER_LAYER + 1;
struct Args { const float* in[16]; float* out; unsigned char* ws; int ph_lo, ph_hi; };
__global__ void __launch_bounds__(NTHREADS, 2) mk_fwd(Args a) {
    extern __shared__ __attribute__((aligned(16))) unsigned char lds_raw[];
    Frame F;
    F.lds = (LAS unsigned char*)lds_raw;
    F.tid = threadIdx.x; F.lane = F.tid & 63; F.wave = __builtin_amdgcn_readfirstlane(F.tid >> 6); F.bid = blockIdx.x; F.G = gridDim.x;
    F.x = a.in[0]; F.norm_g = a.in[1]; F.w_in = a.in[2]; F.cdw_w = a.in[3]; F.cdw_b = a.in[4]; F.cln_g = a.in[5]; F.cln_b = a.in[6]; F.lcw = a.in[7]; F.lcb = a.in[8];
    F.wa = a.in[9]; F.ba = a.in[10]; F.wx = a.in[11]; F.bx = a.in[12]; F.lam = a.in[13]; F.w_out = a.in[14]; F.final_g = a.in[15]; F.out = a.out;
    unsigned char* ws = a.ws;
    F.WinT = (bf16_t*)(ws + WS_WINT); F.WoutT = (bf16_t*)(ws + WS_WOUTT); F.XB = (bf16_t*)(ws + WS_XB); F.U = (bf16_t*)(ws + WS_U); F.Y = (bf16_t*)(ws + WS_Y);
    F.SSQ = (float*)(ws + WS_SSQ); F.PS = (float*)(ws + WS_PS); F.HS = (float*)(ws + WS_HS); F.UF = (float*)(ws + WS_UF); F.LA = (float*)(ws + WS_LA); F.LB = (float*)(ws + WS_LB);
    volatile LAS unsigned* bst = (volatile LAS unsigned*)(F.lds + LDS_BYTES - 64);
    if (F.tid < 16) bst[F.tid] = 0u;
    __syncthreads();
    XcdBarrier bar; bar.bar = (unsigned*)(ws + WS_CTL) + 4096; bar.x = 0; bar.st = bst;
    if (MK_ONE_LAUNCH) bar = xcd_barrier_post((unsigned*)(ws + WS_CTL) + 4096, bst);
    for (int ph = a.ph_lo; ph < a.ph_hi; ++ph) {
        if (ph == 0) p_prologue(F);
        else if (ph == NPH - 1) p_final(F);
        else { const int l = (ph - 1) / PH_PER_LAYER, j = (ph - 1) % PH_PER_LAYER;
            if (j == 0) p_sgemm(F, F.XB, F.WinT + (size_t)l * DIN * D, S, DIN, D, F.UF, DIN);
            else if (j == 1) p_epi1(F);
            else if (j == 2) p_mix1(F, l);
            else if (j == 3) p_scan1(F);
            else if (j == 4) p_scan2(F);
            else if (j == 5) p_sgemm(F, F.Y, F.WoutT + (size_t)l * D * D, S, D, D, F.UF, D);
            else p_epi2(F, l);
        }
        if (ph + 1 < a.ph_hi) xcd_barrier(bar);
    }
}

extern "C" void kernel_launch(void* const* d_in, const int* in_sizes, int n_in, void* d_out, int out_size, void* d_ws, size_t ws_size, hipStream_t stream) {
    static int grid = 0;
    if (grid == 0) {
        if (n_in != 16 || in_sizes[0] != S * D || out_size != S * D || ws_size < WS_END) { fprintf(stderr, "kernel_launch: unexpected shapes (n_in %d, in0 %d, out %d, ws %zu)\n", n_in, n_in > 0 ? in_sizes[0] : -1, out_size, ws_size); grid = -1; return; }
        int dev = 0, cus = 0, per_cu = 0;
        if (hipGetDevice(&dev) != hipSuccess || hipDeviceGetAttribute(&cus, hipDeviceAttributeMultiprocessorCount, dev) != hipSuccess) { grid = -1; return; }
        if (hipFuncSetAttribute((const void*)mk_fwd, hipFuncAttributeMaxDynamicSharedMemorySize, LDS_BYTES) != hipSuccess) { fprintf(stderr, "kernel_launch: hipFuncSetAttribute failed\n"); grid = -1; return; }
        if (hipOccupancyMaxActiveBlocksPerMultiprocessor(&per_cu, (const void*)mk_fwd, NTHREADS, LDS_BYTES) != hipSuccess || per_cu < 1) fprintf(stderr, "kernel_launch: occupancy query says %d per CU\n", per_cu);
        (void)hipGetLastError();
        grid = cus;
    }
    if (grid < 0) return;
    (void)hipMemsetAsync((char*)d_ws + WS_CTL, 0, CTL_ZERO_BYTES, stream);
    Args a{};
    for (int i = 0; i < 16; ++i) a.in[i] = (const float*)d_in[i];
    a.out = (float*)d_out; a.ws = (unsigned char*)d_ws;
#if MK_ONE_LAUNCH
    a.ph_lo = 0; a.ph_hi = NPH;
    hipLaunchKernelGGL(mk_fwd, dim3(grid), dim3(NTHREADS), LDS_BYTES, stream, a);
#else
    for (int ph = 0; ph < NPH; ++ph) { a.ph_lo = ph; a.ph_hi = ph + 1; hipLaunchKernelGGL(mk_fwd, dim3(grid), dim3(NTHREADS), LDS_BYTES, stream, a); }
#endif
}
```

```cpp
#include <hip/hip_runtime.h>
#include <cstdio>
#include <cstdint>

#ifndef MK_ONE_LAUNCH
#define MK_ONE_LAUNCH 1
#endif

#define LAS __attribute__((address_space(3)))
#define GAS __attribute__((address_space(1)))
typedef unsigned short bf16_t;
typedef short bf16x8 __attribute__((ext_vector_type(8)));
typedef float f32x4 __attribute__((ext_vector_type(4)));
typedef float f32x2 __attribute__((ext_vector_type(2)));
typedef unsigned u32x4 __attribute__((ext_vector_type(4)));
typedef unsigned u32x2 __attribute__((ext_vector_type(2)));

constexpr int S = 8192, D = 2048, DEPTH = 4, DC = 1024, DL = 1024, DIN = 5120, NHEAD = 8, HD = 128, CW = 31, LW = 4;
constexpr int UW = 4096;
constexpr float RMS_EPS = 1e-6f, LN_EPS = 1e-5f;
constexpr int NTHREADS = 512, NWAVES = 8;
constexpr int LDS_BYTES = 147456;
constexpr int SCH = 64, NSCH = S / SCH;

constexpr size_t MiB = 1u << 20;
constexpr size_t WS_CTL = 0, CTL_ZERO_BYTES = 1 * MiB;
constexpr size_t WS_WINT = 2 * MiB;
constexpr size_t WS_WOUTT = 82 * MiB;
constexpr size_t WS_XB = 114 * MiB;
constexpr size_t WS_U = 146 * MiB;
constexpr size_t WS_Y = 210 * MiB;
constexpr size_t WS_SSQ = 242 * MiB;
constexpr size_t WS_PS = 243 * MiB;
constexpr size_t WS_HS = 243 * MiB + 512 * 1024;
constexpr size_t WS_UF = 244 * MiB;
constexpr size_t WS_LA = 404 * MiB;
constexpr size_t WS_LB = 436 * MiB;
constexpr size_t WS_END = 468 * MiB;

#define MAKE_RSRC(p, bytes) __builtin_amdgcn_make_buffer_rsrc((void*)(p), 0, (int)(bytes), 0x00020000)
__device__ __forceinline__ unsigned f2bf(float f) { unsigned u = __builtin_bit_cast(unsigned, f); return (u + 0x7fffu + ((u >> 16) & 1u)) >> 16; }
__device__ __forceinline__ unsigned pk2(float lo, float hi) { return f2bf(lo) | (f2bf(hi) << 16); }
__device__ __forceinline__ float bflo(unsigned w) { return __builtin_bit_cast(float, w << 16); }
__device__ __forceinline__ float bfhi(unsigned w) { return __builtin_bit_cast(float, w & 0xffff0000u); }
__device__ __forceinline__ float bf2f(bf16_t b) { return __builtin_bit_cast(float, (unsigned)b << 16); }
__device__ __forceinline__ float sigm(float x) { return 1.f / (1.f + __expf(-x)); }
__device__ __forceinline__ float siluf(float x) { return x * sigm(x); }
__device__ __forceinline__ float wave_sum(float v) {
#pragma unroll
    for (int o = 1; o < 64; o <<= 1) v += __shfl_xor(v, o);
    return v;
}
__device__ __forceinline__ float neg_expm1(float x) {
    if (x > -0.35f) { float p = 1.f + x * (1.f / 8.f); p = 1.f + x * (1.f / 7.f) * p; p = 1.f + x * (1.f / 6.f) * p; p = 1.f + x * (1.f / 5.f) * p; p = 1.f + x * 0.25f * p; p = 1.f + x * (1.f / 3.f) * p; p = 1.f + x * 0.5f * p; return -x * p; }
    return 1.f - __expf(x);
}
__device__ __forceinline__ float log_sigmoid(float x) { return fminf(x, 0.f) - log1pf(expf(-fabsf(x))); }
__host__ __device__ __forceinline__ int src_col(int np) { if (np < 2048) { const int p = np >> 8, j = np & 255; return j < 128 ? 128 * p + j : 1024 + 128 * p + (j - 128); } return np; }

#define XB_TMO      128
#define XB_XCNT(j)  (256  + 64 * (j))
#define XB_XSUB(j)  (1280 + 64 * (j))
#define XB_XGEN(j)  (2304 + 64 * (j))
#define XB_TOP      3328
#define XB_TOPGEN   3392
#define XCD_BAR_WORDS 3456
#define XB_SPIN_CAP (1u << 18)
__device__ __forceinline__ unsigned xb_ld(unsigned* p)              { return __hip_atomic_load(p, __ATOMIC_RELAXED, __HIP_MEMORY_SCOPE_AGENT); }
__device__ __forceinline__ unsigned xb_add(unsigned* p, unsigned v) { return __hip_atomic_fetch_add(p, v, __ATOMIC_RELAXED, __HIP_MEMORY_SCOPE_AGENT); }
__device__ __forceinline__ unsigned xb_xcc_id() { return (unsigned)__builtin_amdgcn_s_getreg((3 << 11) | 20) & 0xFu; }
#define XB_SPIN(cond, bar) do { unsigned _sp = 0; while (cond) { __builtin_amdgcn_s_sleep(1); \
    if ((++_sp & 255u) == 0u) { if (xb_ld(&(bar)[XB_TMO])) break; if (_sp > XB_SPIN_CAP) { atomicAdd(&(bar)[XB_TMO], 1u); break; } } } } while (0)
struct XcdBarrier { unsigned* bar; unsigned x; volatile LAS unsigned* st; };
__device__ __forceinline__ XcdBarrier xcd_barrier_post(unsigned* bar, volatile LAS unsigned* st) {
    XcdBarrier b; b.bar = bar; b.x = xb_xcc_id(); b.st = st;
    if (threadIdx.x == 0) (void)xb_add(&bar[XB_XCNT(b.x)], 1u);
    return b;
}
__device__ __forceinline__ void xcd_barrier_complete(unsigned* bar, unsigned x, unsigned& nloc, unsigned& nx) {
    const unsigned G = gridDim.x * gridDim.y * gridDim.z;
    unsigned sum, cnt, mine, sp = 0u;
    for (;;) {
        sum = 0u; cnt = 0u; mine = 0u;
#pragma unroll
        for (unsigned j = 0; j < 16; ++j) { const unsigned c = xb_ld(&bar[XB_XCNT(j)]); sum += c; cnt += (c > 0u) ? 1u : 0u; mine = (j == x) ? c : mine; }
        if (sum == G) break;
        __builtin_amdgcn_s_sleep(1);
        if ((++sp & 255u) == 0u) { if (xb_ld(&bar[XB_TMO])) break; if (sp > XB_SPIN_CAP) { atomicAdd(&bar[XB_TMO], 1u); break; } }
    }
    nloc = mine > 0u ? mine : 1u; nx = cnt > 0u ? cnt : 1u;
}
__device__ __forceinline__ void xcd_barrier(const XcdBarrier& b) {
    asm volatile("s_waitcnt vmcnt(0)" ::: "memory");
    __syncthreads();
    if (threadIdx.x == 0) {
        unsigned* bar = b.bar;
        __builtin_amdgcn_s_waitcnt(0);
        unsigned nloc = b.st[0], nx = b.st[1];
        if (nloc == 0u) { xcd_barrier_complete(bar, b.x, nloc, nx); b.st[0] = nloc; b.st[1] = nx; }
        const unsigned old = xb_add(&bar[XB_XSUB(b.x)], 1u);
        const unsigned gen = old / nloc;
        if (old + 1u == (gen + 1u) * nloc) {
            __builtin_amdgcn_fence(__ATOMIC_RELEASE, "agent");
            asm volatile("s_waitcnt vmcnt(0)" ::: "memory");
            const unsigned og = xb_add(&bar[XB_TOP], 1u);
            const unsigned tg = og / nx;
            if (og + 1u == (tg + 1u) * nx) xb_add(&bar[XB_TOPGEN], 1u);
            else XB_SPIN(xb_ld(&bar[XB_TOPGEN]) == tg, bar);
            __builtin_amdgcn_fence(__ATOMIC_ACQUIRE, "agent");
            xb_add(&bar[XB_XGEN(b.x)], 1u);
            asm volatile("s_waitcnt vmcnt(0)" ::: "memory");
        } else {
            XB_SPIN(xb_ld(&bar[XB_XGEN(b.x)]) == gen, bar);
            __builtin_amdgcn_fence(__ATOMIC_ACQUIRE, "agent");
            asm volatile("s_waitcnt vmcnt(0)" ::: "memory");
        }
    }
    __syncthreads();
}

struct Frame {
    LAS unsigned char* lds;
    int tid, lane, wave, bid, G;
    const float *x, *norm_g, *w_in, *cdw_w, *cdw_b, *cln_g, *cln_b, *lcw, *lcb, *wa, *ba, *wx, *bx, *lam, *w_out, *final_g;
    float* out;
    bf16_t *WinT, *WoutT, *XB, *U, *Y;
    float *SSQ, *PS, *HS, *UF, *LA, *LB;
};

#define PHASE_TID(F) do { int _t = threadIdx.x; asm volatile("" : "+v"(_t)); (F).tid = _t; (F).lane = _t & 63; (F).wave = __builtin_amdgcn_readfirstlane(_t >> 6); } while (0)
__device__ __forceinline__ void transpose_item(const float* W, int K, int N, bf16_t* WT, int dst_row0, int src_col0, const float* gk, LAS float* scr, int k0, int lane) {
#pragma unroll 8
    for (int i = 0; i < 32; ++i) { const int kk = 2 * i + (lane >> 5); float v = W[(size_t)(k0 + kk) * N + src_col0 + (lane & 31)]; if (gk) v *= gk[k0 + kk]; scr[kk * 33 + (lane & 31)] = v; }
    asm volatile("s_waitcnt lgkmcnt(0)" ::: "memory");
    const int c = lane & 7;
#pragma unroll
    for (int j = 0; j < 4; ++j) { const int n = (lane >> 3) + 8 * j; const LAS float* s = scr + (8 * c) * 33 + n;
        u32x4 o; o.x = pk2(s[0 * 33], s[1 * 33]); o.y = pk2(s[2 * 33], s[3 * 33]); o.z = pk2(s[4 * 33], s[5 * 33]); o.w = pk2(s[6 * 33], s[7 * 33]);
        *(u32x4*)(WT + (size_t)(dst_row0 + n) * K + k0 + 8 * c) = o; }
    asm volatile("s_waitcnt lgkmcnt(0)" ::: "memory");
}
__device__ __forceinline__ void p_prologue(Frame& F) {
    PHASE_TID(F);
    LAS float* scr = (LAS float*)(F.lds + F.wave * 16384);
    const int gw = F.bid * NWAVES + F.wave, NGW = F.G * NWAVES;
    constexpr int I_IN = (D / 64) * (DIN / 32), I_OUT = (D / 64) * (D / 32), I_L = I_IN + I_OUT;
    for (int it = gw; it < DEPTH * I_L; it += NGW) {
        const int l = it / I_L; int r = it % I_L;
        if (r < I_IN) { const int kb = r / (DIN / 32), nb = r % (DIN / 32);
            transpose_item(F.w_in + (size_t)l * D * DIN, D, DIN, F.WinT + (size_t)l * DIN * D, 32 * nb, src_col(32 * nb), F.norm_g + l * D, scr, 64 * kb, F.lane);
        } else { r -= I_IN; const int kb = r / (D / 32), nb = r % (D / 32);
            transpose_item(F.w_out + (size_t)l * D * D, D, D, F.WoutT + (size_t)l * D * D, 32 * nb, 32 * nb, nullptr, scr, 64 * kb, F.lane); }
    }
    for (int m = gw; m < S; m += NGW) {
        const f32x4* xr = (const f32x4*)(F.x + (size_t)m * D) + F.lane; u32x2* ob = (u32x2*)(F.XB + (size_t)m * D) + F.lane; float s = 0.f;
#pragma unroll
        for (int j = 0; j < 8; ++j) { const f32x4 v = xr[64 * j]; s += (v.x * v.x + v.y * v.y) + (v.z * v.z + v.w * v.w); u32x2 w; w.x = pk2(v.x, v.y); w.y = pk2(v.z, v.w); ob[64 * j] = w; }
        s = wave_sum(s);
        if (F.lane < 8) F.SSQ[F.lane * S + m] = F.lane == 0 ? s : 0.f;
    }
}

__device__ __forceinline__ void p_sgemm(Frame& F, const bf16_t* A, const bf16_t* Bt, int M, int N, int K, float* C, int ldc) {
    PHASE_TID(F);
    LAS bf16_t* As = (LAS bf16_t*)F.lds; LAS bf16_t* Bs = As + 128 * 40;
    const int tid = F.tid, lane = F.lane, wid = F.wave, wr = wid >> 2, wc = wid & 3, fr = lane & 15, fq = lane >> 4;
    const int r = tid >> 2, c8 = (tid & 3) * 8;
    const int nN = N / 128, items = (M / 128) * nN;
    for (int it = F.bid; it < items; it += F.G) {
        const int m0 = (it / nN) * 128, n0 = (it % nN) * 128;
        f32x4 acc[4][2];
#pragma unroll
        for (int m = 0; m < 4; ++m)
#pragma unroll
            for (int n = 0; n < 2; ++n) acc[m][n] = (f32x4){0.f, 0.f, 0.f, 0.f};
        const bf16_t* ap = A + (size_t)(m0 + r) * K + c8; const bf16_t* bp = Bt + (size_t)(n0 + r) * K + c8;
        for (int k0 = 0; k0 < K; k0 += 32) {
            const u32x4 va = *(const u32x4*)(ap + k0), vb = *(const u32x4*)(bp + k0);
            __syncthreads();
            *(LAS u32x4*)(As + r * 40 + c8) = va; *(LAS u32x4*)(Bs + r * 40 + c8) = vb;
            __syncthreads();
            bf16x8 a[4], b[2];
#pragma unroll
            for (int m = 0; m < 4; ++m) a[m] = *(const LAS bf16x8*)(As + (wr * 64 + m * 16 + fr) * 40 + fq * 8);
#pragma unroll
            for (int n = 0; n < 2; ++n) b[n] = *(const LAS bf16x8*)(Bs + (wc * 32 + n * 16 + fr) * 40 + fq * 8);
#pragma unroll
            for (int m = 0; m < 4; ++m)
#pragma unroll
                for (int n = 0; n < 2; ++n) acc[m][n] = __builtin_amdgcn_mfma_f32_16x16x32_bf16(b[n], a[m], acc[m][n], 0, 0, 0);
        }
#pragma unroll
        for (int m = 0; m < 4; ++m)
#pragma unroll
            for (int n = 0; n < 2; ++n) *(f32x4*)(C + (size_t)(m0 + wr * 64 + m * 16 + fr) * ldc + n0 + wc * 32 + n * 16 + 4 * fq) = acc[m][n];
    }
    __syncthreads();
}

__device__ __forceinline__ void p_epi1(Frame& F) {
    PHASE_TID(F);
    const long total = (long)S * (UW / 8);
    for (long g = (long)F.bid * NTHREADS + F.tid; g < total; g += (long)F.G * NTHREADS) {
        const int row = (int)(g / (UW / 8)), j0 = (int)(g % (UW / 8)) * 8;
        float ss = 0.f;
#pragma unroll
        for (int p = 0; p < 8; ++p) ss += F.SSQ[p * S + row];
        const float rstd = 1.f / sqrtf(ss * (1.f / D) + RMS_EPS);
        const float* ur = F.UF + (size_t)row * DIN;
        float o[8];
        if (j0 < 1024) { const int p = j0 >> 7, jj = j0 & 127; const float* vp = ur + 256 * p + jj; const float* gp = vp + 128;
#pragma unroll
            for (int e = 0; e < 8; ++e) { const float v = vp[e] * rstd, gt = gp[e] * rstd; o[e] = v * sigm(gt); }
        } else { const float* sp = ur + 1024 + j0;
            const bool act = (j0 < 2048) || (j0 >= 3072);
#pragma unroll
            for (int e = 0; e < 8; ++e) { const float v = sp[e] * rstd; o[e] = act ? siluf(v) : v; }
        }
        u32x4 w; w.x = pk2(o[0], o[1]); w.y = pk2(o[2], o[3]); w.z = pk2(o[4], o[5]); w.w = pk2(o[6], o[7]);
        *(u32x4*)(F.U + (size_t)row * UW + j0) = w;
    }
}

template <int NV> __device__ __forceinline__ void block_sum(float (&v)[NV], LAS float* red  , int wave, int lane) {
#pragma unroll
    for (int i = 0; i < NV; ++i) { const float s = wave_sum(v[i]); if (lane == 0) red[i * 8 + wave] = s; }
    __syncthreads();
#pragma unroll
    for (int i = 0; i < NV; ++i) { const LAS f32x4* p = (const LAS f32x4*)(red + i * 8); const f32x4 a = p[0], b = p[1]; v[i] = ((a.x + a.y) + (a.z + a.w)) + ((b.x + b.y) + (b.z + b.w)); }
    __syncthreads();
}
constexpr int CT = 16;
__device__ __forceinline__ void conv_item(Frame& F, int l, int item) {
    LAS unsigned char* cs = F.lds;
    LAS float* red = (LAS float*)(F.lds + 62 * 2048);
    const int t0 = item * 32, c0 = 2 * F.tid;
    for (int q = F.tid; q < 62 * 128; q += NTHREADS) { const int row = q >> 7, c16 = q & 127, s = t0 - 30 + row; u32x4 v = (u32x4){0u, 0u, 0u, 0u};
        if (s >= 0) v = *(const u32x4*)(F.U + (size_t)s * UW + c16 * 8);
        *(LAS u32x4*)(cs + row * 2048 + c16 * 16) = v; }
    __syncthreads();
    float w0[31], w1[31];
    const auto rw = MAKE_RSRC(F.cdw_w + (size_t)l * CW * DC, CW * DC * 4);
#pragma unroll
    for (int j = 0; j < 31; ++j) { const f32x2 t = __builtin_bit_cast(f32x2, __builtin_amdgcn_raw_buffer_load_b64(rw, c0 * 4, (30 - j) * DC * 4, 0)); w0[j] = t.x; w1[j] = t.y; }
    const f32x2 bias = *(const f32x2*)(F.cdw_b + l * DC + c0);
    const f32x2 lg = *(const f32x2*)(F.cln_g + l * DC + c0), lb = *(const f32x2*)(F.cln_b + l * DC + c0);
    const auto ru = MAKE_RSRC(F.U, (size_t)S * UW * 2); const auto ry = MAKE_RSRC(F.Y, (size_t)S * D * 2);
#pragma unroll 1
    for (int hb = 0; hb < 32 / CT; ++hb) {
        float a0[CT], a1[CT];
#pragma unroll
        for (int i = 0; i < CT; ++i) { a0[i] = bias.x; a1[i] = bias.y; }
        const LAS unsigned char* cp = cs + (hb * CT) * 2048 + F.tid * 4;
#pragma unroll
        for (int si = 0; si < CT + 30; ++si) {
            const unsigned cw = *(const LAS unsigned*)(cp + si * 2048);
            const float x0 = bflo(cw), x1 = bfhi(cw);
#pragma unroll
            for (int i = 0; i < CT; ++i) { const int j = i + 30 - si; if (j >= 0 && j <= 30) { a0[i] += w0[j] * x0; a1[i] += w1[j] * x1; } }
        }
        float sv[CT];
#pragma unroll
        for (int i = 0; i < CT; ++i) sv[i] = a0[i] + a1[i];
        block_sum<CT>(sv, red, F.wave, F.lane);
#pragma unroll
        for (int i = 0; i < CT; ++i) { const float mean = sv[i] * (1.f / DC); a0[i] -= mean; a1[i] -= mean; sv[i] = a0[i] * a0[i] + a1[i] * a1[i]; }
        block_sum<CT>(sv, red, F.wave, F.lane);
#pragma unroll
        for (int i = 0; i < CT; ++i) {
            const int t = t0 + hb * CT + i;
            const float rstd = 1.f / sqrtf(sv[i] * (1.f / DC) + LN_EPS);
            const unsigned zw = __builtin_amdgcn_raw_buffer_load_b32(ru, (1024 + c0) * 2, t * (UW * 2), 0);
            const float y0 = siluf(a0[i] * rstd * lg.x + lb.x) * bflo(zw), y1 = siluf(a1[i] * rstd * lg.y + lb.y) * bfhi(zw);
            __builtin_amdgcn_raw_buffer_store_b32(pk2(y0, y1), ry, c0 * 2, t * (D * 2), 0);
        }
    }
    __syncthreads();
}
__device__ __forceinline__ void lru_ab_item(Frame& F, int l, int item) {
    LAS float* xcs = (LAS float*)F.lds;
    const int cidx = item >> 3, h = item & 7, t0 = cidx * SCH, ch0 = h * HD;
    {
        const int t = F.tid >> 3, cb = (F.tid & 7) * 16;
        const float* cwp = F.lcw + (size_t)l * LW * DL + ch0 + cb; const float* cbp = F.lcb + l * DL + ch0 + cb;
        float acc[16];
#pragma unroll
        for (int e = 0; e < 16; ++e) acc[e] = cbp[e];
#pragma unroll
        for (int k = 0; k < 4; ++k) { const int s = t0 + t - 3 + k;
            if (s >= 0) { const u32x4* up = (const u32x4*)(F.U + (size_t)s * UW + 2048 + ch0 + cb); const u32x4 q0 = up[0], q1 = up[1];
                const unsigned qq[8] = {q0.x, q0.y, q0.z, q0.w, q1.x, q1.y, q1.z, q1.w};
#pragma unroll
                for (int e = 0; e < 8; ++e) { acc[2 * e] += cwp[(size_t)k * DL + 2 * e] * bflo(qq[e]); acc[2 * e + 1] += cwp[(size_t)k * DL + 2 * e + 1] * bfhi(qq[e]); } } }
#pragma unroll
        for (int e = 0; e < 16; ++e) xcs[t * 128 + cb + e] = acc[e];
    }
    __syncthreads();
    const int ch = F.tid & 127, tg = F.tid >> 7;
    const float* wap = F.wa + ((size_t)(l * NHEAD + h) * HD) * HD + ch; const float* wxp = F.wx + ((size_t)(l * NHEAD + h) * HD) * HD + ch;
    float ar[16], ai[16];
#pragma unroll
    for (int i = 0; i < 16; ++i) { ar[i] = 0.f; ai[i] = 0.f; }
#pragma unroll 2
    for (int k = 0; k < HD; ++k) { const float war = wap[(size_t)k * HD], wxr = wxp[(size_t)k * HD];
#pragma unroll
        for (int i = 0; i < 16; ++i) { const float xv = xcs[(tg * 16 + i) * 128 + k]; ar[i] += xv * war; ai[i] += xv * wxr; } }
    const int gch = ch0 + ch;
    const float bar_ = F.ba[l * DL + gch], bxr = F.bx[l * DL + gch], c8 = 8.f * log_sigmoid(F.lam[l * DL + gch]);
#pragma unroll
    for (int i = 0; i < 16; ++i) { const int t = tg * 16 + i;
        const float r = sigm(ar[i] + bar_), ig = sigm(ai[i] + bxr), la = c8 * r, a = __expf(la), mult = sqrtf(neg_expm1(2.f * la));
        F.LA[(size_t)(t0 + t) * DL + gch] = a; F.LB[(size_t)(t0 + t) * DL + gch] = mult * (ig * xcs[t * 128 + ch]); }
    __syncthreads();
}
__device__ __forceinline__ void p_mix1(Frame& F, int l) {
    PHASE_TID(F);
    constexpr int NCONV = S / 32, NLRU = NSCH * NHEAD;
    for (int it = F.bid; it < NCONV; it += F.G) { PHASE_TID(F); conv_item(F, l, it); }
    for (int it = F.bid; it < NLRU; it += F.G) { PHASE_TID(F); lru_ab_item(F, l, it); }
}
__device__ __forceinline__ void p_scan1(Frame& F) {
    PHASE_TID(F);
    for (int it = F.bid; it < NSCH * 2; it += F.G) { const int cidx = it >> 1, ch = (it & 1) * 512 + F.tid, t0 = cidx * SCH; float P = 1.f, H = 0.f;
#pragma unroll 8
        for (int i = 0; i < SCH; ++i) { const float a = F.LA[(size_t)(t0 + i) * DL + ch], b = F.LB[(size_t)(t0 + i) * DL + ch]; H = a * H + b; P *= a; }
        F.PS[cidx * DL + ch] = P; F.HS[cidx * DL + ch] = H; }
}
__device__ __forceinline__ void p_scan2(Frame& F) {
    PHASE_TID(F);
    for (int it = F.bid; it < NSCH * 2; it += F.G) { const int cidx = it >> 1, ch = (it & 1) * 512 + F.tid, t0 = cidx * SCH; float H = 0.f;
        for (int c = 0; c < cidx; ++c) H = F.PS[c * DL + ch] * H + F.HS[c * DL + ch];
#pragma unroll 8
        for (int i = 0; i < SCH; ++i) { const float a = F.LA[(size_t)(t0 + i) * DL + ch], b = F.LB[(size_t)(t0 + i) * DL + ch]; H = a * H + b;
            const float z = bf2f(F.U[(size_t)(t0 + i) * UW + 3072 + ch]); F.Y[(size_t)(t0 + i) * D + DC + ch] = (bf16_t)f2bf(H * z); } }
}
__device__ __forceinline__ void p_epi2(Frame& F, int l) {
    PHASE_TID(F);
    const int gw = F.bid * NWAVES + F.wave, NGW = F.G * NWAVES; const float* xold = (l == 0) ? F.x : F.out;
    for (int m = gw; m < S; m += NGW) {
        const f32x4* xr = (const f32x4*)(xold + (size_t)m * D) + F.lane; const f32x4* ur = (const f32x4*)(F.UF + (size_t)m * D) + F.lane;
        f32x4* orow = (f32x4*)(F.out + (size_t)m * D) + F.lane; u32x2* ob = (u32x2*)(F.XB + (size_t)m * D) + F.lane; float s = 0.f;
#pragma unroll
        for (int j = 0; j < 8; ++j) { const f32x4 v = xr[64 * j] + ur[64 * j]; s += (v.x * v.x + v.y * v.y) + (v.z * v.z + v.w * v.w); orow[64 * j] = v; u32x2 w; w.x = pk2(v.x, v.y); w.y = pk2(v.z, v.w); ob[64 * j] = w; }
        s = wave_sum(s);
        if (F.lane < 8) F.SSQ[F.lane * S + m] = F.lane == 0 ? s : 0.f;
    }
}
__device__ __forceinline__ void p_final(Frame& F) {
    PHASE_TID(F);
    const int gw = F.bid * NWAVES + F.wave, NGW = F.G * NWAVES;
    for (int m = gw; m < S; m += NGW) {
        float ss = 0.f;
#pragma unroll
        for (int p = 0; p < 8; ++p) ss += F.SSQ[p * S + m];
        const float rstd = 1.f / sqrtf(ss * (1.f / D) + RMS_EPS);
        f32x4* orow = (f32x4*)(F.out + (size_t)m * D) + F.lane; const f32x4* gr = (const f32x4*)F.final_g + F.lane;
#pragma unroll
        for (int j = 0; j < 8; ++j) orow[64 * j] = orow[64 * j] * rstd * gr[64 * j];
    }
}

constexpr int PH_PER_LAYER = 7, NPH = 1 + DEPTH * PH_PER_LAYER + 1;
struct Args { const float* in[16]; float* out; unsigned char* ws; int ph_lo, ph_hi; };
__global__ void __launch_bounds__(NTHREADS, 2) mk_fwd(Args a) {
    extern __shared__ __attribute__((aligned(16))) unsigned char lds_raw[];
    Frame F;
    F.lds = (LAS unsigned char*)lds_raw;
    F.tid = threadIdx.x; F.lane = F.tid & 63; F.wave = __builtin_amdgcn_readfirstlane(F.tid >> 6); F.bid = blockIdx.x; F.G = gridDim.x;
    F.x = a.in[0]; F.norm_g = a.in[1]; F.w_in = a.in[2]; F.cdw_w = a.in[3]; F.cdw_b = a.in[4]; F.cln_g = a.in[5]; F.cln_b = a.in[6]; F.lcw = a.in[7]; F.lcb = a.in[8];
    F.wa = a.in[9]; F.ba = a.in[10]; F.wx = a.in[11]; F.bx = a.in[12]; F.lam = a.in[13]; F.w_out = a.in[14]; F.final_g = a.in[15]; F.out = a.out;
    unsigned char* ws = a.ws;
    F.WinT = (bf16_t*)(ws + WS_WINT); F.WoutT = (bf16_t*)(ws + WS_WOUTT); F.XB = (bf16_t*)(ws + WS_XB); F.U = (bf16_t*)(ws + WS_U); F.Y = (bf16_t*)(ws + WS_Y);
    F.SSQ = (float*)(ws + WS_SSQ); F.PS = (float*)(ws + WS_PS); F.HS = (float*)(ws + WS_HS); F.UF = (float*)(ws + WS_UF); F.LA = (float*)(ws + WS_LA); F.LB = (float*)(ws + WS_LB);
    volatile LAS unsigned* bst = (volatile LAS unsigned*)(F.lds + LDS_BYTES - 64);
    if (F.tid < 16) bst[F.tid] = 0u;
    __syncthreads();
    XcdBarrier bar; bar.bar = (unsigned*)(ws + WS_CTL) + 4096; bar.x = 0; bar.st = bst;
    if (MK_ONE_LAUNCH) bar = xcd_barrier_post((unsigned*)(ws + WS_CTL) + 4096, bst);
    for (int ph = a.ph_lo; ph < a.ph_hi; ++ph) {
        if (ph == 0) p_prologue(F);
        else if (ph == NPH - 1) p_final(F);
        else { const int l = (ph - 1) / PH_PER_LAYER, j = (ph - 1) % PH_PER_LAYER;
            if (j == 0) p_sgemm(F, F.XB, F.WinT + (size_t)l * DIN * D, S, DIN, D, F.UF, DIN);
            else if (j == 1) p_epi1(F);
            else if (j == 2) p_mix1(F, l);
            else if (j == 3) p_scan1(F);
            else if (j == 4) p_scan2(F);
            else if (j == 5) p_sgemm(F, F.Y, F.WoutT + (size_t)l * D * D, S, D, D, F.UF, D);
            else p_epi2(F, l);
        }
        if (ph + 1 < a.ph_hi) xcd_barrier(bar);
    }
}

extern "C" void kernel_launch(void* const* d_in, const int* in_sizes, int n_in, void* d_out, int out_size, void* d_ws, size_t ws_size, hipStream_t stream) {
    static int grid = 0;
    if (grid == 0) {
        if (n_in != 16 || in_sizes[0] != S * D || out_size != S * D || ws_size < WS_END) { fprintf(stderr, "kernel_launch: unexpected shapes (n_in %d, in0 %d, out %d, ws %zu)\n", n_in, n_in > 0 ? in_sizes[0] : -1, out_size, ws_size); grid = -1; return; }
        int dev = 0, cus = 0, per_cu = 0;
        if (hipGetDevice(&dev) != hipSuccess || hipDeviceGetAttribute(&cus, hipDeviceAttributeMultiprocessorCount, dev) != hipSuccess) { grid = -1; return; }
        if (hipFuncSetAttribute((const void*)mk_fwd, hipFuncAttributeMaxDynamicSharedMemorySize, LDS_BYTES) != hipSuccess) { fprintf(stderr, "kernel_launch: hipFuncSetAttribute failed\n"); grid = -1; return; }
        if (hipOccupancyMaxActiveBlocksPerMultiprocessor(&per_cu, (const void*)mk_fwd, NTHREADS, LDS_BYTES) != hipSuccess || per_cu < 1) fprintf(stderr, "kernel_launch: occupancy query says %d per CU\n", per_cu);
        (void)hipGetLastError();
        grid = cus;
    }
    if (grid < 0) return;
    (void)hipMemsetAsync((char*)d_ws + WS_CTL, 0, CTL_ZERO_BYTES, stream);
    Args a{};
    for (int i = 0; i < 16; ++i) a.in[i] = (const float*)d_in[i];
    a.out = (float*)d_out; a.ws = (unsigned char*)d_ws;
#if MK_ONE_LAUNCH
    a.ph_lo = 0; a.ph_hi = NPH;
    hipLaunchKernelGGL(mk_fwd, dim3(grid), dim3(NTHREADS), LDS_BYTES, stream, a);
#else
    for (int ph = 0; ph < NPH; ++ph) { a.ph_lo = ph; a.ph_hi = ph + 1; hipLaunchKernelGGL(mk_fwd, dim3(grid), dim3(NTHREADS), LDS_BYTES, stream, a); }
#endif
}
```

```cpp
#include <hip/hip_runtime.h>
#include <cstdio>
#include <cstdint>

#ifndef MK_ONE_LAUNCH
#define MK_ONE_LAUNCH 1
#endif

#define LAS __attribute__((address_space(3)))
#define GAS __attribute__((address_space(1)))
typedef unsigned short bf16_t;
typedef short bf16x8 __attribute__((ext_vector_type(8)));
typedef float f32x4 __attribute__((ext_vector_type(4)));
typedef float f32x2 __attribute__((ext_vector_type(2)));
typedef unsigned u32x4 __attribute__((ext_vector_type(4)));
typedef unsigned u32x2 __attribute__((ext_vector_type(2)));

constexpr int S = 8192, D = 2048, DEPTH = 4, DC = 1024, DL = 1024, DIN = 5120, NHEAD = 8, HD = 128, CW = 31, LW = 4;
constexpr int UW = 4096;
constexpr float RMS_EPS = 1e-6f, LN_EPS = 1e-5f;
constexpr int NTHREADS = 512, NWAVES = 8;
constexpr int LDS_BYTES = 147456;
constexpr int SCH = 64, NSCH = S / SCH;

constexpr size_t MiB = 1u << 20;
constexpr size_t WS_CTL = 0, CTL_ZERO_BYTES = 1 * MiB;
constexpr size_t WS_WINT = 2 * MiB;
constexpr size_t WS_WOUTT = 82 * MiB;
constexpr size_t WS_XB = 114 * MiB;
constexpr size_t WS_U = 146 * MiB;
constexpr size_t WS_Y = 210 * MiB;
constexpr size_t WS_SSQ = 242 * MiB;
constexpr size_t WS_PS = 243 * MiB;
constexpr size_t WS_HS = 243 * MiB + 512 * 1024;
constexpr size_t WS_UF = 244 * MiB;
constexpr size_t WS_LA = 404 * MiB;
constexpr size_t WS_LB = 436 * MiB;
constexpr size_t WS_END = 468 * MiB;

#define MAKE_RSRC(p, bytes) __builtin_amdgcn_make_buffer_rsrc((void*)(p), 0, (int)(bytes), 0x00020000)
__device__ __forceinline__ unsigned f2bf(float f) { unsigned u = __builtin_bit_cast(unsigned, f); return (u + 0x7fffu + ((u >> 16) & 1u)) >> 16; }
__device__ __forceinline__ unsigned pk2(float lo, float hi) { return f2bf(lo) | (f2bf(hi) << 16); }
__device__ __forceinline__ float bflo(unsigned w) { return __builtin_bit_cast(float, w << 16); }
__device__ __forceinline__ float bfhi(unsigned w) { return __builtin_bit_cast(float, w & 0xffff0000u); }
__device__ __forceinline__ float bf2f(bf16_t b) { return __builtin_bit_cast(float, (unsigned)b << 16); }
__device__ __forceinline__ float sigm(float x) { return 1.f / (1.f + __expf(-x)); }
__device__ __forceinline__ float siluf(float x) { return x * sigm(x); }
__device__ __forceinline__ float wave_sum(float v) {
#pragma unroll
    for (int o = 1; o < 64; o <<= 1) v += __shfl_xor(v, o);
    return v;
}
__device__ __forceinline__ float neg_expm1(float x) {
    if (x > -0.35f) { float p = 1.f + x * (1.f / 8.f); p = 1.f + x * (1.f / 7.f) * p; p = 1.f + x * (1.f / 6.f) * p; p = 1.f + x * (1.f / 5.f) * p; p = 1.f + x * 0.25f * p; p = 1.f + x * (1.f / 3.f) * p; p = 1.f + x * 0.5f * p; return -x * p; }
    return 1.f - __expf(x);
}
__device__ __forceinline__ float log_sigmoid(float x) { return fminf(x, 0.f) - log1pf(expf(-fabsf(x))); }
__host__ __device__ __forceinline__ int src_col(int np) { if (np < 2048) { const int p = np >> 8, j = np & 255; return j < 128 ? 128 * p + j : 1024 + 128 * p + (j - 128); } return np; }

#define XB_TMO      128
#define XB_XCNT(j)  (256  + 64 * (j))
#define XB_XSUB(j)  (1280 + 64 * (j))
#define XB_XGEN(j)  (2304 + 64 * (j))
#define XB_TOP      3328
#define XB_TOPGEN   3392
#define XCD_BAR_WORDS 3456
#define XB_SPIN_CAP (1u << 18)
__device__ __forceinline__ unsigned xb_ld(unsigned* p)              { return __hip_atomic_load(p, __ATOMIC_RELAXED, __HIP_MEMORY_SCOPE_AGENT); }
__device__ __forceinline__ unsigned xb_add(unsigned* p, unsigned v) { return __hip_atomic_fetch_add(p, v, __ATOMIC_RELAXED, __HIP_MEMORY_SCOPE_AGENT); }
__device__ __forceinline__ unsigned xb_xcc_id() { return (unsigned)__builtin_amdgcn_s_getreg((3 << 11) | 20) & 0xFu; }
#define XB_SPIN(cond, bar) do { unsigned _sp = 0; while (cond) { __builtin_amdgcn_s_sleep(1); \
    if ((++_sp & 255u) == 0u) { if (xb_ld(&(bar)[XB_TMO])) break; if (_sp > XB_SPIN_CAP) { atomicAdd(&(bar)[XB_TMO], 1u); break; } } } } while (0)
struct XcdBarrier { unsigned* bar; unsigned x; volatile LAS unsigned* st; };
__device__ __forceinline__ XcdBarrier xcd_barrier_post(unsigned* bar, volatile LAS unsigned* st) {
    XcdBarrier b; b.bar = bar; b.x = xb_xcc_id(); b.st = st;
    if (threadIdx.x == 0) (void)xb_add(&bar[XB_XCNT(b.x)], 1u);
    return b;
}
__device__ __forceinline__ void xcd_barrier_complete(unsigned* bar, unsigned x, unsigned& nloc, unsigned& nx) {
    const unsigned G = gridDim.x * gridDim.y * gridDim.z;
    unsigned sum, cnt, mine, sp = 0u;
    for (;;) {
        sum = 0u; cnt = 0u; mine = 0u;
#pragma unroll
        for (unsigned j = 0; j < 16; ++j) { const unsigned c = xb_ld(&bar[XB_XCNT(j)]); sum += c; cnt += (c > 0u) ? 1u : 0u; mine = (j == x) ? c : mine; }
        if (sum == G) break;
        __builtin_amdgcn_s_sleep(1);
        if ((++sp & 255u) == 0u) { if (xb_ld(&bar[XB_TMO])) break; if (sp > XB_SPIN_CAP) { atomicAdd(&bar[XB_TMO], 1u); break; } }
    }
    nloc = mine > 0u ? mine : 1u; nx = cnt > 0u ? cnt : 1u;
}
__device__ __forceinline__ void xcd_barrier(const XcdBarrier& b) {
    asm volatile("s_waitcnt vmcnt(0)" ::: "memory");
    __syncthreads();
    if (threadIdx.x == 0) {
        unsigned* bar = b.bar;
        __builtin_amdgcn_s_waitcnt(0);
        unsigned nloc = b.st[0], nx = b.st[1];
        if (nloc == 0u) { xcd_barrier_complete(bar, b.x, nloc, nx); b.st[0] = nloc; b.st[1] = nx; }
        const unsigned old = xb_add(&bar[XB_XSUB(b.x)], 1u);
        const unsigned gen = old / nloc;
        if (old + 1u == (gen + 1u) * nloc) {
            __builtin_amdgcn_fence(__ATOMIC_RELEASE, "agent");
            asm volatile("s_waitcnt vmcnt(0)" ::: "memory");
            const unsigned og = xb_add(&bar[XB_TOP], 1u);
            const unsigned tg = og / nx;
            if (og + 1u == (tg + 1u) * nx) xb_add(&bar[XB_TOPGEN], 1u);
            else XB_SPIN(xb_ld(&bar[XB_TOPGEN]) == tg, bar);
            __builtin_amdgcn_fence(__ATOMIC_ACQUIRE, "agent");
            xb_add(&bar[XB_XGEN(b.x)], 1u);
            asm volatile("s_waitcnt vmcnt(0)" ::: "memory");
        } else {
            XB_SPIN(xb_ld(&bar[XB_XGEN(b.x)]) == gen, bar);
            __builtin_amdgcn_fence(__ATOMIC_ACQUIRE, "agent");
            asm volatile("s_waitcnt vmcnt(0)" ::: "memory");
        }
    }
    __syncthreads();
}

struct Frame {
    LAS unsigned char* lds;
    int tid, lane, wave, bid, G;
    const float *x, *norm_g, *w_in, *cdw_w, *cdw_b, *cln_g, *cln_b, *lcw, *lcb, *wa, *ba, *wx, *bx, *lam, *w_out, *final_g;
    float* out;
    bf16_t *WinT, *WoutT, *XB, *U, *Y;
    float *SSQ, *PS, *HS, *UF, *LA, *LB;
};

namespace pg8 {
#define PG8_LAS __attribute__((address_space(3)))
typedef unsigned short bf16_t;
typedef short bf16x8 __attribute__((ext_vector_type(8)));
typedef float f32x4 __attribute__((ext_vector_type(4)));
typedef unsigned u32x4 __attribute__((ext_vector_type(4)));
constexpr int BM = 256, BK = 64, HALF = 128, HTB = HALF * BK * 2  , STAGE_BYTES = 8 * HTB, NXCD = 8, WGM = 8;

__host__ __device__ __forceinline__ int lds_byte(int r, int c) { const int st = (r >> 4) * 2 + (c >> 5), rr = r & 15, cc = c & 31, ob = rr * 64 + cc * 2; return st * 1024 + (ob ^ (((ob >> 9) & 1) << 5)); }
__host__ __device__ __forceinline__ void stage_rc(int b, int& R, int& C) { const int st = b / 1024, sb = b % 1024, swz = sb ^ (((sb >> 9) & 1) << 5); R = (st >> 1) * 16 + swz / 64; C = (st & 1) * 32 + (swz % 64) / 2; }
__host__ __device__ __forceinline__ int perm32(int rho) { const int n = rho >> 4, i = rho & 15; return 8 * (i >> 2) + 4 * n + (i & 3); }

struct Unit { int pm, pn; };
struct Gemm { const bf16_t* A; const bf16_t* Bt; int M, N, K; };

struct StaticOrder {
    int nM, nN, nwg, G, c;
    __host__ __device__ void init(int M, int N, int G_, int c_) { nM = M / BM; nN = N / BM; nwg = nM * nN; G = G_; c = c_; }
    __host__ __device__ bool next(int i, Unit& u) const {
        const long L = (long)i * G + c; if (L >= nwg) return false;
        int wgid = (int)L; { const int q = nwg / NXCD, r = nwg % NXCD, xcd = wgid % NXCD, off = wgid / NXCD; wgid = (xcd < r ? xcd * (q + 1) : r * (q + 1) + (xcd - r) * q) + off; }
        const int nig = WGM * nN, gid = wgid / nig, fm = gid * WGM, gsz = (nM - fm) < WGM ? (nM - fm) : WGM;
        u.pm = fm + ((wgid % nig) % gsz); u.pn = (wgid % nig) / gsz; return true;
    }
    __device__ __forceinline__ void a_ready(const Unit&, int) const {}
    __device__ __forceinline__ void done(const Unit&) const {}
};


__device__ __forceinline__ unsigned cvt_pk_bf16(float lo, float hi) { unsigned r; asm volatile("v_cvt_pk_bf16_f32 %0, %1, %2" : "=v"(r) : "v"(lo), "v"(hi)); return r; }
__device__ __forceinline__ float fsigm(float x) { return __builtin_amdgcn_rcpf(1.f + __builtin_amdgcn_exp2f(x * -1.44269504089f)); }
constexpr int RTAB_OFF = STAGE_BYTES;

struct OrderRstd : StaticOrder {
    const float* ssq; PG8_LAS float* rtab;
    __device__ __forceinline__ void a_ready(const Unit& u, int ui) const {
        int t_ = threadIdx.x; asm volatile("" : "+v"(t_));
        const int wid = __builtin_amdgcn_readfirstlane(t_ >> 6), lane = t_ & 63, rl = wid * 32 + (lane & 31), half = lane >> 5;
        const float* p = ssq + (size_t)(half * 16) * 8192 + u.pm * BM + rl; float s = 0.f;
#pragma unroll
        for (int q = 0; q < 16; ++q) s += p[(size_t)q * 8192];
        s += __shfl_xor(s, 32);
        if (lane < 32) rtab[(ui & 1) * 256 + rl] = 1.0f / sqrtf(s * (1.0f / 2048.0f) + 1e-6f);
    }
};
struct EpiIn {
    static constexpr bool PERM = true, AFTER_DRAIN = false;
    bf16_t* U; const PG8_LAS float* rtab;
    __device__ __forceinline__ void operator()(const f32x4 (&acc)[2][2][4][2], const Unit& u, int wr, int wc, int fr, int fq, int ui) const {
        const PG8_LAS float* rt = rtab + (ui & 1) * 256 + wr * 64 + fr;
        if (u.pn < 8) {
            bf16_t* base = U + (size_t)(u.pm * BM + wr * 64 + fr) * 4096 + 128 * u.pn + wc * 32 + 8 * fq;
#pragma unroll
            for (int ai = 0; ai < 2; ++ai)
#pragma unroll
                for (int m = 0; m < 4; ++m) { const float rs = rt[ai * HALF + m * 16];
                    const f32x4 v0 = acc[ai][0][m][0] * rs, v1 = acc[ai][0][m][1] * rs, g0 = acc[ai][1][m][0] * rs, g1 = acc[ai][1][m][1] * rs;
                    u32x4 w; w.x = cvt_pk_bf16(v0[0] * fsigm(g0[0]), v0[1] * fsigm(g0[1])); w.y = cvt_pk_bf16(v0[2] * fsigm(g0[2]), v0[3] * fsigm(g0[3]));
                    w.z = cvt_pk_bf16(v1[0] * fsigm(g1[0]), v1[1] * fsigm(g1[1])); w.w = cvt_pk_bf16(v1[2] * fsigm(g1[2]), v1[3] * fsigm(g1[3]));
                    *(u32x4*)(base + (size_t)(ai * HALF + m * 16) * 4096) = w; }
        } else {
            const bool act = (u.pn < 12) || (u.pn >= 16);
            bf16_t* base = U + (size_t)(u.pm * BM + wr * 64 + fr) * 4096 + (256 * u.pn - 1024) + wc * 32 + 8 * fq;
#pragma unroll
            for (int ai = 0; ai < 2; ++ai)
#pragma unroll
                for (int m = 0; m < 4; ++m) { const float rs = rt[ai * HALF + m * 16];
#pragma unroll
                    for (int bj = 0; bj < 2; ++bj) { f32x4 v0 = acc[ai][bj][m][0] * rs, v1 = acc[ai][bj][m][1] * rs;
                        if (act) {
#pragma unroll
                            for (int e = 0; e < 4; ++e) { v0[e] = v0[e] * fsigm(v0[e]); v1[e] = v1[e] * fsigm(v1[e]); } }
                        u32x4 w; w.x = cvt_pk_bf16(v0[0], v0[1]); w.y = cvt_pk_bf16(v0[2], v0[3]); w.z = cvt_pk_bf16(v1[0], v1[1]); w.w = cvt_pk_bf16(v1[2], v1[3]);
                        *(u32x4*)(base + (size_t)(ai * HALF + m * 16) * 4096 + bj * HALF) = w; } }
        }
    }
};
struct EpiOut {
    static constexpr bool PERM = true, AFTER_DRAIN = false;
    const float* xold; float* out; bf16_t* XB; float* ssq;
    __device__ __forceinline__ void operator()(const f32x4 (&acc)[2][2][4][2], const Unit& u, int wr, int wc, int fr, int fq, int) const {
#pragma unroll
        for (int ai = 0; ai < 2; ++ai)
#pragma unroll
            for (int m = 0; m < 4; ++m) { const int row = u.pm * BM + ai * HALF + wr * 64 + m * 16 + fr; const size_t off = (size_t)row * 2048 + u.pn * BM + wc * 32 + 8 * fq; float s = 0.f;
#pragma unroll
                for (int bj = 0; bj < 2; ++bj) { const f32x4 x0 = *(const f32x4*)(xold + off + bj * HALF), x1 = *(const f32x4*)(xold + off + bj * HALF + 4);
                    const f32x4 v0 = x0 + acc[ai][bj][m][0], v1 = x1 + acc[ai][bj][m][1];
                    *(f32x4*)(out + off + bj * HALF) = v0; *(f32x4*)(out + off + bj * HALF + 4) = v1;
                    u32x4 w; w.x = cvt_pk_bf16(v0[0], v0[1]); w.y = cvt_pk_bf16(v0[2], v0[3]); w.z = cvt_pk_bf16(v1[0], v1[1]); w.w = cvt_pk_bf16(v1[2], v1[3]);
                    *(u32x4*)(XB + off + bj * HALF) = w;
                    s += (v0[0] * v0[0] + v0[1] * v0[1]) + (v0[2] * v0[2] + v0[3] * v0[3]) + (v1[0] * v1[0] + v1[1] * v1[1]) + (v1[2] * v1[2] + v1[3] * v1[3]); }
                s += __shfl_xor(s, 16); s += __shfl_xor(s, 32);
                if (fq == 0) ssq[(size_t)(u.pn * 4 + wc) * 8192 + row] = s;
                if (m & 1) asm volatile("" ::: "memory"); }
    }
};

template <class Epi, class Sched, bool ALIGN_EPI = false, bool SP2 = false>
__device__ __forceinline__ void gemm_phase(PG8_LAS unsigned char* lds, const Gemm g, const Sched& S, const Epi& E) {
    int tid_ = threadIdx.x; asm volatile("" : "+v"(tid_));
    const int tid = tid_, wid = __builtin_amdgcn_readfirstlane(tid >> 6), lane = tid & 63, wr = wid >> 2, wc = wid & 3, fr = lane & 15, fq = lane >> 4;
    const int K = g.K, nt = K / BK;
    unsigned voffA[2], voffB[2];
#pragma unroll
    for (int i = 0; i < 2; ++i) { int R, C; stage_rc(tid * 16 + i * 8192, R, C); const int Rb = Epi::PERM ? ((R & ~31) + perm32(R & 31)) : R;
        voffA[i] = (unsigned)(R * K + C) * 2u; voffB[i] = (unsigned)(Rb * K + C) * 2u; }
    const size_t kstep = (size_t)(BK * 2);
    const size_t hstep = (size_t)HALF * K * 2;
    const size_t tstep = 2 * hstep;
    const unsigned ldsw = (unsigned)wid * 1024u;
    const int aoff = lds_byte(wr * 64 + fr, fq * 8), boff = lds_byte(wc * 32 + fr, fq * 8);
#define PG8_SA(b, h) (((b) * 2 + (h)) * HTB)
#define PG8_SB(b, h) ((4 + (b) * 2 + (h)) * HTB)
#define PG8_STAGE(bufoff, gbase, voff) do { _Pragma("unroll") for (int _i = 0; _i < 2; ++_i) \
        __builtin_amdgcn_global_load_lds((const unsigned*)((const char*)(gbase) + (voff)[_i]), (PG8_LAS unsigned*)(lds + (bufoff) + ldsw + _i * 8192), 16, 0, 0); } while (0)
#define PG8_LDA(dst, b, h) do { _Pragma("unroll") for (int m = 0; m < 4; ++m) _Pragma("unroll") for (int k = 0; k < 2; ++k) dst[m][k] = *(const PG8_LAS bf16x8*)(lds + PG8_SA(b, h) + aoff + m * 2048 + k * 1024); } while (0)
#define PG8_LDB(dst, b, h) do { _Pragma("unroll") for (int n = 0; n < 2; ++n) _Pragma("unroll") for (int k = 0; k < 2; ++k) dst[n][k] = *(const PG8_LAS bf16x8*)(lds + PG8_SB(b, h) + boff + n * 2048 + k * 1024); } while (0)
#define PG8_MMA(ai, bj, At, Bt) do { __builtin_amdgcn_s_setprio(1); _Pragma("unroll") for (int m = 0; m < 4; ++m) _Pragma("unroll") for (int n = 0; n < 2; ++n) _Pragma("unroll") for (int k = 0; k < 2; ++k) \
        acc[ai][bj][m][n] = __builtin_amdgcn_mfma_f32_16x16x32_bf16(Bt[n][k], At[m][k], acc[ai][bj][m][n], 0, 0, 0); __builtin_amdgcn_s_setprio(0); } while (0)
#define PG8_WAIT_V(n) asm volatile("s_waitcnt vmcnt(" #n ")" ::: "memory")
#define PG8_WAIT_L(n) asm volatile("s_waitcnt lgkmcnt(" #n ")" ::: "memory")
#define PG8_BAR __builtin_amdgcn_s_barrier()
#define PG8_SCHED __builtin_amdgcn_sched_barrier(0)
    Unit cur, nxt; int ui = 0;
    if (!S.next(0, cur)) return;
    f32x4 acc[2][2][4][2];
#pragma unroll
    for (int a = 0; a < 2; ++a)
#pragma unroll
        for (int b = 0; b < 2; ++b)
#pragma unroll
            for (int m = 0; m < 4; ++m)
#pragma unroll
                for (int n = 0; n < 2; ++n) acc[a][b][m][n] = (f32x4){0.f, 0.f, 0.f, 0.f};
    bf16x8 At[4][2], B0[2][2], B1[2][2];
    const char* cA = (const char*)g.A + (size_t)cur.pm * tstep; const char* cB = (const char*)g.Bt + (size_t)cur.pn * tstep;
    S.a_ready(cur, 0);
    if constexpr (SP2) {
        PG8_STAGE(PG8_SB(0, 0), cB, voffB); PG8_STAGE(PG8_SB(0, 1), cB + hstep, voffB); PG8_STAGE(PG8_SA(0, 0), cA, voffA); PG8_STAGE(PG8_SA(0, 1), cA + hstep, voffA);
        if (wr == 1) PG8_BAR;
        PG8_WAIT_V(2); PG8_BAR;
        PG8_STAGE(PG8_SB(1, 0), cB + kstep, voffB); PG8_STAGE(PG8_SA(1, 0), cA + kstep, voffA); PG8_STAGE(PG8_SB(1, 1), cB + hstep + kstep, voffB);
        PG8_WAIT_V(6); PG8_BAR;
    } else {
        PG8_STAGE(PG8_SB(0, 0), cB, voffB); PG8_STAGE(PG8_SA(0, 0), cA, voffA); PG8_STAGE(PG8_SB(0, 1), cB + hstep, voffB); PG8_STAGE(PG8_SA(0, 1), cA + hstep, voffA);
        if (wr == 1) PG8_BAR;
        PG8_WAIT_V(4); PG8_BAR;
        PG8_STAGE(PG8_SB(1, 0), cB + kstep, voffB); PG8_STAGE(PG8_SA(1, 0), cA + kstep, voffA); PG8_STAGE(PG8_SB(1, 1), cB + hstep + kstep, voffB);
        PG8_WAIT_V(6); PG8_BAR;
    }
    for (;;) {
        const bool has_next = S.next(ui + 1, nxt);
        const char* nA = has_next ? (const char*)g.A + (size_t)nxt.pm * tstep : cA; const char* nB = has_next ? (const char*)g.Bt + (size_t)nxt.pn * tstep : cB;
        for (int t = 0; t < nt; t += 2) {
            const bool last = (t == nt - 2);
            const char* a1 = cA + (size_t)(t + 1) * kstep;
            const char* a2 = last ? nA : cA + (size_t)(t + 2) * kstep; const char* b2 = last ? nB : cB + (size_t)(t + 2) * kstep;
            const char* a3 = a2 + kstep; const char* b3 = b2 + kstep;
            if (last && has_next) S.a_ready(nxt, ui + 1);
            if constexpr (SP2) {
            PG8_LDB(B0, 0, 0); PG8_LDB(B1, 0, 1); PG8_SCHED; PG8_LDA(At, 0, 0); PG8_STAGE(PG8_SA(1, 1), a1 + hstep, voffA);
            PG8_WAIT_V(8); PG8_WAIT_L(0); PG8_BAR; PG8_MMA(0, 0, At, B0); PG8_MMA(0, 1, At, B1); PG8_BAR; PG8_SCHED;
            PG8_LDA(At, 0, 1); PG8_STAGE(PG8_SB(0, 0), b2, voffB); PG8_STAGE(PG8_SB(0, 1), b2 + hstep, voffB); PG8_STAGE(PG8_SA(0, 0), a2, voffA);
            PG8_WAIT_V(8); PG8_WAIT_L(0); PG8_BAR; PG8_MMA(1, 0, At, B0); PG8_MMA(1, 1, At, B1); PG8_BAR; PG8_SCHED;
            PG8_LDB(B0, 1, 0); PG8_LDB(B1, 1, 1); PG8_SCHED; PG8_LDA(At, 1, 0); PG8_STAGE(PG8_SA(0, 1), a2 + hstep, voffA);
            PG8_WAIT_V(8); PG8_WAIT_L(0); PG8_BAR; PG8_MMA(0, 0, At, B0); PG8_MMA(0, 1, At, B1); PG8_BAR; PG8_SCHED;
            PG8_LDA(At, 1, 1); PG8_STAGE(PG8_SB(1, 0), b3, voffB); PG8_STAGE(PG8_SB(1, 1), b3 + hstep, voffB); PG8_STAGE(PG8_SA(1, 0), a3, voffA);
            PG8_WAIT_V(8); PG8_WAIT_L(0); PG8_BAR; PG8_MMA(1, 0, At, B0); PG8_MMA(1, 1, At, B1); PG8_BAR; PG8_SCHED;
            } else {
            PG8_LDB(B0, 0, 0); PG8_SCHED; PG8_LDA(At, 0, 0); PG8_STAGE(PG8_SA(1, 1), a1 + hstep, voffA);
            PG8_WAIT_L(8); PG8_BAR; PG8_WAIT_L(0); PG8_MMA(0, 0, At, B0); PG8_BAR; PG8_SCHED;
            PG8_LDB(B1, 0, 1); PG8_STAGE(PG8_SB(0, 0), b2, voffB);
            PG8_BAR; PG8_WAIT_L(0); PG8_MMA(0, 1, At, B1); PG8_BAR;
            PG8_LDA(At, 0, 1); PG8_STAGE(PG8_SA(0, 0), a2, voffA);
            PG8_BAR; PG8_WAIT_L(0); PG8_MMA(1, 0, At, B0); PG8_BAR; PG8_SCHED;
            PG8_STAGE(PG8_SB(0, 1), b2 + hstep, voffB);
            PG8_WAIT_V(6); PG8_BAR; PG8_MMA(1, 1, At, B1); PG8_BAR;
            PG8_LDB(B0, 1, 0); PG8_SCHED; PG8_LDA(At, 1, 0); PG8_STAGE(PG8_SA(0, 1), a2 + hstep, voffA);
            PG8_WAIT_L(8); PG8_BAR; PG8_WAIT_L(0); PG8_MMA(0, 0, At, B0); PG8_BAR; PG8_SCHED;
            PG8_LDB(B1, 1, 1); PG8_STAGE(PG8_SB(1, 0), b3, voffB);
            PG8_BAR; PG8_WAIT_L(0); PG8_MMA(0, 1, At, B1); PG8_BAR;
            PG8_LDA(At, 1, 1); PG8_STAGE(PG8_SA(1, 0), a3, voffA);
            PG8_BAR; PG8_WAIT_L(0); PG8_MMA(1, 0, At, B0); PG8_BAR; PG8_SCHED;
            PG8_STAGE(PG8_SB(1, 1), b3 + hstep, voffB);
            PG8_WAIT_V(6); PG8_BAR; PG8_MMA(1, 1, At, B1); PG8_BAR;
            }
        }
        if constexpr (ALIGN_EPI) { if (wr == 0) PG8_BAR; }
        if constexpr (!Epi::AFTER_DRAIN) { E(acc, cur, wr, wc, fr, fq, ui); S.done(cur); }
        if (!has_next) break;
#pragma unroll
        for (int a = 0; a < 2; ++a)
#pragma unroll
            for (int b = 0; b < 2; ++b)
#pragma unroll
                for (int m = 0; m < 4; ++m)
#pragma unroll
                    for (int n = 0; n < 2; ++n) acc[a][b][m][n] = (f32x4){0.f, 0.f, 0.f, 0.f};
        cur = nxt; cA = nA; cB = nB; ++ui;
        if constexpr (ALIGN_EPI) { if (wr == 1) PG8_BAR; }
    }
    PG8_WAIT_V(0);
    if constexpr (!ALIGN_EPI) { if (wr == 0) PG8_BAR; }
    PG8_BAR;
    if constexpr (Epi::AFTER_DRAIN) { E.fused(acc, cur, wr, wc, fr, fq, lds, wid, lane); S.done(cur); }
#undef PG8_SA
#undef PG8_SB
#undef PG8_STAGE
#undef PG8_LDA
#undef PG8_LDB
#undef PG8_MMA
#undef PG8_WAIT_V
#undef PG8_WAIT_L
#undef PG8_BAR
#undef PG8_SCHED
}
}

#define PHASE_TID(F) do { int _t = threadIdx.x; asm volatile("" : "+v"(_t)); (F).tid = _t; (F).lane = _t & 63; (F).wave = __builtin_amdgcn_readfirstlane(_t >> 6); } while (0)
__device__ __forceinline__ void transpose_item(const float* W, int K, int N, bf16_t* WT, int dst_row0, int src_col0, const float* gk, LAS float* scr, int k0, int lane) {
#pragma unroll 8
    for (int i = 0; i < 32; ++i) { const int kk = 2 * i + (lane >> 5); float v = W[(size_t)(k0 + kk) * N + src_col0 + (lane & 31)]; if (gk) v *= gk[k0 + kk]; scr[kk * 33 + (lane & 31)] = v; }
    asm volatile("s_waitcnt lgkmcnt(0)" ::: "memory");
    const int c = lane & 7;
#pragma unroll
    for (int j = 0; j < 4; ++j) { const int n = (lane >> 3) + 8 * j; const LAS float* s = scr + (8 * c) * 33 + n;
        u32x4 o; o.x = pk2(s[0 * 33], s[1 * 33]); o.y = pk2(s[2 * 33], s[3 * 33]); o.z = pk2(s[4 * 33], s[5 * 33]); o.w = pk2(s[6 * 33], s[7 * 33]);
        *(u32x4*)(WT + (size_t)(dst_row0 + n) * K + k0 + 8 * c) = o; }
    asm volatile("s_waitcnt lgkmcnt(0)" ::: "memory");
}
__device__ __forceinline__ void p_prologue(Frame& F) {
    PHASE_TID(F);
    LAS float* scr = (LAS float*)(F.lds + F.wave * 16384);
    const int gw = F.bid * NWAVES + F.wave, NGW = F.G * NWAVES;
    constexpr int I_IN = (D / 64) * (DIN / 32), I_OUT = (D / 64) * (D / 32), I_L = I_IN + I_OUT;
    for (int it = gw; it < DEPTH * I_L; it += NGW) {
        const int l = it / I_L; int r = it % I_L;
        if (r < I_IN) { const int kb = r / (DIN / 32), nb = r % (DIN / 32);
            transpose_item(F.w_in + (size_t)l * D * DIN, D, DIN, F.WinT + (size_t)l * DIN * D, 32 * nb, src_col(32 * nb), F.norm_g + l * D, scr, 64 * kb, F.lane);
        } else { r -= I_IN; const int kb = r / (D / 32), nb = r % (D / 32);
            transpose_item(F.w_out + (size_t)l * D * D, D, D, F.WoutT + (size_t)l * D * D, 32 * nb, 32 * nb, nullptr, scr, 64 * kb, F.lane); }
    }
    for (int m = gw; m < S; m += NGW) {
        const f32x4* xr = (const f32x4*)(F.x + (size_t)m * D) + F.lane; u32x2* ob = (u32x2*)(F.XB + (size_t)m * D) + F.lane; float s = 0.f;
#pragma unroll
        for (int j = 0; j < 8; ++j) { const f32x4 v = xr[64 * j]; s += (v.x * v.x + v.y * v.y) + (v.z * v.z + v.w * v.w); u32x2 w; w.x = pk2(v.x, v.y); w.y = pk2(v.z, v.w); ob[64 * j] = w; }
        s = wave_sum(s);
        if (F.lane < 32) F.SSQ[F.lane * S + m] = F.lane == 0 ? s : 0.f;
    }
}

template <int NV> __device__ __forceinline__ void block_sum(float (&v)[NV], LAS float* red  , int wave, int lane) {
#pragma unroll
    for (int i = 0; i < NV; ++i) { const float s = wave_sum(v[i]); if (lane == 0) red[i * 8 + wave] = s; }
    __syncthreads();
#pragma unroll
    for (int i = 0; i < NV; ++i) { const LAS f32x4* p = (const LAS f32x4*)(red + i * 8); const f32x4 a = p[0], b = p[1]; v[i] = ((a.x + a.y) + (a.z + a.w)) + ((b.x + b.y) + (b.z + b.w)); }
    __syncthreads();
}
constexpr int CT = 16;
__device__ __forceinline__ void conv_item(Frame& F, int l, int item) {
    LAS unsigned char* cs = F.lds;
    LAS float* red = (LAS float*)(F.lds + 62 * 2048);
    const int t0 = item * 32, c0 = 2 * F.tid;
    for (int q = F.tid; q < 62 * 128; q += NTHREADS) { const int row = q >> 7, c16 = q & 127, s = t0 - 30 + row; u32x4 v = (u32x4){0u, 0u, 0u, 0u};
        if (s >= 0) v = *(const u32x4*)(F.U + (size_t)s * UW + c16 * 8);
        *(LAS u32x4*)(cs + row * 2048 + c16 * 16) = v; }
    __syncthreads();
    float w0[31], w1[31];
    const auto rw = MAKE_RSRC(F.cdw_w + (size_t)l * CW * DC, CW * DC * 4);
#pragma unroll
    for (int j = 0; j < 31; ++j) { const f32x2 t = __builtin_bit_cast(f32x2, __builtin_amdgcn_raw_buffer_load_b64(rw, c0 * 4, (30 - j) * DC * 4, 0)); w0[j] = t.x; w1[j] = t.y; }
    const f32x2 bias = *(const f32x2*)(F.cdw_b + l * DC + c0);
    const f32x2 lg = *(const f32x2*)(F.cln_g + l * DC + c0), lb = *(const f32x2*)(F.cln_b + l * DC + c0);
    const auto ru = MAKE_RSRC(F.U, (size_t)S * UW * 2); const auto ry = MAKE_RSRC(F.Y, (size_t)S * D * 2);
#pragma unroll 1
    for (int hb = 0; hb < 32 / CT; ++hb) {
        float a0[CT], a1[CT];
#pragma unroll
        for (int i = 0; i < CT; ++i) { a0[i] = bias.x; a1[i] = bias.y; }
        const LAS unsigned char* cp = cs + (hb * CT) * 2048 + F.tid * 4;
#pragma unroll
        for (int si = 0; si < CT + 30; ++si) {
            const unsigned cw = *(const LAS unsigned*)(cp + si * 2048);
            const float x0 = bflo(cw), x1 = bfhi(cw);
#pragma unroll
            for (int i = 0; i < CT; ++i) { const int j = i + 30 - si; if (j >= 0 && j <= 30) { a0[i] += w0[j] * x0; a1[i] += w1[j] * x1; } }
        }
        float sv[CT];
#pragma unroll
        for (int i = 0; i < CT; ++i) sv[i] = a0[i] + a1[i];
        block_sum<CT>(sv, red, F.wave, F.lane);
#pragma unroll
        for (int i = 0; i < CT; ++i) { const float mean = sv[i] * (1.f / DC); a0[i] -= mean; a1[i] -= mean; sv[i] = a0[i] * a0[i] + a1[i] * a1[i]; }
        block_sum<CT>(sv, red, F.wave, F.lane);
#pragma unroll
        for (int i = 0; i < CT; ++i) {
            const int t = t0 + hb * CT + i;
            const float rstd = 1.f / sqrtf(sv[i] * (1.f / DC) + LN_EPS);
            const unsigned zw = __builtin_amdgcn_raw_buffer_load_b32(ru, (1024 + c0) * 2, t * (UW * 2), 0);
            const float y0 = siluf(a0[i] * rstd * lg.x + lb.x) * bflo(zw), y1 = siluf(a1[i] * rstd * lg.y + lb.y) * bfhi(zw);
            __builtin_amdgcn_raw_buffer_store_b32(pk2(y0, y1), ry, c0 * 2, t * (D * 2), 0);
        }
    }
    __syncthreads();
}
__device__ __forceinline__ void lru_ab_item(Frame& F, int l, int item) {
    LAS float* xcs = (LAS float*)F.lds;
    const int cidx = item >> 3, h = item & 7, t0 = cidx * SCH, ch0 = h * HD;
    {
        const int t = F.tid >> 3, cb = (F.tid & 7) * 16;
        const float* cwp = F.lcw + (size_t)l * LW * DL + ch0 + cb; const float* cbp = F.lcb + l * DL + ch0 + cb;
        float acc[16];
#pragma unroll
        for (int e = 0; e < 16; ++e) acc[e] = cbp[e];
#pragma unroll
        for (int k = 0; k < 4; ++k) { const int s = t0 + t - 3 + k;
            if (s >= 0) { const u32x4* up = (const u32x4*)(F.U + (size_t)s * UW + 2048 + ch0 + cb); const u32x4 q0 = up[0], q1 = up[1];
                const unsigned qq[8] = {q0.x, q0.y, q0.z, q0.w, q1.x, q1.y, q1.z, q1.w};
#pragma unroll
                for (int e = 0; e < 8; ++e) { acc[2 * e] += cwp[(size_t)k * DL + 2 * e] * bflo(qq[e]); acc[2 * e + 1] += cwp[(size_t)k * DL + 2 * e + 1] * bfhi(qq[e]); } } }
#pragma unroll
        for (int e = 0; e < 16; ++e) xcs[t * 128 + cb + e] = acc[e];
    }
    __syncthreads();
    const int ch = F.tid & 127, tg = F.tid >> 7;
    const float* wap = F.wa + ((size_t)(l * NHEAD + h) * HD) * HD + ch; const float* wxp = F.wx + ((size_t)(l * NHEAD + h) * HD) * HD + ch;
    float ar[16], ai[16];
#pragma unroll
    for (int i = 0; i < 16; ++i) { ar[i] = 0.f; ai[i] = 0.f; }
#pragma unroll 2
    for (int k = 0; k < HD; ++k) { const float war = wap[(size_t)k * HD], wxr = wxp[(size_t)k * HD];
#pragma unroll
        for (int i = 0; i < 16; ++i) { const float xv = xcs[(tg * 16 + i) * 128 + k]; ar[i] += xv * war; ai[i] += xv * wxr; } }
    const int gch = ch0 + ch;
    const float bar_ = F.ba[l * DL + gch], bxr = F.bx[l * DL + gch], c8 = 8.f * log_sigmoid(F.lam[l * DL + gch]);
#pragma unroll
    for (int i = 0; i < 16; ++i) { const int t = tg * 16 + i;
        const float r = sigm(ar[i] + bar_), ig = sigm(ai[i] + bxr), la = c8 * r, a = __expf(la), mult = sqrtf(neg_expm1(2.f * la));
        F.LA[(size_t)(t0 + t) * DL + gch] = a; F.LB[(size_t)(t0 + t) * DL + gch] = mult * (ig * xcs[t * 128 + ch]); }
    __syncthreads();
}
__device__ __forceinline__ void p_mix1(Frame& F, int l) {
    PHASE_TID(F);
    constexpr int NCONV = S / 32, NLRU = NSCH * NHEAD;
    for (int it = F.bid; it < NCONV; it += F.G) { PHASE_TID(F); conv_item(F, l, it); }
    for (int it = F.bid; it < NLRU; it += F.G) { PHASE_TID(F); lru_ab_item(F, l, it); }
}
__device__ __forceinline__ void p_scan1(Frame& F) {
    PHASE_TID(F);
    for (int it = F.bid; it < NSCH * 2; it += F.G) { const int cidx = it >> 1, ch = (it & 1) * 512 + F.tid, t0 = cidx * SCH; float P = 1.f, H = 0.f;
#pragma unroll 8
        for (int i = 0; i < SCH; ++i) { const float a = F.LA[(size_t)(t0 + i) * DL + ch], b = F.LB[(size_t)(t0 + i) * DL + ch]; H = a * H + b; P *= a; }
        F.PS[cidx * DL + ch] = P; F.HS[cidx * DL + ch] = H; }
}
__device__ __forceinline__ void p_scan2(Frame& F) {
    PHASE_TID(F);
    for (int it = F.bid; it < NSCH * 2; it += F.G) { const int cidx = it >> 1, ch = (it & 1) * 512 + F.tid, t0 = cidx * SCH; float H = 0.f;
        for (int c = 0; c < cidx; ++c) H = F.PS[c * DL + ch] * H + F.HS[c * DL + ch];
#pragma unroll 8
        for (int i = 0; i < SCH; ++i) { const float a = F.LA[(size_t)(t0 + i) * DL + ch], b = F.LB[(size_t)(t0 + i) * DL + ch]; H = a * H + b;
            const float z = bf2f(F.U[(size_t)(t0 + i) * UW + 3072 + ch]); F.Y[(size_t)(t0 + i) * D + DC + ch] = (bf16_t)f2bf(H * z); } }
}
__device__ __forceinline__ void p_final(Frame& F) {
    PHASE_TID(F);
    const int gw = F.bid * NWAVES + F.wave, NGW = F.G * NWAVES;
    for (int m = gw; m < S; m += NGW) {
        float ss = 0.f;
#pragma unroll
        for (int p = 0; p < 32; ++p) ss += F.SSQ[p * S + m];
        const float rstd = 1.f / sqrtf(ss * (1.f / D) + RMS_EPS);
        f32x4* orow = (f32x4*)(F.out + (size_t)m * D) + F.lane; const f32x4* gr = (const f32x4*)F.final_g + F.lane;
#pragma unroll
        for (int j = 0; j < 8; ++j) orow[64 * j] = orow[64 * j] * rstd * gr[64 * j];
    }
}

constexpr int PH_PER_LAYER = 5, NPH = 1 + DEPTH * PH_PER_LAYER + 1;
struct Args { const float* in[16]; float* out; unsigned char* ws; int ph_lo, ph_hi; };
__global__ void __launch_bounds__(NTHREADS, 2) mk_fwd(Args a) {
    extern __shared__ __attribute__((aligned(16))) unsigned char lds_raw[];
    Frame F;
    F.lds = (LAS unsigned char*)lds_raw;
    F.tid = threadIdx.x; F.lane = F.tid & 63; F.wave = __builtin_amdgcn_readfirstlane(F.tid >> 6); F.bid = blockIdx.x; F.G = gridDim.x;
    F.x = a.in[0]; F.norm_g = a.in[1]; F.w_in = a.in[2]; F.cdw_w = a.in[3]; F.cdw_b = a.in[4]; F.cln_g = a.in[5]; F.cln_b = a.in[6]; F.lcw = a.in[7]; F.lcb = a.in[8];
    F.wa = a.in[9]; F.ba = a.in[10]; F.wx = a.in[11]; F.bx = a.in[12]; F.lam = a.in[13]; F.w_out = a.in[14]; F.final_g = a.in[15]; F.out = a.out;
    unsigned char* ws = a.ws;
    F.WinT = (bf16_t*)(ws + WS_WINT); F.WoutT = (bf16_t*)(ws + WS_WOUTT); F.XB = (bf16_t*)(ws + WS_XB); F.U = (bf16_t*)(ws + WS_U); F.Y = (bf16_t*)(ws + WS_Y);
    F.SSQ = (float*)(ws + WS_SSQ); F.PS = (float*)(ws + WS_PS); F.HS = (float*)(ws + WS_HS); F.UF = (float*)(ws + WS_UF); F.LA = (float*)(ws + WS_LA); F.LB = (float*)(ws + WS_LB);
    volatile LAS unsigned* bst = (volatile LAS unsigned*)(F.lds + LDS_BYTES - 64);
    if (F.tid < 16) bst[F.tid] = 0u;
    __syncthreads();
    XcdBarrier bar; bar.bar = (unsigned*)(ws + WS_CTL) + 4096; bar.x = 0; bar.st = bst;
    if (MK_ONE_LAUNCH) bar = xcd_barrier_post((unsigned*)(ws + WS_CTL) + 4096, bst);
    for (int ph = a.ph_lo; ph < a.ph_hi; ++ph) {
        if (ph == 0) p_prologue(F);
        else if (ph == NPH - 1) p_final(F);
        else { const int l = (ph - 1) / PH_PER_LAYER, j = (ph - 1) % PH_PER_LAYER;
            if (j == 0) { pg8::Gemm g{F.XB, F.WinT + (size_t)l * DIN * D, S, DIN, D}; pg8::OrderRstd Sd; Sd.init(S, DIN, F.G, F.bid); Sd.ssq = F.SSQ; Sd.rtab = (LAS float*)(F.lds + pg8::RTAB_OFF);
                pg8::EpiIn E{F.U, (const LAS float*)(F.lds + pg8::RTAB_OFF)};
                pg8::gemm_phase<pg8::EpiIn, pg8::OrderRstd, true, true>(F.lds, g, Sd, E); }
            else if (j == 1) p_mix1(F, l);
            else if (j == 2) p_scan1(F);
            else if (j == 3) p_scan2(F);
            else { pg8::Gemm g{F.Y, F.WoutT + (size_t)l * D * D, S, D, D}; pg8::StaticOrder Sd; Sd.init(S, D, F.G, F.bid);
                pg8::EpiOut E{l == 0 ? F.x : F.out, F.out, F.XB, F.SSQ};
                pg8::gemm_phase<pg8::EpiOut, pg8::StaticOrder, true, true>(F.lds, g, Sd, E); }
        }
        if (ph + 1 < a.ph_hi) xcd_barrier(bar);
    }
}

extern "C" void kernel_launch(void* const* d_in, const int* in_sizes, int n_in, void* d_out, int out_size, void* d_ws, size_t ws_size, hipStream_t stream) {
    static int grid = 0;
    if (grid == 0) {
        if (n_in != 16 || in_sizes[0] != S * D || out_size != S * D || ws_size < WS_END) { fprintf(stderr, "kernel_launch: unexpected shapes (n_in %d, in0 %d, out %d, ws %zu)\n", n_in, n_in > 0 ? in_sizes[0] : -1, out_size, ws_size); grid = -1; return; }
        int dev = 0, cus = 0, per_cu = 0;
        if (hipGetDevice(&dev) != hipSuccess || hipDeviceGetAttribute(&cus, hipDeviceAttributeMultiprocessorCount, dev) != hipSuccess) { grid = -1; return; }
        if (hipFuncSetAttribute((const void*)mk_fwd, hipFuncAttributeMaxDynamicSharedMemorySize, LDS_BYTES) != hipSuccess) { fprintf(stderr, "kernel_launch: hipFuncSetAttribute failed\n"); grid = -1; return; }
        if (hipOccupancyMaxActiveBlocksPerMultiprocessor(&per_cu, (const void*)mk_fwd, NTHREADS, LDS_BYTES) != hipSuccess || per_cu < 1) fprintf(stderr, "kernel_launch: occupancy query says %d per CU\n", per_cu);
        (void)hipGetLastError();
        grid = cus;
    }
    if (grid < 0) return;
    (void)hipMemsetAsync((char*)d_ws + WS_CTL, 0, CTL_ZERO_BYTES, stream);
    Args a{};
    for (int i = 0; i < 16; ++i) a.in[i] = (const float*)d_in[i];
    a.out = (float*)d_out; a.ws = (unsigned char*)d_ws;
#if MK_ONE_LAUNCH
    a.ph_lo = 0; a.ph_hi = NPH;
    hipLaunchKernelGGL(mk_fwd, dim3(grid), dim3(NTHREADS), LDS_BYTES, stream, a);
#else
    for (int ph = 0; ph < NPH; ++ph) { a.ph_lo = ph; a.ph_hi = ph + 1; hipLaunchKernelGGL(mk_fwd, dim3(grid), dim3(NTHREADS), LDS_BYTES, stream, a); }
#endif
}
```

```cpp
#include <hip/hip_runtime.h>
#include <cstdio>
#include <cstdint>

#ifndef MK_ONE_LAUNCH
#define MK_ONE_LAUNCH 1
#endif

#define LAS __attribute__((address_space(3)))
#define GAS __attribute__((address_space(1)))
typedef unsigned short bf16_t;
typedef short bf16x8 __attribute__((ext_vector_type(8)));
typedef float f32x4 __attribute__((ext_vector_type(4)));
typedef float f32x2 __attribute__((ext_vector_type(2)));
typedef unsigned u32x4 __attribute__((ext_vector_type(4)));
typedef unsigned u32x2 __attribute__((ext_vector_type(2)));

constexpr int S = 8192, D = 2048, DEPTH = 4, DC = 1024, DL = 1024, DIN = 5120, NHEAD = 8, HD = 128, CW = 31, LW = 4;
constexpr int UW = 4096;
constexpr float RMS_EPS = 1e-6f, LN_EPS = 1e-5f;
constexpr int NTHREADS = 512, NWAVES = 8;
constexpr int LDS_BYTES = 147456;
constexpr int LCH = 256, NLCH = S / LCH;
constexpr int XROW = 272;
constexpr int CW_BAR = 4096, CW_LRU = 16384;

constexpr size_t MiB = 1u << 20;
constexpr size_t WS_CTL = 0, CTL_ZERO_BYTES = 1 * MiB;
constexpr size_t WS_WINT = 2 * MiB;
constexpr size_t WS_WOUTT = 82 * MiB;
constexpr size_t WS_XB = 114 * MiB;
constexpr size_t WS_U = 146 * MiB;
constexpr size_t WS_Y = 210 * MiB;
constexpr size_t WS_SSQ = 242 * MiB;
constexpr size_t WS_SUM = 243 * MiB;
constexpr size_t WS_WG = 244 * MiB;
constexpr size_t WS_END = 246 * MiB;

#define MAKE_RSRC(p, bytes) __builtin_amdgcn_make_buffer_rsrc((void*)(p), 0, (int)(bytes), 0x00020000)
__device__ __forceinline__ unsigned f2bf(float f) { unsigned u = __builtin_bit_cast(unsigned, f); return (u + 0x7fffu + ((u >> 16) & 1u)) >> 16; }
__device__ __forceinline__ unsigned pk2(float lo, float hi) { return f2bf(lo) | (f2bf(hi) << 16); }
__device__ __forceinline__ float bflo(unsigned w) { return __builtin_bit_cast(float, w << 16); }
__device__ __forceinline__ float bfhi(unsigned w) { return __builtin_bit_cast(float, w & 0xffff0000u); }
__device__ __forceinline__ float u2f(unsigned u) { return __builtin_bit_cast(float, u); }
__device__ __forceinline__ float bf2f(bf16_t b) { return __builtin_bit_cast(float, (unsigned)b << 16); }
__device__ __forceinline__ float sigm(float x) { return 1.f / (1.f + __expf(-x)); }
__device__ __forceinline__ float siluf(float x) { return x * sigm(x); }
__device__ __forceinline__ float wave_sum(float v) {
#pragma unroll
    for (int o = 1; o < 64; o <<= 1) v += __shfl_xor(v, o);
    return v;
}
__device__ __forceinline__ float neg_expm1(float x) {
    if (x > -0.35f) { float p = 1.f + x * (1.f / 8.f); p = 1.f + x * (1.f / 7.f) * p; p = 1.f + x * (1.f / 6.f) * p; p = 1.f + x * (1.f / 5.f) * p; p = 1.f + x * 0.25f * p; p = 1.f + x * (1.f / 3.f) * p; p = 1.f + x * 0.5f * p; return -x * p; }
    return 1.f - __expf(x);
}
__device__ __forceinline__ float log_sigmoid(float x) { return fminf(x, 0.f) - log1pf(expf(-fabsf(x))); }
__host__ __device__ __forceinline__ int src_col(int np) { if (np < 2048) { const int p = np >> 8, j = np & 255; return j < 128 ? 128 * p + j : 1024 + 128 * p + (j - 128); } return np; }

#define XB_TMO      128
#define XB_XCNT(j)  (256  + 64 * (j))
#define XB_XSUB(j)  (1280 + 64 * (j))
#define XB_XGEN(j)  (2304 + 64 * (j))
#define XB_TOP      3328
#define XB_TOPGEN   3392
#define XCD_BAR_WORDS 3456
#define XB_SPIN_CAP (1u << 18)
__device__ __forceinline__ unsigned xb_ld(unsigned* p)              { return __hip_atomic_load(p, __ATOMIC_RELAXED, __HIP_MEMORY_SCOPE_AGENT); }
__device__ __forceinline__ unsigned xb_add(unsigned* p, unsigned v) { return __hip_atomic_fetch_add(p, v, __ATOMIC_RELAXED, __HIP_MEMORY_SCOPE_AGENT); }
__device__ __forceinline__ unsigned xb_xcc_id() { return (unsigned)__builtin_amdgcn_s_getreg((3 << 11) | 20) & 0xFu; }
#define XB_SPIN(cond, bar) do { unsigned _sp = 0; while (cond) { __builtin_amdgcn_s_sleep(1); \
    if ((++_sp & 255u) == 0u) { if (xb_ld(&(bar)[XB_TMO])) break; if (_sp > XB_SPIN_CAP) { atomicAdd(&(bar)[XB_TMO], 1u); break; } } } } while (0)
struct XcdBarrier { unsigned* bar; unsigned x; volatile LAS unsigned* st; };
__device__ __forceinline__ XcdBarrier xcd_barrier_post(unsigned* bar, volatile LAS unsigned* st) {
    XcdBarrier b; b.bar = bar; b.x = xb_xcc_id(); b.st = st;
    if (threadIdx.x == 0) (void)xb_add(&bar[XB_XCNT(b.x)], 1u);
    return b;
}
__device__ __forceinline__ void xcd_barrier_complete(unsigned* bar, unsigned x, unsigned& nloc, unsigned& nx) {
    const unsigned G = gridDim.x * gridDim.y * gridDim.z;
    unsigned sum, cnt, mine, sp = 0u;
    for (;;) {
        sum = 0u; cnt = 0u; mine = 0u;
#pragma unroll
        for (unsigned j = 0; j < 16; ++j) { const unsigned c = xb_ld(&bar[XB_XCNT(j)]); sum += c; cnt += (c > 0u) ? 1u : 0u; mine = (j == x) ? c : mine; }
        if (sum == G) break;
        __builtin_amdgcn_s_sleep(1);
        if ((++sp & 255u) == 0u) { if (xb_ld(&bar[XB_TMO])) break; if (sp > XB_SPIN_CAP) { atomicAdd(&bar[XB_TMO], 1u); break; } }
    }
    nloc = mine > 0u ? mine : 1u; nx = cnt > 0u ? cnt : 1u;
}
__device__ __forceinline__ void xcd_barrier(const XcdBarrier& b) {
    asm volatile("s_waitcnt vmcnt(0)" ::: "memory");
    __syncthreads();
    if (threadIdx.x == 0) {
        unsigned* bar = b.bar;
        __builtin_amdgcn_s_waitcnt(0);
        unsigned nloc = b.st[0], nx = b.st[1];
        if (nloc == 0u) { xcd_barrier_complete(bar, b.x, nloc, nx); b.st[0] = nloc; b.st[1] = nx; }
        const unsigned old = xb_add(&bar[XB_XSUB(b.x)], 1u);
        const unsigned gen = old / nloc;
        if (old + 1u == (gen + 1u) * nloc) {
            __builtin_amdgcn_fence(__ATOMIC_RELEASE, "agent");
            asm volatile("s_waitcnt vmcnt(0)" ::: "memory");
            const unsigned og = xb_add(&bar[XB_TOP], 1u);
            const unsigned tg = og / nx;
            if (og + 1u == (tg + 1u) * nx) xb_add(&bar[XB_TOPGEN], 1u);
            else XB_SPIN(xb_ld(&bar[XB_TOPGEN]) == tg, bar);
            __builtin_amdgcn_fence(__ATOMIC_ACQUIRE, "agent");
            xb_add(&bar[XB_XGEN(b.x)], 1u);
            asm volatile("s_waitcnt vmcnt(0)" ::: "memory");
        } else {
            XB_SPIN(xb_ld(&bar[XB_XGEN(b.x)]) == gen, bar);
            __builtin_amdgcn_fence(__ATOMIC_ACQUIRE, "agent");
            asm volatile("s_waitcnt vmcnt(0)" ::: "memory");
        }
    }
    __syncthreads();
}

struct Frame {
    LAS unsigned char* lds;
    int tid, lane, wave, bid, G;
    const float *x, *norm_g, *w_in, *cdw_w, *cdw_b, *cln_g, *cln_b, *lcw, *lcb, *wa, *ba, *wx, *bx, *lam, *w_out, *final_g;
    float* out;
    bf16_t *WinT, *WoutT, *XB, *U, *Y;
    float *SSQ; unsigned long long* SUM; bf16_t* WgT; unsigned* ctl;
};

namespace pg8 {
#define PG8_LAS __attribute__((address_space(3)))
typedef unsigned short bf16_t;
typedef short bf16x8 __attribute__((ext_vector_type(8)));
typedef float f32x4 __attribute__((ext_vector_type(4)));
typedef unsigned u32x4 __attribute__((ext_vector_type(4)));
constexpr int BM = 256, BK = 64, HALF = 128, HTB = HALF * BK * 2  , STAGE_BYTES = 8 * HTB, NXCD = 8, WGM = 8;

__host__ __device__ __forceinline__ int lds_byte(int r, int c) { const int st = (r >> 4) * 2 + (c >> 5), rr = r & 15, cc = c & 31, ob = rr * 64 + cc * 2; return st * 1024 + (ob ^ (((ob >> 9) & 1) << 5)); }
__host__ __device__ __forceinline__ void stage_rc(int b, int& R, int& C) { const int st = b / 1024, sb = b % 1024, swz = sb ^ (((sb >> 9) & 1) << 5); R = (st >> 1) * 16 + swz / 64; C = (st & 1) * 32 + (swz % 64) / 2; }
__host__ __device__ __forceinline__ int perm32(int rho) { const int n = rho >> 4, i = rho & 15; return 8 * (i >> 2) + 4 * n + (i & 3); }

struct Unit { int pm, pn; };
struct Gemm { const bf16_t* A; const bf16_t* Bt; int M, N, K; };

struct StaticOrder {
    int nM, nN, nwg, G, c;
    __host__ __device__ void init(int M, int N, int G_, int c_) { nM = M / BM; nN = N / BM; nwg = nM * nN; G = G_; c = c_; }
    __host__ __device__ bool next(int i, Unit& u) const {
        const long L = (long)i * G + c; if (L >= nwg) return false;
        int wgid = (int)L; { const int q = nwg / NXCD, r = nwg % NXCD, xcd = wgid % NXCD, off = wgid / NXCD; wgid = (xcd < r ? xcd * (q + 1) : r * (q + 1) + (xcd - r) * q) + off; }
        const int nig = WGM * nN, gid = wgid / nig, fm = gid * WGM, gsz = (nM - fm) < WGM ? (nM - fm) : WGM;
        u.pm = fm + ((wgid % nig) % gsz); u.pn = (wgid % nig) / gsz; return true;
    }
    __device__ __forceinline__ void a_ready(const Unit&, int) const {}
    __device__ __forceinline__ void done(const Unit&) const {}
};


__device__ __forceinline__ unsigned cvt_pk_bf16(float lo, float hi) { unsigned r; asm volatile("v_cvt_pk_bf16_f32 %0, %1, %2" : "=v"(r) : "v"(lo), "v"(hi)); return r; }
__device__ __forceinline__ float fsigm(float x) { return __builtin_amdgcn_rcpf(1.f + __builtin_amdgcn_exp2f(x * -1.44269504089f)); }
constexpr int RTAB_OFF = STAGE_BYTES;

struct OrderRstd : StaticOrder {
    const float* ssq; PG8_LAS float* rtab;
    __device__ __forceinline__ void a_ready(const Unit& u, int ui) const {
        int t_ = threadIdx.x; asm volatile("" : "+v"(t_));
        const int wid = __builtin_amdgcn_readfirstlane(t_ >> 6), lane = t_ & 63, rl = wid * 32 + (lane & 31), half = lane >> 5;
        const float* p = ssq + (size_t)(half * 16) * 8192 + u.pm * BM + rl; float s = 0.f;
#pragma unroll
        for (int q = 0; q < 16; ++q) s += p[(size_t)q * 8192];
        s += __shfl_xor(s, 32);
        if (lane < 32) rtab[(ui & 1) * 256 + rl] = 1.0f / sqrtf(s * (1.0f / 2048.0f) + 1e-6f);
    }
};
struct EpiIn {
    static constexpr bool PERM = true, AFTER_DRAIN = false;
    bf16_t* U; const PG8_LAS float* rtab;
    __device__ __forceinline__ void operator()(const f32x4 (&acc)[2][2][4][2], const Unit& u, int wr, int wc, int fr, int fq, int ui) const {
        const PG8_LAS float* rt = rtab + (ui & 1) * 256 + wr * 64 + fr;
        if (u.pn < 8) {
            bf16_t* base = U + (size_t)(u.pm * BM + wr * 64 + fr) * 4096 + 128 * u.pn + wc * 32 + 8 * fq;
#pragma unroll
            for (int ai = 0; ai < 2; ++ai)
#pragma unroll
                for (int m = 0; m < 4; ++m) { const float rs = rt[ai * HALF + m * 16];
                    const f32x4 v0 = acc[ai][0][m][0] * rs, v1 = acc[ai][0][m][1] * rs, g0 = acc[ai][1][m][0] * rs, g1 = acc[ai][1][m][1] * rs;
                    u32x4 w; w.x = cvt_pk_bf16(v0[0] * fsigm(g0[0]), v0[1] * fsigm(g0[1])); w.y = cvt_pk_bf16(v0[2] * fsigm(g0[2]), v0[3] * fsigm(g0[3]));
                    w.z = cvt_pk_bf16(v1[0] * fsigm(g1[0]), v1[1] * fsigm(g1[1])); w.w = cvt_pk_bf16(v1[2] * fsigm(g1[2]), v1[3] * fsigm(g1[3]));
                    *(u32x4*)(base + (size_t)(ai * HALF + m * 16) * 4096) = w; }
        } else {
            const bool act = (u.pn < 12) || (u.pn >= 16);
            bf16_t* base = U + (size_t)(u.pm * BM + wr * 64 + fr) * 4096 + (256 * u.pn - 1024) + wc * 32 + 8 * fq;
#pragma unroll
            for (int ai = 0; ai < 2; ++ai)
#pragma unroll
                for (int m = 0; m < 4; ++m) { const float rs = rt[ai * HALF + m * 16];
#pragma unroll
                    for (int bj = 0; bj < 2; ++bj) { f32x4 v0 = acc[ai][bj][m][0] * rs, v1 = acc[ai][bj][m][1] * rs;
                        if (act) {
#pragma unroll
                            for (int e = 0; e < 4; ++e) { v0[e] = v0[e] * fsigm(v0[e]); v1[e] = v1[e] * fsigm(v1[e]); } }
                        u32x4 w; w.x = cvt_pk_bf16(v0[0], v0[1]); w.y = cvt_pk_bf16(v0[2], v0[3]); w.z = cvt_pk_bf16(v1[0], v1[1]); w.w = cvt_pk_bf16(v1[2], v1[3]);
                        *(u32x4*)(base + (size_t)(ai * HALF + m * 16) * 4096 + bj * HALF) = w; } }
        }
    }
};
struct EpiOut {
    static constexpr bool PERM = true, AFTER_DRAIN = false;
    const float* xold; float* out; bf16_t* XB; float* ssq;
    __device__ __forceinline__ void operator()(const f32x4 (&acc)[2][2][4][2], const Unit& u, int wr, int wc, int fr, int fq, int) const {
#pragma unroll
        for (int ai = 0; ai < 2; ++ai)
#pragma unroll
            for (int m = 0; m < 4; ++m) { const int row = u.pm * BM + ai * HALF + wr * 64 + m * 16 + fr; const size_t off = (size_t)row * 2048 + u.pn * BM + wc * 32 + 8 * fq; float s = 0.f;
#pragma unroll
                for (int bj = 0; bj < 2; ++bj) { const f32x4 x0 = *(const f32x4*)(xold + off + bj * HALF), x1 = *(const f32x4*)(xold + off + bj * HALF + 4);
                    const f32x4 v0 = x0 + acc[ai][bj][m][0], v1 = x1 + acc[ai][bj][m][1];
                    *(f32x4*)(out + off + bj * HALF) = v0; *(f32x4*)(out + off + bj * HALF + 4) = v1;
                    u32x4 w; w.x = cvt_pk_bf16(v0[0], v0[1]); w.y = cvt_pk_bf16(v0[2], v0[3]); w.z = cvt_pk_bf16(v1[0], v1[1]); w.w = cvt_pk_bf16(v1[2], v1[3]);
                    *(u32x4*)(XB + off + bj * HALF) = w;
                    s += (v0[0] * v0[0] + v0[1] * v0[1]) + (v0[2] * v0[2] + v0[3] * v0[3]) + (v1[0] * v1[0] + v1[1] * v1[1]) + (v1[2] * v1[2] + v1[3] * v1[3]); }
                s += __shfl_xor(s, 16); s += __shfl_xor(s, 32);
                if (fq == 0) ssq[(size_t)(u.pn * 4 + wc) * 8192 + row] = s;
                if (m & 1) asm volatile("" ::: "memory"); }
    }
};

template <class Epi, class Sched, bool ALIGN_EPI = false, bool SP2 = false>
__device__ __forceinline__ void gemm_phase(PG8_LAS unsigned char* lds, const Gemm g, const Sched& S, const Epi& E) {
    int tid_ = threadIdx.x; asm volatile("" : "+v"(tid_));
    const int tid = tid_, wid = __builtin_amdgcn_readfirstlane(tid >> 6), lane = tid & 63, wr = wid >> 2, wc = wid & 3, fr = lane & 15, fq = lane >> 4;
    const int K = g.K, nt = K / BK;
    unsigned voffA[2], voffB[2];
#pragma unroll
    for (int i = 0; i < 2; ++i) { int R, C; stage_rc(tid * 16 + i * 8192, R, C); const int Rb = Epi::PERM ? ((R & ~31) + perm32(R & 31)) : R;
        voffA[i] = (unsigned)(R * K + C) * 2u; voffB[i] = (unsigned)(Rb * K + C) * 2u; }
    const size_t kstep = (size_t)(BK * 2);
    const size_t hstep = (size_t)HALF * K * 2;
    const size_t tstep = 2 * hstep;
    const unsigned ldsw = (unsigned)wid * 1024u;
    const int aoff = lds_byte(wr * 64 + fr, fq * 8), boff = lds_byte(wc * 32 + fr, fq * 8);
#define PG8_SA(b, h) (((b) * 2 + (h)) * HTB)
#define PG8_SB(b, h) ((4 + (b) * 2 + (h)) * HTB)
#define PG8_STAGE(bufoff, gbase, voff) do { _Pragma("unroll") for (int _i = 0; _i < 2; ++_i) \
        __builtin_amdgcn_global_load_lds((const unsigned*)((const char*)(gbase) + (voff)[_i]), (PG8_LAS unsigned*)(lds + (bufoff) + ldsw + _i * 8192), 16, 0, 0); } while (0)
#define PG8_LDA(dst, b, h) do { _Pragma("unroll") for (int m = 0; m < 4; ++m) _Pragma("unroll") for (int k = 0; k < 2; ++k) dst[m][k] = *(const PG8_LAS bf16x8*)(lds + PG8_SA(b, h) + aoff + m * 2048 + k * 1024); } while (0)
#define PG8_LDB(dst, b, h) do { _Pragma("unroll") for (int n = 0; n < 2; ++n) _Pragma("unroll") for (int k = 0; k < 2; ++k) dst[n][k] = *(const PG8_LAS bf16x8*)(lds + PG8_SB(b, h) + boff + n * 2048 + k * 1024); } while (0)
#define PG8_MMA(ai, bj, At, Bt) do { __builtin_amdgcn_s_setprio(1); _Pragma("unroll") for (int m = 0; m < 4; ++m) _Pragma("unroll") for (int n = 0; n < 2; ++n) _Pragma("unroll") for (int k = 0; k < 2; ++k) \
        acc[ai][bj][m][n] = __builtin_amdgcn_mfma_f32_16x16x32_bf16(Bt[n][k], At[m][k], acc[ai][bj][m][n], 0, 0, 0); __builtin_amdgcn_s_setprio(0); } while (0)
#define PG8_WAIT_V(n) asm volatile("s_waitcnt vmcnt(" #n ")" ::: "memory")
#define PG8_WAIT_L(n) asm volatile("s_waitcnt lgkmcnt(" #n ")" ::: "memory")
#define PG8_BAR __builtin_amdgcn_s_barrier()
#define PG8_SCHED __builtin_amdgcn_sched_barrier(0)
    Unit cur, nxt; int ui = 0;
    if (!S.next(0, cur)) return;
    f32x4 acc[2][2][4][2];
#pragma unroll
    for (int a = 0; a < 2; ++a)
#pragma unroll
        for (int b = 0; b < 2; ++b)
#pragma unroll
            for (int m = 0; m < 4; ++m)
#pragma unroll
                for (int n = 0; n < 2; ++n) acc[a][b][m][n] = (f32x4){0.f, 0.f, 0.f, 0.f};
    bf16x8 At[4][2], B0[2][2], B1[2][2];
    const char* cA = (const char*)g.A + (size_t)cur.pm * tstep; const char* cB = (const char*)g.Bt + (size_t)cur.pn * tstep;
    S.a_ready(cur, 0);
    if constexpr (SP2) {
        PG8_STAGE(PG8_SB(0, 0), cB, voffB); PG8_STAGE(PG8_SB(0, 1), cB + hstep, voffB); PG8_STAGE(PG8_SA(0, 0), cA, voffA); PG8_STAGE(PG8_SA(0, 1), cA + hstep, voffA);
        if (wr == 1) PG8_BAR;
        PG8_WAIT_V(2); PG8_BAR;
        PG8_STAGE(PG8_SB(1, 0), cB + kstep, voffB); PG8_STAGE(PG8_SA(1, 0), cA + kstep, voffA); PG8_STAGE(PG8_SB(1, 1), cB + hstep + kstep, voffB);
        PG8_WAIT_V(6); PG8_BAR;
    } else {
        PG8_STAGE(PG8_SB(0, 0), cB, voffB); PG8_STAGE(PG8_SA(0, 0), cA, voffA); PG8_STAGE(PG8_SB(0, 1), cB + hstep, voffB); PG8_STAGE(PG8_SA(0, 1), cA + hstep, voffA);
        if (wr == 1) PG8_BAR;
        PG8_WAIT_V(4); PG8_BAR;
        PG8_STAGE(PG8_SB(1, 0), cB + kstep, voffB); PG8_STAGE(PG8_SA(1, 0), cA + kstep, voffA); PG8_STAGE(PG8_SB(1, 1), cB + hstep + kstep, voffB);
        PG8_WAIT_V(6); PG8_BAR;
    }
    for (;;) {
        const bool has_next = S.next(ui + 1, nxt);
        const char* nA = has_next ? (const char*)g.A + (size_t)nxt.pm * tstep : cA; const char* nB = has_next ? (const char*)g.Bt + (size_t)nxt.pn * tstep : cB;
        for (int t = 0; t < nt; t += 2) {
            const bool last = (t == nt - 2);
            const char* a1 = cA + (size_t)(t + 1) * kstep;
            const char* a2 = last ? nA : cA + (size_t)(t + 2) * kstep; const char* b2 = last ? nB : cB + (size_t)(t + 2) * kstep;
            const char* a3 = a2 + kstep; const char* b3 = b2 + kstep;
            if (last && has_next) S.a_ready(nxt, ui + 1);
            if constexpr (SP2) {
            PG8_LDB(B0, 0, 0); PG8_LDB(B1, 0, 1); PG8_SCHED; PG8_LDA(At, 0, 0); PG8_STAGE(PG8_SA(1, 1), a1 + hstep, voffA);
            PG8_WAIT_V(8); PG8_WAIT_L(0); PG8_BAR; PG8_MMA(0, 0, At, B0); PG8_MMA(0, 1, At, B1); PG8_BAR; PG8_SCHED;
            PG8_LDA(At, 0, 1); PG8_STAGE(PG8_SB(0, 0), b2, voffB); PG8_STAGE(PG8_SB(0, 1), b2 + hstep, voffB); PG8_STAGE(PG8_SA(0, 0), a2, voffA);
            PG8_WAIT_V(8); PG8_WAIT_L(0); PG8_BAR; PG8_MMA(1, 0, At, B0); PG8_MMA(1, 1, At, B1); PG8_BAR; PG8_SCHED;
            PG8_LDB(B0, 1, 0); PG8_LDB(B1, 1, 1); PG8_SCHED; PG8_LDA(At, 1, 0); PG8_STAGE(PG8_SA(0, 1), a2 + hstep, voffA);
            PG8_WAIT_V(8); PG8_WAIT_L(0); PG8_BAR; PG8_MMA(0, 0, At, B0); PG8_MMA(0, 1, At, B1); PG8_BAR; PG8_SCHED;
            PG8_LDA(At, 1, 1); PG8_STAGE(PG8_SB(1, 0), b3, voffB); PG8_STAGE(PG8_SB(1, 1), b3 + hstep, voffB); PG8_STAGE(PG8_SA(1, 0), a3, voffA);
            PG8_WAIT_V(8); PG8_WAIT_L(0); PG8_BAR; PG8_MMA(1, 0, At, B0); PG8_MMA(1, 1, At, B1); PG8_BAR; PG8_SCHED;
            } else {
            PG8_LDB(B0, 0, 0); PG8_SCHED; PG8_LDA(At, 0, 0); PG8_STAGE(PG8_SA(1, 1), a1 + hstep, voffA);
            PG8_WAIT_L(8); PG8_BAR; PG8_WAIT_L(0); PG8_MMA(0, 0, At, B0); PG8_BAR; PG8_SCHED;
            PG8_LDB(B1, 0, 1); PG8_STAGE(PG8_SB(0, 0), b2, voffB);
            PG8_BAR; PG8_WAIT_L(0); PG8_MMA(0, 1, At, B1); PG8_BAR;
            PG8_LDA(At, 0, 1); PG8_STAGE(PG8_SA(0, 0), a2, voffA);
            PG8_BAR; PG8_WAIT_L(0); PG8_MMA(1, 0, At, B0); PG8_BAR; PG8_SCHED;
            PG8_STAGE(PG8_SB(0, 1), b2 + hstep, voffB);
            PG8_WAIT_V(6); PG8_BAR; PG8_MMA(1, 1, At, B1); PG8_BAR;
            PG8_LDB(B0, 1, 0); PG8_SCHED; PG8_LDA(At, 1, 0); PG8_STAGE(PG8_SA(0, 1), a2 + hstep, voffA);
            PG8_WAIT_L(8); PG8_BAR; PG8_WAIT_L(0); PG8_MMA(0, 0, At, B0); PG8_BAR; PG8_SCHED;
            PG8_LDB(B1, 1, 1); PG8_STAGE(PG8_SB(1, 0), b3, voffB);
            PG8_BAR; PG8_WAIT_L(0); PG8_MMA(0, 1, At, B1); PG8_BAR;
            PG8_LDA(At, 1, 1); PG8_STAGE(PG8_SA(1, 0), a3, voffA);
            PG8_BAR; PG8_WAIT_L(0); PG8_MMA(1, 0, At, B0); PG8_BAR; PG8_SCHED;
            PG8_STAGE(PG8_SB(1, 1), b3 + hstep, voffB);
            PG8_WAIT_V(6); PG8_BAR; PG8_MMA(1, 1, At, B1); PG8_BAR;
            }
        }
        if constexpr (ALIGN_EPI) { if (wr == 0) PG8_BAR; }
        if constexpr (!Epi::AFTER_DRAIN) { E(acc, cur, wr, wc, fr, fq, ui); S.done(cur); }
        if (!has_next) break;
#pragma unroll
        for (int a = 0; a < 2; ++a)
#pragma unroll
            for (int b = 0; b < 2; ++b)
#pragma unroll
                for (int m = 0; m < 4; ++m)
#pragma unroll
                    for (int n = 0; n < 2; ++n) acc[a][b][m][n] = (f32x4){0.f, 0.f, 0.f, 0.f};
        cur = nxt; cA = nA; cB = nB; ++ui;
        if constexpr (ALIGN_EPI) { if (wr == 1) PG8_BAR; }
    }
    PG8_WAIT_V(0);
    if constexpr (!ALIGN_EPI) { if (wr == 0) PG8_BAR; }
    PG8_BAR;
    if constexpr (Epi::AFTER_DRAIN) { E.fused(acc, cur, wr, wc, fr, fq, lds, wid, lane); S.done(cur); }
#undef PG8_SA
#undef PG8_SB
#undef PG8_STAGE
#undef PG8_LDA
#undef PG8_LDB
#undef PG8_MMA
#undef PG8_WAIT_V
#undef PG8_WAIT_L
#undef PG8_BAR
#undef PG8_SCHED
}
}

#define PHASE_TID(F) do { int _t = threadIdx.x; asm volatile("" : "+v"(_t)); (F).tid = _t; (F).lane = _t & 63; (F).wave = __builtin_amdgcn_readfirstlane(_t >> 6); } while (0)
__device__ __forceinline__ void transpose_item(const float* W, int K, int N, bf16_t* WT, int dst_row0, int src_col0, const float* gk, LAS float* scr, int k0, int lane) {
#pragma unroll 8
    for (int i = 0; i < 32; ++i) { const int kk = 2 * i + (lane >> 5); float v = W[(size_t)(k0 + kk) * N + src_col0 + (lane & 31)]; if (gk) v *= gk[k0 + kk]; scr[kk * 33 + (lane & 31)] = v; }
    asm volatile("s_waitcnt lgkmcnt(0)" ::: "memory");
    const int c = lane & 7;
#pragma unroll
    for (int j = 0; j < 4; ++j) { const int n = (lane >> 3) + 8 * j; const LAS float* s = scr + (8 * c) * 33 + n;
        u32x4 o; o.x = pk2(s[0 * 33], s[1 * 33]); o.y = pk2(s[2 * 33], s[3 * 33]); o.z = pk2(s[4 * 33], s[5 * 33]); o.w = pk2(s[6 * 33], s[7 * 33]);
        *(u32x4*)(WT + (size_t)(dst_row0 + n) * K + k0 + 8 * c) = o; }
    asm volatile("s_waitcnt lgkmcnt(0)" ::: "memory");
}
__device__ __forceinline__ void p_prologue(Frame& F) {
    PHASE_TID(F);
    LAS float* scr = (LAS float*)(F.lds + F.wave * 16384);
    const int gw = F.bid * NWAVES + F.wave, NGW = F.G * NWAVES;
    constexpr int I_IN = (D / 64) * (DIN / 32), I_OUT = (D / 64) * (D / 32), I_G = NHEAD * 2 * (HD / 64) * (HD / 32), I_L = I_IN + I_OUT + I_G;
    for (int it = gw; it < DEPTH * I_L; it += NGW) {
        const int l = it / I_L; int r = it % I_L;
        if (r >= I_IN + I_OUT) { r -= I_IN + I_OUT; const int hg = r >> 3, kb = (r >> 2) & 1, nb = r & 3, h = hg >> 1, gsel = hg & 1;
            transpose_item((gsel ? F.wx : F.wa) + (size_t)(l * NHEAD + h) * HD * HD, HD, HD, F.WgT + (size_t)((l * NHEAD + h) * 2 + gsel) * HD * HD, 32 * nb, 32 * nb, nullptr, scr, 64 * kb, F.lane);
        } else if (r < I_IN) { const int kb = r / (DIN / 32), nb = r % (DIN / 32);
            transpose_item(F.w_in + (size_t)l * D * DIN, D, DIN, F.WinT + (size_t)l * DIN * D, 32 * nb, src_col(32 * nb), F.norm_g + l * D, scr, 64 * kb, F.lane);
        } else { r -= I_IN; const int kb = r / (D / 32), nb = r % (D / 32);
            transpose_item(F.w_out + (size_t)l * D * D, D, D, F.WoutT + (size_t)l * D * D, 32 * nb, 32 * nb, nullptr, scr, 64 * kb, F.lane); }
    }
    for (int m = gw; m < S; m += NGW) {
        const f32x4* xr = (const f32x4*)(F.x + (size_t)m * D) + F.lane; u32x2* ob = (u32x2*)(F.XB + (size_t)m * D) + F.lane; float s = 0.f;
#pragma unroll
        for (int j = 0; j < 8; ++j) { const f32x4 v = xr[64 * j]; s += (v.x * v.x + v.y * v.y) + (v.z * v.z + v.w * v.w); u32x2 w; w.x = pk2(v.x, v.y); w.y = pk2(v.z, v.w); ob[64 * j] = w; }
        s = wave_sum(s);
        if (F.lane < 32) F.SSQ[F.lane * S + m] = F.lane == 0 ? s : 0.f;
    }
}

template <int NV> __device__ __forceinline__ void block_sum(float (&v)[NV], LAS float* red  , int wave, int lane) {
#pragma unroll
    for (int i = 0; i < NV; ++i) { const float s = wave_sum(v[i]); if (lane == 0) red[i * 8 + wave] = s; }
    __syncthreads();
#pragma unroll
    for (int i = 0; i < NV; ++i) { const LAS f32x4* p = (const LAS f32x4*)(red + i * 8); const f32x4 a = p[0], b = p[1]; v[i] = ((a.x + a.y) + (a.z + a.w)) + ((b.x + b.y) + (b.z + b.w)); }
    __syncthreads();
}
constexpr int CT = 16;
__device__ __forceinline__ void conv_item(Frame& F, int l, int item) {
    LAS unsigned char* cs = F.lds;
    LAS float* red = (LAS float*)(F.lds + 62 * 2048);
    const int t0 = item * 32, c0 = 2 * F.tid;
    for (int q = F.tid; q < 62 * 128; q += NTHREADS) { const int row = q >> 7, c16 = q & 127, s = t0 - 30 + row; u32x4 v = (u32x4){0u, 0u, 0u, 0u};
        if (s >= 0) v = *(const u32x4*)(F.U + (size_t)s * UW + c16 * 8);
        *(LAS u32x4*)(cs + row * 2048 + c16 * 16) = v; }
    __syncthreads();
    float w0[31], w1[31];
    const auto rw = MAKE_RSRC(F.cdw_w + (size_t)l * CW * DC, CW * DC * 4);
#pragma unroll
    for (int j = 0; j < 31; ++j) { const f32x2 t = __builtin_bit_cast(f32x2, __builtin_amdgcn_raw_buffer_load_b64(rw, c0 * 4, (30 - j) * DC * 4, 0)); w0[j] = t.x; w1[j] = t.y; }
    const f32x2 bias = *(const f32x2*)(F.cdw_b + l * DC + c0);
    const f32x2 lg = *(const f32x2*)(F.cln_g + l * DC + c0), lb = *(const f32x2*)(F.cln_b + l * DC + c0);
    const auto ru = MAKE_RSRC(F.U, (size_t)S * UW * 2); const auto ry = MAKE_RSRC(F.Y, (size_t)S * D * 2);
#pragma unroll 1
    for (int hb = 0; hb < 32 / CT; ++hb) {
        float a0[CT], a1[CT];
#pragma unroll
        for (int i = 0; i < CT; ++i) { a0[i] = bias.x; a1[i] = bias.y; }
        const LAS unsigned char* cp = cs + (hb * CT) * 2048 + F.tid * 4;
#pragma unroll
        for (int si = 0; si < CT + 30; ++si) {
            const unsigned cw = *(const LAS unsigned*)(cp + si * 2048);
            const float x0 = bflo(cw), x1 = bfhi(cw);
#pragma unroll
            for (int i = 0; i < CT; ++i) { const int j = i + 30 - si; if (j >= 0 && j <= 30) { a0[i] += w0[j] * x0; a1[i] += w1[j] * x1; } }
        }
        float sv[CT];
#pragma unroll
        for (int i = 0; i < CT; ++i) sv[i] = a0[i] + a1[i];
        block_sum<CT>(sv, red, F.wave, F.lane);
#pragma unroll
        for (int i = 0; i < CT; ++i) { const float mean = sv[i] * (1.f / DC); a0[i] -= mean; a1[i] -= mean; sv[i] = a0[i] * a0[i] + a1[i] * a1[i]; }
        block_sum<CT>(sv, red, F.wave, F.lane);
#pragma unroll
        for (int i = 0; i < CT; ++i) {
            const int t = t0 + hb * CT + i;
            const float rstd = 1.f / sqrtf(sv[i] * (1.f / DC) + LN_EPS);
            const unsigned zw = __builtin_amdgcn_raw_buffer_load_b32(ru, (1024 + c0) * 2, t * (UW * 2), 0);
            const float y0 = siluf(a0[i] * rstd * lg.x + lb.x) * bflo(zw), y1 = siluf(a1[i] * rstd * lg.y + lb.y) * bfhi(zw);
            __builtin_amdgcn_raw_buffer_store_b32(pk2(y0, y1), ry, c0 * 2, t * (D * 2), 0);
        }
    }
    __syncthreads();
}
#define DPP_ROW_SHR(x, oldv, d) __builtin_bit_cast(float, __builtin_amdgcn_update_dpp(__builtin_bit_cast(int, (float)(oldv)), __builtin_bit_cast(int, (float)(x)), 0x110 + (d), 0xf, 0xf, false))
__device__ __forceinline__ unsigned* lru_flag(Frame& F, int l, int c, int h) { return F.ctl + CW_LRU + 64 * ((l * NLCH + c) * NHEAD + h); }
__device__ __forceinline__ void lru_item(Frame& F, int l, int item) {
    const int c = item >> 3, h = item & 7, t0 = c * LCH, ch0 = h * HD;
    LAS unsigned char* xhi = F.lds; LAS unsigned char* xlo = F.lds + LCH * XROW;
    const int tid = F.tid, lane = F.lane, w = F.wave, fr = lane & 15, fq = lane >> 4;
    const auto ru = MAKE_RSRC(F.U, (size_t)S * UW * 2); const auto ry = MAKE_RSRC(F.Y, (size_t)S * D * 2);
    {
        const int tg = tid >> 4, cg = tid & 15, tb = 8 * tg;
        const float* cw = F.lcw + (size_t)l * LW * DL + ch0 + 8 * cg;
        f32x4 wk[4][2];
#pragma unroll
        for (int k = 0; k < 4; ++k) { wk[k][0] = *(const f32x4*)(cw + (size_t)k * DL); wk[k][1] = *(const f32x4*)(cw + (size_t)k * DL + 4); }
        const f32x4 bb0 = *(const f32x4*)(F.lcb + l * DL + ch0 + 8 * cg), bb1 = *(const f32x4*)(F.lcb + l * DL + ch0 + 8 * cg + 4);
        u32x4 rows[11];
#pragma unroll
        for (int r = 0; r < 11; ++r) { const int sidx = t0 + tb - 3 + r; rows[r] = (u32x4){0u, 0u, 0u, 0u};
            if (sidx >= 0) rows[r] = __builtin_bit_cast(u32x4, __builtin_amdgcn_raw_buffer_load_b128(ru, (2048 + ch0 + 8 * cg) * 2, sidx * (UW * 2), 0)); }
#pragma unroll
        for (int i = 0; i < 8; ++i) {
            f32x4 a0 = bb0, a1 = bb1;
#pragma unroll
            for (int k = 0; k < 4; ++k) { const u32x4 q = rows[i + k];
                a0[0] += wk[k][0][0] * bflo(q.x); a0[1] += wk[k][0][1] * bfhi(q.x); a0[2] += wk[k][0][2] * bflo(q.y); a0[3] += wk[k][0][3] * bfhi(q.y);
                a1[0] += wk[k][1][0] * bflo(q.z); a1[1] += wk[k][1][1] * bfhi(q.z); a1[2] += wk[k][1][2] * bflo(q.w); a1[3] += wk[k][1][3] * bfhi(q.w); }
            u32x4 hi; hi.x = pk2(a0[0], a0[1]); hi.y = pk2(a0[2], a0[3]); hi.z = pk2(a1[0], a1[1]); hi.w = pk2(a1[2], a1[3]);
            u32x4 lo; lo.x = pk2(a0[0] - bflo(hi.x), a0[1] - bfhi(hi.x)); lo.y = pk2(a0[2] - bflo(hi.y), a0[3] - bfhi(hi.y)); lo.z = pk2(a1[0] - bflo(hi.z), a1[1] - bfhi(hi.z)); lo.w = pk2(a1[2] - bflo(hi.w), a1[3] - bfhi(hi.w));
            *(LAS u32x4*)(xhi + (tb + i) * XROW + cg * 16) = hi; *(LAS u32x4*)(xlo + (tb + i) * XROW + cg * 16) = lo; }
    }
    __syncthreads();
    bf16x8 br[4], bi[4];
    { const bf16_t* wg = F.WgT + (size_t)((l * NHEAD + h) * 2) * HD * HD + (size_t)(16 * w + fr) * HD + 8 * fq;
#pragma unroll
      for (int kk = 0; kk < 4; ++kk) { br[kk] = *(const bf16x8*)(wg + 32 * kk); bi[kk] = *(const bf16x8*)(wg + HD * HD + 32 * kk); } }
    const int chl = ch0 + 16 * w + 4 * fq;
    const f32x4 vba = *(const f32x4*)(F.ba + l * DL + chl), vbx = *(const f32x4*)(F.bx + l * DL + chl), vlam = *(const f32x4*)(F.lam + l * DL + chl);
    float c8[4];
#pragma unroll
    for (int j = 0; j < 4; ++j) c8[j] = 8.f * log_sigmoid(vlam[j]);
    float hl[16][4], pc[16][4], HC[4], PC[4];
#pragma unroll
    for (int j = 0; j < 4; ++j) { HC[j] = 0.f; PC[j] = 1.f; }
#pragma unroll
    for (int m = 0; m < 16; ++m) {
        f32x4 ar = (f32x4){0.f, 0.f, 0.f, 0.f}, ai = (f32x4){0.f, 0.f, 0.f, 0.f};
        const LAS unsigned char* rowp = xhi + (16 * m + fr) * XROW;
#pragma unroll
        for (int kk = 0; kk < 4; ++kk) { const bf16x8 a = *(const LAS bf16x8*)(rowp + (32 * kk + 8 * fq) * 2);
            ar = __builtin_amdgcn_mfma_f32_16x16x32_bf16(br[kk], a, ar, 0, 0, 0); ai = __builtin_amdgcn_mfma_f32_16x16x32_bf16(bi[kk], a, ai, 0, 0, 0); }
        const u32x2 qh = *(const LAS u32x2*)(rowp + (16 * w + 4 * fq) * 2), ql = *(const LAS u32x2*)(rowp + LCH * XROW + (16 * w + 4 * fq) * 2);
        const float xcv[4] = {bflo(qh.x) + bflo(ql.x), bfhi(qh.x) + bfhi(ql.x), bflo(qh.y) + bflo(ql.y), bfhi(qh.y) + bfhi(ql.y)};
#pragma unroll
        for (int j = 0; j < 4; ++j) {
            const float r = pg8::fsigm(ar[j] + vba[j]), ig = pg8::fsigm(ai[j] + vbx[j]), la = c8[j] * r;
            float A = __builtin_amdgcn_exp2f(la * 1.44269504089f), B = sqrtf(neg_expm1(2.f * la)) * (ig * xcv[j]);
#define LRU_SCAN_STEP(d) { const float ap = DPP_ROW_SHR(A, 1.0f, d), bp = DPP_ROW_SHR(B, 0.0f, d); B = A * bp + B; A = ap * A; }
            LRU_SCAN_STEP(1) LRU_SCAN_STEP(2) LRU_SCAN_STEP(4) LRU_SCAN_STEP(8)
#undef LRU_SCAN_STEP
            hl[m][j] = B + A * HC[j]; pc[m][j] = A * PC[j];
            HC[j] = __shfl(hl[m][j], lane | 15); PC[j] = __shfl(pc[m][j], lane | 15);
        }
    }
    if (fr == 15) { unsigned long long* sp = F.SUM + (size_t)(l * NLCH + c) * DL + chl;
#pragma unroll
        for (int j = 0; j < 4; ++j) __hip_atomic_store(sp + j, ((unsigned long long)__builtin_bit_cast(unsigned, HC[j]) << 32) | __builtin_bit_cast(unsigned, PC[j]), __ATOMIC_RELAXED, __HIP_MEMORY_SCOPE_AGENT); }
    asm volatile("s_waitcnt vmcnt(0)" ::: "memory");
    __syncthreads();
    if (tid == 0) __hip_atomic_store(lru_flag(F, l, c, h), 1u, __ATOMIC_RELAXED, __HIP_MEMORY_SCOPE_AGENT);
    float Hin[4] = {0.f, 0.f, 0.f, 0.f};
    if (c > 0) {
        if (w == 0) {
            unsigned* fp = lru_flag(F, l, lane < c ? lane : 0, h); unsigned spins = 0;
            for (;;) { const unsigned v = __hip_atomic_load(fp, __ATOMIC_RELAXED, __HIP_MEMORY_SCOPE_AGENT); if (__all(v != 0u)) break; __builtin_amdgcn_s_sleep(2); if (++spins > (1u << 20)) break; }
            __builtin_amdgcn_fence(__ATOMIC_ACQUIRE, "agent");
            asm volatile("s_waitcnt vmcnt(0)" ::: "memory");
        }
        __syncthreads();
        const unsigned long long* sp = F.SUM + (size_t)(l * NLCH) * DL + chl;
#pragma unroll 4
        for (int cc = 0; cc < c; ++cc) { const u32x4 s0 = *(const u32x4*)(sp + (size_t)cc * DL), s1 = *(const u32x4*)(sp + (size_t)cc * DL + 2);
            Hin[0] = u2f(s0.x) * Hin[0] + u2f(s0.y); Hin[1] = u2f(s0.z) * Hin[1] + u2f(s0.w);
            Hin[2] = u2f(s1.x) * Hin[2] + u2f(s1.y); Hin[3] = u2f(s1.z) * Hin[3] + u2f(s1.w); }
    }
    const int vo_u = (fr * UW + 3072 + chl) * 2, vo_y = (fr * D + DC + chl) * 2;
#pragma unroll
    for (int m = 0; m < 16; ++m) { const int trow = t0 + 16 * m;
        const u32x2 zq = __builtin_bit_cast(u32x2, __builtin_amdgcn_raw_buffer_load_b64(ru, vo_u, trow * (UW * 2), 0));
        const float y0 = (hl[m][0] + pc[m][0] * Hin[0]) * bflo(zq.x), y1 = (hl[m][1] + pc[m][1] * Hin[1]) * bfhi(zq.x), y2 = (hl[m][2] + pc[m][2] * Hin[2]) * bflo(zq.y), y3 = (hl[m][3] + pc[m][3] * Hin[3]) * bfhi(zq.y);
        u32x2 o; o.x = pk2(y0, y1); o.y = pk2(y2, y3);
        __builtin_amdgcn_raw_buffer_store_b64(o, ry, vo_y, trow * (D * 2), 0); }
    __syncthreads();
}
__device__ __forceinline__ void p_mix(Frame& F, int l) {
    PHASE_TID(F);
    constexpr int NCONV = S / 32, NLRU = NLCH * NHEAD;
    for (int it = F.bid; it < NLRU; it += F.G) { PHASE_TID(F); lru_item(F, l, it); }
    for (int it = F.bid; it < NCONV; it += F.G) { PHASE_TID(F); conv_item(F, l, it); }
}
__device__ __forceinline__ void p_final(Frame& F) {
    PHASE_TID(F);
    const int gw = F.bid * NWAVES + F.wave, NGW = F.G * NWAVES;
    for (int m = gw; m < S; m += NGW) {
        float ss = 0.f;
#pragma unroll
        for (int p = 0; p < 32; ++p) ss += F.SSQ[p * S + m];
        const float rstd = 1.f / sqrtf(ss * (1.f / D) + RMS_EPS);
        f32x4* orow = (f32x4*)(F.out + (size_t)m * D) + F.lane; const f32x4* gr = (const f32x4*)F.final_g + F.lane;
#pragma unroll
        for (int j = 0; j < 8; ++j) orow[64 * j] = orow[64 * j] * rstd * gr[64 * j];
    }
}

constexpr int PH_PER_LAYER = 3, NPH = 1 + DEPTH * PH_PER_LAYER + 1;
struct Args { const float* in[16]; float* out; unsigned char* ws; int ph_lo, ph_hi; };
__global__ void __launch_bounds__(NTHREADS, 2) mk_fwd(Args a) {
    extern __shared__ __attribute__((aligned(16))) unsigned char lds_raw[];
    Frame F;
    F.lds = (LAS unsigned char*)lds_raw;
    F.tid = threadIdx.x; F.lane = F.tid & 63; F.wave = __builtin_amdgcn_readfirstlane(F.tid >> 6); F.bid = blockIdx.x; F.G = gridDim.x;
    F.x = a.in[0]; F.norm_g = a.in[1]; F.w_in = a.in[2]; F.cdw_w = a.in[3]; F.cdw_b = a.in[4]; F.cln_g = a.in[5]; F.cln_b = a.in[6]; F.lcw = a.in[7]; F.lcb = a.in[8];
    F.wa = a.in[9]; F.ba = a.in[10]; F.wx = a.in[11]; F.bx = a.in[12]; F.lam = a.in[13]; F.w_out = a.in[14]; F.final_g = a.in[15]; F.out = a.out;
    unsigned char* ws = a.ws;
    F.WinT = (bf16_t*)(ws + WS_WINT); F.WoutT = (bf16_t*)(ws + WS_WOUTT); F.XB = (bf16_t*)(ws + WS_XB); F.U = (bf16_t*)(ws + WS_U); F.Y = (bf16_t*)(ws + WS_Y);
    F.SSQ = (float*)(ws + WS_SSQ); F.SUM = (unsigned long long*)(ws + WS_SUM); F.WgT = (bf16_t*)(ws + WS_WG); F.ctl = (unsigned*)(ws + WS_CTL);
    volatile LAS unsigned* bst = (volatile LAS unsigned*)(F.lds + LDS_BYTES - 64);
    if (F.tid < 16) bst[F.tid] = 0u;
    __syncthreads();
    XcdBarrier bar; bar.bar = (unsigned*)(ws + WS_CTL) + CW_BAR; bar.x = 0; bar.st = bst;
    if (MK_ONE_LAUNCH) bar = xcd_barrier_post((unsigned*)(ws + WS_CTL) + CW_BAR, bst);
    for (int ph = a.ph_lo; ph < a.ph_hi; ++ph) {
        if (ph == 0) p_prologue(F);
        else if (ph == NPH - 1) p_final(F);
        else { const int l = (ph - 1) / PH_PER_LAYER, j = (ph - 1) % PH_PER_LAYER;
            if (j == 0) { pg8::Gemm g{F.XB, F.WinT + (size_t)l * DIN * D, S, DIN, D}; pg8::OrderRstd Sd; Sd.init(S, DIN, F.G, F.bid); Sd.ssq = F.SSQ; Sd.rtab = (LAS float*)(F.lds + pg8::RTAB_OFF);
                pg8::EpiIn E{F.U, (const LAS float*)(F.lds + pg8::RTAB_OFF)};
                pg8::gemm_phase<pg8::EpiIn, pg8::OrderRstd, true, true>(F.lds, g, Sd, E); }
            else if (j == 1) p_mix(F, l);
            else { pg8::Gemm g{F.Y, F.WoutT + (size_t)l * D * D, S, D, D}; pg8::StaticOrder Sd; Sd.init(S, D, F.G, F.bid);
                pg8::EpiOut E{l == 0 ? F.x : F.out, F.out, F.XB, F.SSQ};
                pg8::gemm_phase<pg8::EpiOut, pg8::StaticOrder, true, true>(F.lds, g, Sd, E); }
        }
        if (ph + 1 < a.ph_hi) xcd_barrier(bar);
    }
}

extern "C" void kernel_launch(void* const* d_in, const int* in_sizes, int n_in, void* d_out, int out_size, void* d_ws, size_t ws_size, hipStream_t stream) {
    static int grid = 0;
    if (grid == 0) {
        if (n_in != 16 || in_sizes[0] != S * D || out_size != S * D || ws_size < WS_END) { fprintf(stderr, "kernel_launch: unexpected shapes (n_in %d, in0 %d, out %d, ws %zu)\n", n_in, n_in > 0 ? in_sizes[0] : -1, out_size, ws_size); grid = -1; return; }
        int dev = 0, cus = 0, per_cu = 0;
        if (hipGetDevice(&dev) != hipSuccess || hipDeviceGetAttribute(&cus, hipDeviceAttributeMultiprocessorCount, dev) != hipSuccess) { grid = -1; return; }
        if (hipFuncSetAttribute((const void*)mk_fwd, hipFuncAttributeMaxDynamicSharedMemorySize, LDS_BYTES) != hipSuccess) { fprintf(stderr, "kernel_launch: hipFuncSetAttribute failed\n"); grid = -1; return; }
        if (hipOccupancyMaxActiveBlocksPerMultiprocessor(&per_cu, (const void*)mk_fwd, NTHREADS, LDS_BYTES) != hipSuccess || per_cu < 1) fprintf(stderr, "kernel_launch: occupancy query says %d per CU\n", per_cu);
        (void)hipGetLastError();
        grid = cus;
    }
    if (grid < 0) return;
    (void)hipMemsetAsync((char*)d_ws + WS_CTL, 0, CTL_ZERO_BYTES, stream);
    Args a{};
    for (int i = 0; i < 16; ++i) a.in[i] = (const float*)d_in[i];
    a.out = (float*)d_out; a.ws = (unsigned char*)d_ws;
#if MK_ONE_LAUNCH
    a.ph_lo = 0; a.ph_hi = NPH;
    hipLaunchKernelGGL(mk_fwd, dim3(grid), dim3(NTHREADS), LDS_BYTES, stream, a);
#else
    for (int ph = 0; ph < NPH; ++ph) { a.ph_lo = ph; a.ph_hi = ph + 1; hipLaunchKernelGGL(mk_fwd, dim3(grid), dim3(NTHREADS), LDS_BYTES, stream, a); }
#endif
}
```

```cpp
#include <hip/hip_runtime.h>
#include <cstdio>
#include <cstdint>

#ifndef MK_ONE_LAUNCH
#define MK_ONE_LAUNCH 1
#endif

#define LAS __attribute__((address_space(3)))
#define GAS __attribute__((address_space(1)))
typedef unsigned short bf16_t;
typedef short bf16x8 __attribute__((ext_vector_type(8)));
typedef float f32x4 __attribute__((ext_vector_type(4)));
typedef float f32x2 __attribute__((ext_vector_type(2)));
typedef unsigned u32x4 __attribute__((ext_vector_type(4)));
typedef unsigned u32x2 __attribute__((ext_vector_type(2)));

constexpr int S = 8192, D = 2048, DEPTH = 4, DC = 1024, DL = 1024, DIN = 5120, NHEAD = 8, HD = 128, CW = 31, LW = 4;
constexpr int UW = 4096;
constexpr float RMS_EPS = 1e-6f, LN_EPS = 1e-5f;
constexpr int NTHREADS = 512, NWAVES = 8;
constexpr int LDS_BYTES = 147456;
constexpr int LCH = 256, NLCH = S / LCH;
constexpr int XROW = 272;
constexpr int CW_BAR = 4096, CW_LRU = 16384;

constexpr size_t MiB = 1u << 20;
constexpr size_t WS_CTL = 0, CTL_ZERO_BYTES = 1 * MiB;
constexpr size_t WS_WINT = 2 * MiB;
constexpr size_t WS_WOUTT = 82 * MiB;
constexpr size_t WS_XB = 114 * MiB;
constexpr size_t WS_U = 146 * MiB;
constexpr size_t WS_Y = 210 * MiB;
constexpr size_t WS_SSQ = 242 * MiB;
constexpr size_t WS_SUM = 243 * MiB;
constexpr size_t WS_WG = 244 * MiB;
constexpr size_t WS_END = 246 * MiB;

__device__ __forceinline__ int opaque_tid(int wave);
#define MAKE_RSRC(p, bytes) __builtin_amdgcn_make_buffer_rsrc((void*)(p), 0, (int)(bytes), 0x00020000)
__device__ __forceinline__ unsigned f2bf(float f) { unsigned u = __builtin_bit_cast(unsigned, f); return (u + 0x7fffu + ((u >> 16) & 1u)) >> 16; }
__device__ __forceinline__ unsigned pk2(float lo, float hi) { return f2bf(lo) | (f2bf(hi) << 16); }
__device__ __forceinline__ float bflo(unsigned w) { return __builtin_bit_cast(float, w << 16); }
__device__ __forceinline__ float bfhi(unsigned w) { return __builtin_bit_cast(float, w & 0xffff0000u); }
__device__ __forceinline__ float u2f(unsigned u) { return __builtin_bit_cast(float, u); }
__device__ __forceinline__ float bf2f(bf16_t b) { return __builtin_bit_cast(float, (unsigned)b << 16); }
__device__ __forceinline__ float sigm(float x) { return 1.f / (1.f + __expf(-x)); }
__device__ __forceinline__ float siluf(float x) { return x * sigm(x); }
__device__ __forceinline__ float wave_sum(float v) {
#pragma unroll
    for (int o = 1; o < 64; o <<= 1) v += __shfl_xor(v, o);
    return v;
}
__device__ __forceinline__ float neg_expm1(float x) {
    float p = 1.f + x * (1.f / 8.f); p = 1.f + x * (1.f / 7.f) * p; p = 1.f + x * (1.f / 6.f) * p; p = 1.f + x * (1.f / 5.f) * p; p = 1.f + x * 0.25f * p; p = 1.f + x * (1.f / 3.f) * p; p = 1.f + x * 0.5f * p;
    const float big = 1.f - __builtin_amdgcn_exp2f(x * 1.44269504089f);
    return x > -0.35f ? -x * p : big;
}
__device__ __forceinline__ float log_sigmoid(float x) { return fminf(x, 0.f) - log1pf(expf(-fabsf(x))); }
__host__ __device__ __forceinline__ int src_col(int np) { if (np < 2048) { const int p = np >> 8, j = np & 255; return j < 128 ? 128 * p + j : 1024 + 128 * p + (j - 128); } return np; }

#define XB_TMO      128
#define XB_XCNT(j)  (256  + 64 * (j))
#define XB_XSUB(j)  (1280 + 64 * (j))
#define XB_XGEN(j)  (2304 + 64 * (j))
#define XB_TOP      3328
#define XB_TOPGEN   3392
#define XCD_BAR_WORDS 3456
#define XB_SPIN_CAP (1u << 18)
__device__ __forceinline__ unsigned xb_ld(unsigned* p)              { return __hip_atomic_load(p, __ATOMIC_RELAXED, __HIP_MEMORY_SCOPE_AGENT); }
__device__ __forceinline__ unsigned xb_add(unsigned* p, unsigned v) { return __hip_atomic_fetch_add(p, v, __ATOMIC_RELAXED, __HIP_MEMORY_SCOPE_AGENT); }
__device__ __forceinline__ unsigned xb_xcc_id() { return (unsigned)__builtin_amdgcn_s_getreg((3 << 11) | 20) & 0xFu; }
#define XB_SPIN(cond, bar) do { unsigned _sp = 0; while (cond) { __builtin_amdgcn_s_sleep(1); \
    if ((++_sp & 255u) == 0u) { if (xb_ld(&(bar)[XB_TMO])) break; if (_sp > XB_SPIN_CAP) { atomicAdd(&(bar)[XB_TMO], 1u); break; } } } } while (0)
struct XcdBarrier { unsigned* bar; unsigned x; volatile LAS unsigned* st; int wave; };
__device__ __forceinline__ XcdBarrier xcd_barrier_post(unsigned* bar, volatile LAS unsigned* st) {
    XcdBarrier b; b.bar = bar; b.x = xb_xcc_id(); b.st = st;
    if (threadIdx.x == 0) (void)xb_add(&bar[XB_XCNT(b.x)], 1u);
    return b;
}
__device__ __forceinline__ void xcd_barrier_complete(unsigned* bar, unsigned x, unsigned& nloc, unsigned& nx) {
    const unsigned G = gridDim.x * gridDim.y * gridDim.z;
    unsigned sum, cnt, mine, sp = 0u;
    for (;;) {
        sum = 0u; cnt = 0u; mine = 0u;
#pragma unroll
        for (unsigned j = 0; j < 16; ++j) { const unsigned c = xb_ld(&bar[XB_XCNT(j)]); sum += c; cnt += (c > 0u) ? 1u : 0u; mine = (j == x) ? c : mine; }
        if (sum == G) break;
        __builtin_amdgcn_s_sleep(1);
        if ((++sp & 255u) == 0u) { if (xb_ld(&bar[XB_TMO])) break; if (sp > XB_SPIN_CAP) { atomicAdd(&bar[XB_TMO], 1u); break; } }
    }
    nloc = mine > 0u ? mine : 1u; nx = cnt > 0u ? cnt : 1u;
}
__device__ __forceinline__ void xcd_barrier(const XcdBarrier& b) {
    asm volatile("s_waitcnt vmcnt(0)" ::: "memory");
    __syncthreads();
    if (opaque_tid(b.wave) == 0) {
        unsigned* bar = b.bar;
        __builtin_amdgcn_s_waitcnt(0);
        unsigned nloc = b.st[0], nx = b.st[1];
        if (nloc == 0u) { xcd_barrier_complete(bar, b.x, nloc, nx); b.st[0] = nloc; b.st[1] = nx; }
        const unsigned old = xb_add(&bar[XB_XSUB(b.x)], 1u);
        const unsigned gen = old / nloc;
        if (old + 1u == (gen + 1u) * nloc) {
            __builtin_amdgcn_fence(__ATOMIC_RELEASE, "agent");
            asm volatile("s_waitcnt vmcnt(0)" ::: "memory");
            const unsigned og = xb_add(&bar[XB_TOP], 1u);
            const unsigned tg = og / nx;
            if (og + 1u == (tg + 1u) * nx) xb_add(&bar[XB_TOPGEN], 1u);
            else XB_SPIN(xb_ld(&bar[XB_TOPGEN]) == tg, bar);
            __builtin_amdgcn_fence(__ATOMIC_ACQUIRE, "agent");
            xb_add(&bar[XB_XGEN(b.x)], 1u);
            asm volatile("s_waitcnt vmcnt(0)" ::: "memory");
        } else {
            XB_SPIN(xb_ld(&bar[XB_XGEN(b.x)]) == gen, bar);
            __builtin_amdgcn_fence(__ATOMIC_ACQUIRE, "agent");
            asm volatile("s_waitcnt vmcnt(0)" ::: "memory");
        }
    }
    __syncthreads();
}

struct Frame {
    LAS unsigned char* lds;
    int tid, lane, wave, bid, G;
    const float *x, *norm_g, *w_in, *cdw_w, *cdw_b, *cln_g, *cln_b, *lcw, *lcb, *wa, *ba, *wx, *bx, *lam, *w_out, *final_g;
    float* out;
    bf16_t *WinT, *WoutT, *XB, *U, *Y;
    float *SSQ; unsigned long long* SUM; bf16_t* WgT; unsigned* ctl;
};

namespace pg8 {
#define PG8_LAS __attribute__((address_space(3)))
typedef unsigned short bf16_t;
typedef short bf16x8 __attribute__((ext_vector_type(8)));
typedef float f32x4 __attribute__((ext_vector_type(4)));
typedef unsigned u32x4 __attribute__((ext_vector_type(4)));
constexpr int BM = 256, BK = 64, HALF = 128, HTB = HALF * BK * 2  , STAGE_BYTES = 8 * HTB, NXCD = 8, WGM = 8;

__host__ __device__ __forceinline__ int lds_byte(int r, int c) { const int st = (r >> 4) * 2 + (c >> 5), rr = r & 15, cc = c & 31, ob = rr * 64 + cc * 2; return st * 1024 + (ob ^ (((ob >> 9) & 1) << 5)); }
__host__ __device__ __forceinline__ void stage_rc(int b, int& R, int& C) { const int st = b / 1024, sb = b % 1024, swz = sb ^ (((sb >> 9) & 1) << 5); R = (st >> 1) * 16 + swz / 64; C = (st & 1) * 32 + (swz % 64) / 2; }
__host__ __device__ __forceinline__ int perm32(int rho) { const int n = rho >> 4, i = rho & 15; return 8 * (i >> 2) + 4 * n + (i & 3); }

struct Unit { int pm, pn; };
struct Gemm { const bf16_t* A; const bf16_t* Bt; int M, N, K; };

struct StaticOrder {
    int nM, nN, nwg, G, c;
    __host__ __device__ void init(int M, int N, int G_, int c_) { nM = M / BM; nN = N / BM; nwg = nM * nN; G = G_; c = c_; }
    __host__ __device__ bool next(int i, Unit& u) const {
        const long L = (long)i * G + c; if (L >= nwg) return false;
        int wgid = (int)L; { const int q = nwg / NXCD, r = nwg % NXCD, xcd = wgid % NXCD, off = wgid / NXCD; wgid = (xcd < r ? xcd * (q + 1) : r * (q + 1) + (xcd - r) * q) + off; }
        const int nig = WGM * nN, gid = wgid / nig, fm = gid * WGM, gsz = (nM - fm) < WGM ? (nM - fm) : WGM;
        u.pm = fm + ((wgid % nig) % gsz); u.pn = (wgid % nig) / gsz; return true;
    }
    __device__ __forceinline__ void a_ready(const Unit&, int) const {}
    __device__ __forceinline__ void done(const Unit&) const {}
};


__device__ __forceinline__ unsigned cvt_pk_bf16(float lo, float hi) { unsigned r; asm volatile("v_cvt_pk_bf16_f32 %0, %1, %2" : "=v"(r) : "v"(lo), "v"(hi)); return r; }
__device__ __forceinline__ float fsigm(float x) { return __builtin_amdgcn_rcpf(1.f + __builtin_amdgcn_exp2f(x * -1.44269504089f)); }
constexpr int RTAB_OFF = STAGE_BYTES;

struct OrderRstd : StaticOrder {
    const float* ssq; PG8_LAS float* rtab; int wave;
    __device__ __forceinline__ void a_ready(const Unit& u, int ui) const {
        const int t_ = opaque_tid(wave), wid = wave, lane = t_ & 63, rl = wid * 32 + (lane & 31), half = lane >> 5;
        const float* p = ssq + (size_t)(half * 16) * 8192 + u.pm * BM + rl; float s = 0.f;
#pragma unroll
        for (int q = 0; q < 16; ++q) s += p[(size_t)q * 8192];
        s += __shfl_xor(s, 32);
        if (lane < 32) rtab[(ui & 1) * 256 + rl] = 1.0f / sqrtf(s * (1.0f / 2048.0f) + 1e-6f);
    }
};
struct EpiIn {
    static constexpr bool PERM = true, AFTER_DRAIN = false;
    bf16_t* U; const PG8_LAS float* rtab;
    __device__ __forceinline__ void operator()(const f32x4 (&acc)[2][2][4][2], const Unit& u, int wr, int wc, int fr, int fq, int ui) const {
        const PG8_LAS float* rt = rtab + (ui & 1) * 256 + wr * 64 + fr;
        if (u.pn < 8) {
            bf16_t* base = U + (size_t)(u.pm * BM + wr * 64 + fr) * 4096 + 128 * u.pn + wc * 32 + 8 * fq;
#pragma unroll
            for (int ai = 0; ai < 2; ++ai)
#pragma unroll
                for (int m = 0; m < 4; ++m) { const float rs = rt[ai * HALF + m * 16];
                    const f32x4 v0 = acc[ai][0][m][0] * rs, v1 = acc[ai][0][m][1] * rs, g0 = acc[ai][1][m][0] * rs, g1 = acc[ai][1][m][1] * rs;
                    u32x4 w; w.x = cvt_pk_bf16(v0[0] * fsigm(g0[0]), v0[1] * fsigm(g0[1])); w.y = cvt_pk_bf16(v0[2] * fsigm(g0[2]), v0[3] * fsigm(g0[3]));
                    w.z = cvt_pk_bf16(v1[0] * fsigm(g1[0]), v1[1] * fsigm(g1[1])); w.w = cvt_pk_bf16(v1[2] * fsigm(g1[2]), v1[3] * fsigm(g1[3]));
                    *(u32x4*)(base + (size_t)(ai * HALF + m * 16) * 4096) = w; }
        } else {
            const bool act = (u.pn < 12) || (u.pn >= 16);
            bf16_t* base = U + (size_t)(u.pm * BM + wr * 64 + fr) * 4096 + (256 * u.pn - 1024) + wc * 32 + 8 * fq;
#pragma unroll
            for (int ai = 0; ai < 2; ++ai)
#pragma unroll
                for (int m = 0; m < 4; ++m) { const float rs = rt[ai * HALF + m * 16];
#pragma unroll
                    for (int bj = 0; bj < 2; ++bj) { f32x4 v0 = acc[ai][bj][m][0] * rs, v1 = acc[ai][bj][m][1] * rs;
                        if (act) {
#pragma unroll
                            for (int e = 0; e < 4; ++e) { v0[e] = v0[e] * fsigm(v0[e]); v1[e] = v1[e] * fsigm(v1[e]); } }
                        u32x4 w; w.x = cvt_pk_bf16(v0[0], v0[1]); w.y = cvt_pk_bf16(v0[2], v0[3]); w.z = cvt_pk_bf16(v1[0], v1[1]); w.w = cvt_pk_bf16(v1[2], v1[3]);
                        *(u32x4*)(base + (size_t)(ai * HALF + m * 16) * 4096 + bj * HALF) = w; } }
        }
    }
};
struct EpiOut {
    static constexpr bool PERM = true, AFTER_DRAIN = false;
    const float* xold; float* out; bf16_t* XB; float* ssq;
    __device__ __forceinline__ void operator()(const f32x4 (&acc)[2][2][4][2], const Unit& u, int wr, int wc, int fr, int fq, int) const {
#pragma unroll
        for (int ai = 0; ai < 2; ++ai)
#pragma unroll
            for (int m = 0; m < 4; ++m) { const int row = u.pm * BM + ai * HALF + wr * 64 + m * 16 + fr; const size_t off = (size_t)row * 2048 + u.pn * BM + wc * 32 + 8 * fq; float s = 0.f;
#pragma unroll
                for (int bj = 0; bj < 2; ++bj) { const f32x4 x0 = *(const f32x4*)(xold + off + bj * HALF), x1 = *(const f32x4*)(xold + off + bj * HALF + 4);
                    const f32x4 v0 = x0 + acc[ai][bj][m][0], v1 = x1 + acc[ai][bj][m][1];
                    *(f32x4*)(out + off + bj * HALF) = v0; *(f32x4*)(out + off + bj * HALF + 4) = v1;
                    u32x4 w; w.x = cvt_pk_bf16(v0[0], v0[1]); w.y = cvt_pk_bf16(v0[2], v0[3]); w.z = cvt_pk_bf16(v1[0], v1[1]); w.w = cvt_pk_bf16(v1[2], v1[3]);
                    *(u32x4*)(XB + off + bj * HALF) = w;
                    s += (v0[0] * v0[0] + v0[1] * v0[1]) + (v0[2] * v0[2] + v0[3] * v0[3]) + (v1[0] * v1[0] + v1[1] * v1[1]) + (v1[2] * v1[2] + v1[3] * v1[3]); }
                s += __shfl_xor(s, 16); s += __shfl_xor(s, 32);
                if (fq == 0) ssq[(size_t)(u.pn * 4 + wc) * 8192 + row] = s;
                if (m & 1) asm volatile("" ::: "memory"); }
    }
};

template <class Epi, class Sched, bool ALIGN_EPI = false, bool SP2 = false>
__device__ __forceinline__ void gemm_phase(PG8_LAS unsigned char* lds, const Gemm g, const Sched& S, const Epi& E, const int wave_in) {
    const int tid = opaque_tid(wave_in), wid = wave_in,
        lane = tid & 63, wr = wid >> 2, wc = wid & 3, fr = lane & 15, fq = lane >> 4;
    const int K = g.K, nt = K / BK;
    unsigned voffA[2], voffB[2];
#pragma unroll
    for (int i = 0; i < 2; ++i) { int R, C; stage_rc(tid * 16 + i * 8192, R, C); const int Rb = Epi::PERM ? ((R & ~31) + perm32(R & 31)) : R;
        voffA[i] = (unsigned)(R * K + C) * 2u; voffB[i] = (unsigned)(Rb * K + C) * 2u; }
    const size_t kstep = (size_t)(BK * 2);
    const size_t hstep = (size_t)HALF * K * 2;
    const size_t tstep = 2 * hstep;
    const unsigned ldsw = (unsigned)wid * 1024u;
    const int aoff = lds_byte(wr * 64 + fr, fq * 8), boff = lds_byte(wc * 32 + fr, fq * 8);
#define PG8_SA(b, h) (((b) * 2 + (h)) * HTB)
#define PG8_SB(b, h) ((4 + (b) * 2 + (h)) * HTB)
#define PG8_STAGE(bufoff, gbase, voff) do { _Pragma("unroll") for (int _i = 0; _i < 2; ++_i) \
        __builtin_amdgcn_global_load_lds((const unsigned*)((const char*)(gbase) + (voff)[_i]), (PG8_LAS unsigned*)(lds + (bufoff) + ldsw + _i * 8192), 16, 0, 0); } while (0)
#define PG8_LDA(dst, b, h) do { _Pragma("unroll") for (int m = 0; m < 4; ++m) _Pragma("unroll") for (int k = 0; k < 2; ++k) dst[m][k] = *(const PG8_LAS bf16x8*)(lds + PG8_SA(b, h) + aoff + m * 2048 + k * 1024); } while (0)
#define PG8_LDB(dst, b, h) do { _Pragma("unroll") for (int n = 0; n < 2; ++n) _Pragma("unroll") for (int k = 0; k < 2; ++k) dst[n][k] = *(const PG8_LAS bf16x8*)(lds + PG8_SB(b, h) + boff + n * 2048 + k * 1024); } while (0)
#define PG8_MMA(ai, bj, At, Bt) do { __builtin_amdgcn_s_setprio(1); _Pragma("unroll") for (int m = 0; m < 4; ++m) _Pragma("unroll") for (int n = 0; n < 2; ++n) _Pragma("unroll") for (int k = 0; k < 2; ++k) \
        acc[ai][bj][m][n] = __builtin_amdgcn_mfma_f32_16x16x32_bf16(Bt[n][k], At[m][k], acc[ai][bj][m][n], 0, 0, 0); __builtin_amdgcn_s_setprio(0); } while (0)
#define PG8_WAIT_V(n) asm volatile("s_waitcnt vmcnt(" #n ")" ::: "memory")
#define PG8_WAIT_L(n) asm volatile("s_waitcnt lgkmcnt(" #n ")" ::: "memory")
#define PG8_BAR __builtin_amdgcn_s_barrier()
#define PG8_SCHED __builtin_amdgcn_sched_barrier(0)
    Unit cur, nxt; int ui = 0;
    if (!S.next(0, cur)) return;
    f32x4 acc[2][2][4][2];
#pragma unroll
    for (int a = 0; a < 2; ++a)
#pragma unroll
        for (int b = 0; b < 2; ++b)
#pragma unroll
            for (int m = 0; m < 4; ++m)
#pragma unroll
                for (int n = 0; n < 2; ++n) acc[a][b][m][n] = (f32x4){0.f, 0.f, 0.f, 0.f};
    bf16x8 At[4][2], B0[2][2], B1[2][2];
    const char* cA = (const char*)g.A + (size_t)cur.pm * tstep; const char* cB = (const char*)g.Bt + (size_t)cur.pn * tstep;
    S.a_ready(cur, 0);
    if constexpr (SP2) {
        PG8_STAGE(PG8_SB(0, 0), cB, voffB); PG8_STAGE(PG8_SB(0, 1), cB + hstep, voffB); PG8_STAGE(PG8_SA(0, 0), cA, voffA); PG8_STAGE(PG8_SA(0, 1), cA + hstep, voffA);
        if (wr == 1) PG8_BAR;
        PG8_WAIT_V(2); PG8_BAR;
        PG8_STAGE(PG8_SB(1, 0), cB + kstep, voffB); PG8_STAGE(PG8_SA(1, 0), cA + kstep, voffA); PG8_STAGE(PG8_SB(1, 1), cB + hstep + kstep, voffB);
        PG8_WAIT_V(6); PG8_BAR;
    } else {
        PG8_STAGE(PG8_SB(0, 0), cB, voffB); PG8_STAGE(PG8_SA(0, 0), cA, voffA); PG8_STAGE(PG8_SB(0, 1), cB + hstep, voffB); PG8_STAGE(PG8_SA(0, 1), cA + hstep, voffA);
        if (wr == 1) PG8_BAR;
        PG8_WAIT_V(4); PG8_BAR;
        PG8_STAGE(PG8_SB(1, 0), cB + kstep, voffB); PG8_STAGE(PG8_SA(1, 0), cA + kstep, voffA); PG8_STAGE(PG8_SB(1, 1), cB + hstep + kstep, voffB);
        PG8_WAIT_V(6); PG8_BAR;
    }
    for (;;) {
        const bool has_next = S.next(ui + 1, nxt);
        const char* nA = has_next ? (const char*)g.A + (size_t)nxt.pm * tstep : cA; const char* nB = has_next ? (const char*)g.Bt + (size_t)nxt.pn * tstep : cB;
        for (int t = 0; t < nt; t += 2) {
            const bool last = (t == nt - 2);
            const char* a1 = cA + (size_t)(t + 1) * kstep;
            const char* a2 = last ? nA : cA + (size_t)(t + 2) * kstep; const char* b2 = last ? nB : cB + (size_t)(t + 2) * kstep;
            const char* a3 = a2 + kstep; const char* b3 = b2 + kstep;
            if (last && has_next) S.a_ready(nxt, ui + 1);
            if constexpr (SP2) {
            PG8_LDB(B0, 0, 0); PG8_LDB(B1, 0, 1); PG8_SCHED; PG8_LDA(At, 0, 0); PG8_STAGE(PG8_SA(1, 1), a1 + hstep, voffA);
            PG8_WAIT_V(8); PG8_WAIT_L(0); PG8_BAR; PG8_MMA(0, 0, At, B0); PG8_MMA(0, 1, At, B1); PG8_BAR; PG8_SCHED;
            PG8_LDA(At, 0, 1); PG8_STAGE(PG8_SB(0, 0), b2, voffB); PG8_STAGE(PG8_SB(0, 1), b2 + hstep, voffB); PG8_STAGE(PG8_SA(0, 0), a2, voffA);
            PG8_WAIT_V(8); PG8_WAIT_L(0); PG8_BAR; PG8_MMA(1, 0, At, B0); PG8_MMA(1, 1, At, B1); PG8_BAR; PG8_SCHED;
            PG8_LDB(B0, 1, 0); PG8_LDB(B1, 1, 1); PG8_SCHED; PG8_LDA(At, 1, 0); PG8_STAGE(PG8_SA(0, 1), a2 + hstep, voffA);
            PG8_WAIT_V(8); PG8_WAIT_L(0); PG8_BAR; PG8_MMA(0, 0, At, B0); PG8_MMA(0, 1, At, B1); PG8_BAR; PG8_SCHED;
            PG8_LDA(At, 1, 1); PG8_STAGE(PG8_SB(1, 0), b3, voffB); PG8_STAGE(PG8_SB(1, 1), b3 + hstep, voffB); PG8_STAGE(PG8_SA(1, 0), a3, voffA);
            PG8_WAIT_V(8); PG8_WAIT_L(0); PG8_BAR; PG8_MMA(1, 0, At, B0); PG8_MMA(1, 1, At, B1); PG8_BAR; PG8_SCHED;
            } else {
            PG8_LDB(B0, 0, 0); PG8_SCHED; PG8_LDA(At, 0, 0); PG8_STAGE(PG8_SA(1, 1), a1 + hstep, voffA);
            PG8_WAIT_L(8); PG8_BAR; PG8_WAIT_L(0); PG8_MMA(0, 0, At, B0); PG8_BAR; PG8_SCHED;
            PG8_LDB(B1, 0, 1); PG8_STAGE(PG8_SB(0, 0), b2, voffB);
            PG8_BAR; PG8_WAIT_L(0); PG8_MMA(0, 1, At, B1); PG8_BAR;
            PG8_LDA(At, 0, 1); PG8_STAGE(PG8_SA(0, 0), a2, voffA);
            PG8_BAR; PG8_WAIT_L(0); PG8_MMA(1, 0, At, B0); PG8_BAR; PG8_SCHED;
            PG8_STAGE(PG8_SB(0, 1), b2 + hstep, voffB);
            PG8_WAIT_V(6); PG8_BAR; PG8_MMA(1, 1, At, B1); PG8_BAR;
            PG8_LDB(B0, 1, 0); PG8_SCHED; PG8_LDA(At, 1, 0); PG8_STAGE(PG8_SA(0, 1), a2 + hstep, voffA);
            PG8_WAIT_L(8); PG8_BAR; PG8_WAIT_L(0); PG8_MMA(0, 0, At, B0); PG8_BAR; PG8_SCHED;
            PG8_LDB(B1, 1, 1); PG8_STAGE(PG8_SB(1, 0), b3, voffB);
            PG8_BAR; PG8_WAIT_L(0); PG8_MMA(0, 1, At, B1); PG8_BAR;
            PG8_LDA(At, 1, 1); PG8_STAGE(PG8_SA(1, 0), a3, voffA);
            PG8_BAR; PG8_WAIT_L(0); PG8_MMA(1, 0, At, B0); PG8_BAR; PG8_SCHED;
            PG8_STAGE(PG8_SB(1, 1), b3 + hstep, voffB);
            PG8_WAIT_V(6); PG8_BAR; PG8_MMA(1, 1, At, B1); PG8_BAR;
            }
        }
        if constexpr (ALIGN_EPI) { if (wr == 0) PG8_BAR; }
        if constexpr (!Epi::AFTER_DRAIN) { E(acc, cur, wr, wc, fr, fq, ui); S.done(cur); }
        if (!has_next) break;
#pragma unroll
        for (int a = 0; a < 2; ++a)
#pragma unroll
            for (int b = 0; b < 2; ++b)
#pragma unroll
                for (int m = 0; m < 4; ++m)
#pragma unroll
                    for (int n = 0; n < 2; ++n) acc[a][b][m][n] = (f32x4){0.f, 0.f, 0.f, 0.f};
        cur = nxt; cA = nA; cB = nB; ++ui;
        if constexpr (ALIGN_EPI) { if (wr == 1) PG8_BAR; }
    }
    PG8_WAIT_V(0);
    if constexpr (!ALIGN_EPI) { if (wr == 0) PG8_BAR; }
    PG8_BAR;
    if constexpr (Epi::AFTER_DRAIN) { E.fused(acc, cur, wr, wc, fr, fq, lds, wid, lane); S.done(cur); }
#undef PG8_SA
#undef PG8_SB
#undef PG8_STAGE
#undef PG8_LDA
#undef PG8_LDB
#undef PG8_MMA
#undef PG8_WAIT_V
#undef PG8_WAIT_L
#undef PG8_BAR
#undef PG8_SCHED
}
}

__device__ __forceinline__ int opaque_tid(int wave) { int ln = __builtin_amdgcn_mbcnt_hi(~0u, __builtin_amdgcn_mbcnt_lo(~0u, 0u)); asm volatile("" : "+v"(ln)); return wave * 64 + ln; }
#define PHASE_TID(F) do { const int _t = opaque_tid((F).wave); (F).tid = _t; (F).lane = _t & 63; } while (0)
__device__ __forceinline__ void transpose_item(const float* W, int K, int N, bf16_t* WT, int dst_row0, int src_col0, const float* gk, LAS float* scr, int k0, int lane) {
    f32x4 v[16]; const int r0 = lane >> 4, c4 = (lane & 15) * 4;
    const float* wp = W + (size_t)(k0 + r0) * N + src_col0 + c4;
#pragma unroll
    for (int i = 0; i < 16; ++i) v[i] = *(const f32x4*)(wp + (size_t)(4 * i) * N);
    if (gk) {
#pragma unroll
        for (int i = 0; i < 16; ++i) v[i] = v[i] * gk[k0 + r0 + 4 * i]; }
#pragma unroll
    for (int i = 0; i < 16; ++i) { LAS float* d = scr + (r0 + 4 * i) * 65 + c4; d[0] = v[i][0]; d[1] = v[i][1]; d[2] = v[i][2]; d[3] = v[i][3]; }
    asm volatile("s_waitcnt lgkmcnt(0)" ::: "memory");
    const int c = lane & 7;
#pragma unroll
    for (int j = 0; j < 8; ++j) { const int n = (lane >> 3) + 8 * j; const LAS float* sp = scr + (8 * c) * 65 + n;
        u32x4 o; o.x = pk2(sp[0 * 65], sp[1 * 65]); o.y = pk2(sp[2 * 65], sp[3 * 65]); o.z = pk2(sp[4 * 65], sp[5 * 65]); o.w = pk2(sp[6 * 65], sp[7 * 65]);
        *(u32x4*)(WT + (size_t)(dst_row0 + n) * K + k0 + 8 * c) = o; }
    asm volatile("s_waitcnt lgkmcnt(0)" ::: "memory");
}
__device__ __forceinline__ void p_prologue(Frame& F) {
    PHASE_TID(F);
    LAS float* scr = (LAS float*)(F.lds + F.wave * 17408);
    const int gw = F.bid * NWAVES + F.wave, NGW = F.G * NWAVES;
    constexpr int I_IN = (D / 64) * (DIN / 64), I_OUT = (D / 64) * (D / 64), I_G = NHEAD * 2 * (HD / 64) * (HD / 64), I_L = I_IN + I_OUT + I_G;
    for (int it = gw; it < DEPTH * I_L; it += NGW) {
        const int l = it / I_L; int r = it % I_L;
        if (r >= I_IN + I_OUT) { r -= I_IN + I_OUT; const int hg = r >> 2, kb = (r >> 1) & 1, nb = r & 1, h = hg >> 1, gsel = hg & 1;
            transpose_item((gsel ? F.wx : F.wa) + (size_t)(l * NHEAD + h) * HD * HD, HD, HD, F.WgT + (size_t)((l * NHEAD + h) * 2 + gsel) * HD * HD, 64 * nb, 64 * nb, nullptr, scr, 64 * kb, F.lane);
        } else if (r < I_IN) { const int kb = r / (DIN / 64), nb = r % (DIN / 64);
            transpose_item(F.w_in + (size_t)l * D * DIN, D, DIN, F.WinT + (size_t)l * DIN * D, 64 * nb, src_col(64 * nb), F.norm_g + l * D, scr, 64 * kb, F.lane);
        } else { r -= I_IN; const int kb = r / (D / 64), nb = r % (D / 64);
            transpose_item(F.w_out + (size_t)l * D * D, D, D, F.WoutT + (size_t)l * D * D, 64 * nb, 64 * nb, nullptr, scr, 64 * kb, F.lane); }
    }
    for (int m = gw; m < S; m += NGW) {
        const f32x4* xr = (const f32x4*)(F.x + (size_t)m * D) + F.lane; u32x2* ob = (u32x2*)(F.XB + (size_t)m * D) + F.lane; float s = 0.f;
#pragma unroll
        for (int j = 0; j < 8; ++j) { const f32x4 v = xr[64 * j]; s += (v.x * v.x + v.y * v.y) + (v.z * v.z + v.w * v.w); u32x2 w; w.x = pk2(v.x, v.y); w.y = pk2(v.z, v.w); ob[64 * j] = w; }
        s = wave_sum(s);
        if (F.lane < 32) F.SSQ[F.lane * S + m] = F.lane == 0 ? s : 0.f;
    }
}

template <int NV> __device__ __forceinline__ void block_sum(float (&v)[NV], LAS float* red  , int wave, int lane) {
#pragma unroll
    for (int i = 0; i < NV; ++i) { const float s = wave_sum(v[i]); if (lane == 0) red[i * 8 + wave] = s; }
    __syncthreads();
#pragma unroll
    for (int i = 0; i < NV; ++i) { const LAS f32x4* p = (const LAS f32x4*)(red + i * 8); const f32x4 a = p[0], b = p[1]; v[i] = ((a.x + a.y) + (a.z + a.w)) + ((b.x + b.y) + (b.z + b.w)); }
    __syncthreads();
}
constexpr int CT = 16;
__device__ __forceinline__ void conv_item(Frame& F, int l, int item) {
    LAS unsigned char* cs = F.lds;
    LAS float* red = (LAS float*)(F.lds + 62 * 2048);
    const int t0 = item * 32, c0 = 2 * F.tid;
    {
        const auto rus = MAKE_RSRC(F.U, (size_t)S * UW * 2); const int c16 = F.tid & 127, rb = F.tid >> 7; u32x4 v[16];
#pragma unroll
        for (int i = 0; i < 16; ++i) { const int row = rb + 4 * i, sidx = t0 - 30 + row; v[i] = (u32x4){0u, 0u, 0u, 0u};
            if (row < 62 && sidx >= 0) v[i] = __builtin_bit_cast(u32x4, __builtin_amdgcn_raw_buffer_load_b128(rus, c16 * 16, sidx * (UW * 2), 0)); }
#pragma unroll
        for (int i = 0; i < 16; ++i) { const int row = rb + 4 * i; if (row < 62) *(LAS u32x4*)(cs + row * 2048 + c16 * 16) = v[i]; }
    }
    __syncthreads();
    float w0[31], w1[31];
    const auto rw = MAKE_RSRC(F.cdw_w + (size_t)l * CW * DC, CW * DC * 4);
#pragma unroll
    for (int j = 0; j < 31; ++j) { const f32x2 t = __builtin_bit_cast(f32x2, __builtin_amdgcn_raw_buffer_load_b64(rw, c0 * 4, (30 - j) * DC * 4, 0)); w0[j] = t.x; w1[j] = t.y; }
    const f32x2 bias = *(const f32x2*)(F.cdw_b + l * DC + c0);
    const f32x2 lg = *(const f32x2*)(F.cln_g + l * DC + c0), lb = *(const f32x2*)(F.cln_b + l * DC + c0);
    const auto ru = MAKE_RSRC(F.U, (size_t)S * UW * 2); const auto ry = MAKE_RSRC(F.Y, (size_t)S * D * 2);
#pragma unroll 1
    for (int hb = 0; hb < 32 / CT; ++hb) {
        float a0[CT], a1[CT];
#pragma unroll
        for (int i = 0; i < CT; ++i) { a0[i] = bias.x; a1[i] = bias.y; }
        const LAS unsigned char* cp = cs + (hb * CT) * 2048 + F.tid * 4;
#pragma unroll
        for (int si = 0; si < CT + 30; ++si) {
            const unsigned cw = *(const LAS unsigned*)(cp + si * 2048);
            const float x0 = bflo(cw), x1 = bfhi(cw);
#pragma unroll
            for (int i = 0; i < CT; ++i) { const int j = i + 30 - si; if (j >= 0 && j <= 30) { a0[i] += w0[j] * x0; a1[i] += w1[j] * x1; } }
        }
        float sv[CT];
#pragma unroll
        for (int i = 0; i < CT; ++i) sv[i] = a0[i] + a1[i];
        block_sum<CT>(sv, red, F.wave, F.lane);
#pragma unroll
        for (int i = 0; i < CT; ++i) { const float mean = sv[i] * (1.f / DC); a0[i] -= mean; a1[i] -= mean; sv[i] = a0[i] * a0[i] + a1[i] * a1[i]; }
        block_sum<CT>(sv, red, F.wave, F.lane);
#pragma unroll
        for (int i = 0; i < CT; ++i) {
            const int t = t0 + hb * CT + i;
            const float rstd = 1.f / sqrtf(sv[i] * (1.f / DC) + LN_EPS);
            const unsigned zw = __builtin_amdgcn_raw_buffer_load_b32(ru, (1024 + c0) * 2, t * (UW * 2), 0);
            const float y0 = siluf(a0[i] * rstd * lg.x + lb.x) * bflo(zw), y1 = siluf(a1[i] * rstd * lg.y + lb.y) * bfhi(zw);
            __builtin_amdgcn_raw_buffer_store_b32(pk2(y0, y1), ry, c0 * 2, t * (D * 2), 0);
        }
    }
    __syncthreads();
}
#define DPP_ROW_SHR(x, oldv, d) __builtin_bit_cast(float, __builtin_amdgcn_update_dpp(__builtin_bit_cast(int, (float)(oldv)), __builtin_bit_cast(int, (float)(x)), 0x110 + (d), 0xf, 0xf, false))
#define DPP_ROW_BCAST15(x) __builtin_bit_cast(float, __builtin_amdgcn_update_dpp(0, __builtin_bit_cast(int, (float)(x)), 0x15F, 0xf, 0xf, false))
__device__ __forceinline__ unsigned* lru_flag(Frame& F, int l, int c, int h) { return F.ctl + CW_LRU + 64 * ((l * NLCH + c) * NHEAD + h); }
__device__ __forceinline__ void lru_item(Frame& F, int l, int item) {
    const int c = item >> 3, h = item & 7, t0 = c * LCH, ch0 = h * HD;
    LAS unsigned char* xhi = F.lds; LAS unsigned char* xlo = F.lds + LCH * XROW;
    const int tid = F.tid, lane = F.lane, w = F.wave, fr = lane & 15, fq = lane >> 4;
    const auto ru = MAKE_RSRC(F.U, (size_t)S * UW * 2); const auto ry = MAKE_RSRC(F.Y, (size_t)S * D * 2);
    const int chl = ch0 + 16 * w + 4 * fq;
    const f32x4 vba = *(const f32x4*)(F.ba + l * DL + chl), vbx = *(const f32x4*)(F.bx + l * DL + chl), vlam = *(const f32x4*)(F.lam + l * DL + chl);
    float c8[4];
#pragma unroll
    for (int j = 0; j < 4; ++j) c8[j] = 8.f * log_sigmoid(vlam[j]);
    {
        const int tg = tid >> 4, cg = tid & 15, tb = 8 * tg;
        const float* cw = F.lcw + (size_t)l * LW * DL + ch0 + 8 * cg;
        f32x4 wk[4][2];
#pragma unroll
        for (int k = 0; k < 4; ++k) { wk[k][0] = *(const f32x4*)(cw + (size_t)k * DL); wk[k][1] = *(const f32x4*)(cw + (size_t)k * DL + 4); }
        const f32x4 bb0 = *(const f32x4*)(F.lcb + l * DL + ch0 + 8 * cg), bb1 = *(const f32x4*)(F.lcb + l * DL + ch0 + 8 * cg + 4);
        u32x4 rows[11];
#pragma unroll
        for (int r = 0; r < 11; ++r) { const int sidx = t0 + tb - 3 + r; rows[r] = (u32x4){0u, 0u, 0u, 0u};
            if (sidx >= 0) rows[r] = __builtin_bit_cast(u32x4, __builtin_amdgcn_raw_buffer_load_b128(ru, (2048 + ch0 + 8 * cg) * 2, sidx * (UW * 2), 0)); }
#pragma unroll
        for (int i = 0; i < 8; ++i) {
            f32x4 a0 = bb0, a1 = bb1;
#pragma unroll
            for (int k = 0; k < 4; ++k) { const u32x4 q = rows[i + k];
                a0[0] += wk[k][0][0] * bflo(q.x); a0[1] += wk[k][0][1] * bfhi(q.x); a0[2] += wk[k][0][2] * bflo(q.y); a0[3] += wk[k][0][3] * bfhi(q.y);
                a1[0] += wk[k][1][0] * bflo(q.z); a1[1] += wk[k][1][1] * bfhi(q.z); a1[2] += wk[k][1][2] * bflo(q.w); a1[3] += wk[k][1][3] * bfhi(q.w); }
            u32x4 hi; hi.x = pk2(a0[0], a0[1]); hi.y = pk2(a0[2], a0[3]); hi.z = pk2(a1[0], a1[1]); hi.w = pk2(a1[2], a1[3]);
            u32x4 lo; lo.x = pk2(a0[0] - bflo(hi.x), a0[1] - bfhi(hi.x)); lo.y = pk2(a0[2] - bflo(hi.y), a0[3] - bfhi(hi.y)); lo.z = pk2(a1[0] - bflo(hi.z), a1[1] - bfhi(hi.z)); lo.w = pk2(a1[2] - bflo(hi.w), a1[3] - bfhi(hi.w));
            *(LAS u32x4*)(xhi + (tb + i) * XROW + cg * 16) = hi; *(LAS u32x4*)(xlo + (tb + i) * XROW + cg * 16) = lo; }
    }
    __syncthreads();
    bf16x8 br[4], bi[4];
    { const bf16_t* wg = F.WgT + (size_t)((l * NHEAD + h) * 2) * HD * HD + (size_t)(16 * w + fr) * HD + 8 * fq;
#pragma unroll
      for (int kk = 0; kk < 4; ++kk) { br[kk] = *(const bf16x8*)(wg + 32 * kk); bi[kk] = *(const bf16x8*)(wg + HD * HD + 32 * kk); } }
    float hl[16][4], pc[16][4], HC[4], PC[4];
#pragma unroll
    for (int j = 0; j < 4; ++j) { HC[j] = 0.f; PC[j] = 1.f; }
#pragma unroll
    for (int m = 0; m < 16; ++m) {
        f32x4 ar = (f32x4){0.f, 0.f, 0.f, 0.f}, ai = (f32x4){0.f, 0.f, 0.f, 0.f};
        const LAS unsigned char* rowp = xhi + (16 * m + fr) * XROW;
#pragma unroll
        for (int kk = 0; kk < 4; ++kk) { const bf16x8 a = *(const LAS bf16x8*)(rowp + (32 * kk + 8 * fq) * 2);
            ar = __builtin_amdgcn_mfma_f32_16x16x32_bf16(br[kk], a, ar, 0, 0, 0); ai = __builtin_amdgcn_mfma_f32_16x16x32_bf16(bi[kk], a, ai, 0, 0, 0); }
        const u32x2 qh = *(const LAS u32x2*)(rowp + (16 * w + 4 * fq) * 2), ql = *(const LAS u32x2*)(rowp + LCH * XROW + (16 * w + 4 * fq) * 2);
        const float xcv[4] = {bflo(qh.x) + bflo(ql.x), bfhi(qh.x) + bfhi(ql.x), bflo(qh.y) + bflo(ql.y), bfhi(qh.y) + bfhi(ql.y)};
#pragma unroll
        for (int j = 0; j < 4; ++j) {
            const float r = pg8::fsigm(ar[j] + vba[j]), ig = pg8::fsigm(ai[j] + vbx[j]), la = c8[j] * r;
            float A = __builtin_amdgcn_exp2f(la * 1.44269504089f), B = __builtin_amdgcn_sqrtf(neg_expm1(2.f * la)) * (ig * xcv[j]);
#define LRU_SCAN_STEP(d) { const float ap = DPP_ROW_SHR(A, 1.0f, d), bp = DPP_ROW_SHR(B, 0.0f, d); B = A * bp + B; A = ap * A; }
            LRU_SCAN_STEP(1) LRU_SCAN_STEP(2) LRU_SCAN_STEP(4) LRU_SCAN_STEP(8)
#undef LRU_SCAN_STEP
            hl[m][j] = B + A * HC[j]; pc[m][j] = A * PC[j];
            HC[j] = DPP_ROW_BCAST15(hl[m][j]); PC[j] = DPP_ROW_BCAST15(pc[m][j]);
        }
    }
    if (fr == 15) { unsigned long long* sp = F.SUM + (size_t)(l * NLCH + c) * DL + chl;
#pragma unroll
        for (int j = 0; j < 4; ++j) __hip_atomic_store(sp + j, ((unsigned long long)__builtin_bit_cast(unsigned, HC[j]) << 32) | __builtin_bit_cast(unsigned, PC[j]), __ATOMIC_RELAXED, __HIP_MEMORY_SCOPE_AGENT); }
    asm volatile("s_waitcnt vmcnt(0)" ::: "memory");
    __syncthreads();
    if (tid == 0) __hip_atomic_store(lru_flag(F, l, c, h), 1u, __ATOMIC_RELAXED, __HIP_MEMORY_SCOPE_AGENT);
    float Hin[4] = {0.f, 0.f, 0.f, 0.f};
    if (c > 0) {
        if (w == 0) {
            unsigned* fp = lru_flag(F, l, lane < c ? lane : 0, h); unsigned spins = 0;
            for (;;) { const unsigned v = __hip_atomic_load(fp, __ATOMIC_RELAXED, __HIP_MEMORY_SCOPE_AGENT); if (__all(v != 0u)) break; __builtin_amdgcn_s_sleep(2); if (++spins > (1u << 20)) break; }
            __builtin_amdgcn_fence(__ATOMIC_ACQUIRE, "agent");
            asm volatile("s_waitcnt vmcnt(0)" ::: "memory");
        }
        __syncthreads();
        const unsigned long long* sp = F.SUM + (size_t)(l * NLCH) * DL + chl;
        u32x4 q[2][2];
#pragma unroll
        for (int g = 0; g < 2; ++g) { const int cc = fr + 16 * g; q[g][0] = (u32x4){0x3f800000u, 0u, 0x3f800000u, 0u}; q[g][1] = q[g][0];
            if (cc < c) { q[g][0] = *(const u32x4*)(sp + (size_t)cc * DL); q[g][1] = *(const u32x4*)(sp + (size_t)cc * DL + 2); } }
#pragma unroll
        for (int j = 0; j < 4; ++j) { float Hq[2];
#pragma unroll
            for (int g = 0; g < 2; ++g) { const u32x4 qq = q[g][j >> 1]; float A = (j & 1) ? u2f(qq.z) : u2f(qq.x), B = (j & 1) ? u2f(qq.w) : u2f(qq.y);
#define LRU_SCAN_STEP(d) { const float ap = DPP_ROW_SHR(A, 1.0f, d), bp = DPP_ROW_SHR(B, 0.0f, d); B = A * bp + B; A = ap * A; }
                LRU_SCAN_STEP(1) LRU_SCAN_STEP(2) LRU_SCAN_STEP(4) LRU_SCAN_STEP(8)
#undef LRU_SCAN_STEP
                const float At = DPP_ROW_BCAST15(A), Bt = DPP_ROW_BCAST15(B);
                Hq[g] = g == 0 ? Bt : At * Hq[0] + Bt; }
            Hin[j] = Hq[1]; }
    }
    const int vo_u = (fr * UW + 3072 + chl) * 2, vo_y = (fr * D + DC + chl) * 2;
#pragma unroll
    for (int m = 0; m < 16; ++m) { const int trow = t0 + 16 * m;
        const u32x2 zq = __builtin_bit_cast(u32x2, __builtin_amdgcn_raw_buffer_load_b64(ru, vo_u, trow * (UW * 2), 0));
        const float y0 = (hl[m][0] + pc[m][0] * Hin[0]) * bflo(zq.x), y1 = (hl[m][1] + pc[m][1] * Hin[1]) * bfhi(zq.x), y2 = (hl[m][2] + pc[m][2] * Hin[2]) * bflo(zq.y), y3 = (hl[m][3] + pc[m][3] * Hin[3]) * bfhi(zq.y);
        u32x2 o; o.x = pk2(y0, y1); o.y = pk2(y2, y3);
        __builtin_amdgcn_raw_buffer_store_b64(o, ry, vo_y, trow * (D * 2), 0); }
    __syncthreads();
}
__device__ __forceinline__ void p_mix(Frame& F, int l) {
    PHASE_TID(F);
    constexpr int NCONV = S / 32, NLRU = NLCH * NHEAD;
    for (int it = F.bid; it < NLRU; it += F.G) { PHASE_TID(F); lru_item(F, l, it); }
    for (int it = F.bid; it < NCONV; it += F.G) { PHASE_TID(F); conv_item(F, l, it); }
}
__device__ __forceinline__ void p_final(Frame& F) {
    PHASE_TID(F);
    const int gw = F.bid * NWAVES + F.wave, NGW = F.G * NWAVES;
    for (int m = gw; m < S; m += NGW) {
        float ss = 0.f;
#pragma unroll
        for (int p = 0; p < 32; ++p) ss += F.SSQ[p * S + m];
        const float rstd = 1.f / sqrtf(ss * (1.f / D) + RMS_EPS);
        f32x4* orow = (f32x4*)(F.out + (size_t)m * D) + F.lane; const f32x4* gr = (const f32x4*)F.final_g + F.lane;
#pragma unroll
        for (int j = 0; j < 8; ++j) orow[64 * j] = orow[64 * j] * rstd * gr[64 * j];
    }
}

constexpr int PH_PER_LAYER = 3, NPH = 1 + DEPTH * PH_PER_LAYER + 1;
struct Args { const float* in[16]; float* out; unsigned char* ws; int ph_lo, ph_hi; };
__global__ void __launch_bounds__(NTHREADS, 2) mk_fwd(Args a) {
    extern __shared__ __attribute__((aligned(16))) unsigned char lds_raw[];
    Frame F;
    F.lds = (LAS unsigned char*)lds_raw;
    F.wave = __builtin_amdgcn_readfirstlane(threadIdx.x >> 6); F.tid = threadIdx.x; F.lane = F.tid & 63; F.bid = blockIdx.x; F.G = gridDim.x;
    F.x = a.in[0]; F.norm_g = a.in[1]; F.w_in = a.in[2]; F.cdw_w = a.in[3]; F.cdw_b = a.in[4]; F.cln_g = a.in[5]; F.cln_b = a.in[6]; F.lcw = a.in[7]; F.lcb = a.in[8];
    F.wa = a.in[9]; F.ba = a.in[10]; F.wx = a.in[11]; F.bx = a.in[12]; F.lam = a.in[13]; F.w_out = a.in[14]; F.final_g = a.in[15]; F.out = a.out;
    unsigned char* ws = a.ws;
    F.WinT = (bf16_t*)(ws + WS_WINT); F.WoutT = (bf16_t*)(ws + WS_WOUTT); F.XB = (bf16_t*)(ws + WS_XB); F.U = (bf16_t*)(ws + WS_U); F.Y = (bf16_t*)(ws + WS_Y);
    F.SSQ = (float*)(ws + WS_SSQ); F.SUM = (unsigned long long*)(ws + WS_SUM); F.WgT = (bf16_t*)(ws + WS_WG); F.ctl = (unsigned*)(ws + WS_CTL);
    volatile LAS unsigned* bst = (volatile LAS unsigned*)(F.lds + LDS_BYTES - 64);
    if (F.tid < 16) bst[F.tid] = 0u;
    __syncthreads();
    XcdBarrier bar; bar.bar = (unsigned*)(ws + WS_CTL) + CW_BAR; bar.x = 0; bar.st = bst;
    if (MK_ONE_LAUNCH) bar = xcd_barrier_post((unsigned*)(ws + WS_CTL) + CW_BAR, bst);
    bar.wave = F.wave;
#ifndef PROBE_DUP
#define PROBE_DUP 0
#endif
    for (int ph = a.ph_lo; ph < a.ph_hi; ++ph) {
      const int jj = (ph == 0 || ph == NPH - 1) ? -1 : (ph - 1) % PH_PER_LAYER;
      const int reps = ((PROBE_DUP & 1) && ph == 0) || ((PROBE_DUP & 2) && jj == 0) || ((PROBE_DUP & 4) && jj == 1) ? 2 : 1;
      for (int rep = 0; rep < reps; ++rep) {
        if (rep) xcd_barrier(bar);
        if (ph == 0) p_prologue(F);
        else if (ph == NPH - 1) p_final(F);
        else { const int l = (ph - 1) / PH_PER_LAYER, j = (ph - 1) % PH_PER_LAYER;
            if (j == 0) { pg8::Gemm g{F.XB, F.WinT + (size_t)l * DIN * D, S, DIN, D}; pg8::OrderRstd Sd; Sd.init(S, DIN, F.G, F.bid); Sd.ssq = F.SSQ; Sd.rtab = (LAS float*)(F.lds + pg8::RTAB_OFF); Sd.wave = F.wave;
                pg8::EpiIn E{F.U, (const LAS float*)(F.lds + pg8::RTAB_OFF)};
                pg8::gemm_phase<pg8::EpiIn, pg8::OrderRstd, true, true>(F.lds, g, Sd, E, F.wave); }
            else if (j == 1) p_mix(F, l);
            else { pg8::Gemm g{F.Y, F.WoutT + (size_t)l * D * D, S, D, D}; pg8::StaticOrder Sd; Sd.init(S, D, F.G, F.bid);
                pg8::EpiOut E{l == 0 ? F.x : F.out, F.out, F.XB, F.SSQ};
                pg8::gemm_phase<pg8::EpiOut, pg8::StaticOrder, true, true>(F.lds, g, Sd, E, F.wave); }
        }
      }
        if (ph + 1 < a.ph_hi) xcd_barrier(bar);
    }
}

extern "C" void kernel_launch(void* const* d_in, const int* in_sizes, int n_in, void* d_out, int out_size, void* d_ws, size_t ws_size, hipStream_t stream) {
    static int grid = 0;
    if (grid == 0) {
        if (n_in != 16 || in_sizes[0] != S * D || out_size != S * D || ws_size < WS_END) { fprintf(stderr, "kernel_launch: unexpected shapes (n_in %d, in0 %d, out %d, ws %zu)\n", n_in, n_in > 0 ? in_sizes[0] : -1, out_size, ws_size); grid = -1; return; }
        int dev = 0, cus = 0, per_cu = 0;
        if (hipGetDevice(&dev) != hipSuccess || hipDeviceGetAttribute(&cus, hipDeviceAttributeMultiprocessorCount, dev) != hipSuccess) { grid = -1; return; }
        if (hipFuncSetAttribute((const void*)mk_fwd, hipFuncAttributeMaxDynamicSharedMemorySize, LDS_BYTES) != hipSuccess) { fprintf(stderr, "kernel_launch: hipFuncSetAttribute failed\n"); grid = -1; return; }
        if (hipOccupancyMaxActiveBlocksPerMultiprocessor(&per_cu, (const void*)mk_fwd, NTHREADS, LDS_BYTES) != hipSuccess || per_cu < 1) fprintf(stderr, "kernel_launch: occupancy query says %d per CU\n", per_cu);
        (void)hipGetLastError();
        grid = cus;
    }
    if (grid < 0) return;
    (void)hipMemsetAsync((char*)d_ws + WS_CTL, 0, CTL_ZERO_BYTES, stream);
    Args a{};
    for (int i = 0; i < 16; ++i) a.in[i] = (const float*)d_in[i];
    a.out = (float*)d_out; a.ws = (unsigned char*)d_ws;
#if MK_ONE_LAUNCH
    a.ph_lo = 0; a.ph_hi = NPH;
    hipLaunchKernelGGL(mk_fwd, dim3(grid), dim3(NTHREADS), LDS_BYTES, stream, a);
#else
    for (int ph = 0; ph < NPH; ++ph) { a.ph_lo = ph; a.ph_hi = ph + 1; hipLaunchKernelGGL(mk_fwd, dim3(grid), dim3(NTHREADS), LDS_BYTES, stream, a); }
#endif
}
```

```cpp
#include <hip/hip_runtime.h>
#include <cstdio>
#include <cstdint>

#ifndef MK_ONE_LAUNCH
#define MK_ONE_LAUNCH 1
#endif

#ifndef PROBE_DUP
#define PROBE_DUP 0
#endif
#define LAS __attribute__((address_space(3)))
#define GAS __attribute__((address_space(1)))
typedef unsigned short bf16_t;
typedef short bf16x8 __attribute__((ext_vector_type(8)));
typedef float f32x4 __attribute__((ext_vector_type(4)));
typedef float f32x2 __attribute__((ext_vector_type(2)));
typedef unsigned u32x4 __attribute__((ext_vector_type(4)));
typedef unsigned u32x2 __attribute__((ext_vector_type(2)));

constexpr int S = 8192, D = 2048, DEPTH = 4, DC = 1024, DL = 1024, DIN = 5120, NHEAD = 8, HD = 128, CW = 31, LW = 4;
constexpr int UW = 4096;
constexpr float RMS_EPS = 1e-6f, LN_EPS = 1e-5f;
constexpr int NTHREADS = 512, NWAVES = 8;
constexpr int LDS_BYTES = 147456;
constexpr int LCH = 256, NLCH = S / LCH;
constexpr int XROW = 272;
constexpr int CW_BAR = 4096, CW_LRU = 16384;

constexpr size_t MiB = 1u << 20;
constexpr size_t WS_CTL = 0, CTL_ZERO_BYTES = 1 * MiB;
constexpr size_t WS_WINT = 2 * MiB;
constexpr size_t WS_WOUTT = 82 * MiB;
constexpr size_t WS_XB = 114 * MiB;
constexpr size_t WS_U = 146 * MiB;
constexpr size_t WS_Y = 210 * MiB;
constexpr size_t WS_SSQ = 242 * MiB;
constexpr size_t WS_SUM = 243 * MiB;
constexpr size_t WS_WG = 244 * MiB;
constexpr size_t WS_END = 246 * MiB;

__device__ __forceinline__ int opaque_tid(int wave);
#define MAKE_RSRC(p, bytes) __builtin_amdgcn_make_buffer_rsrc((void*)(p), 0, (int)(bytes), 0x00020000)
__device__ __forceinline__ unsigned f2bf(float f) { unsigned u = __builtin_bit_cast(unsigned, f); return (u + 0x7fffu + ((u >> 16) & 1u)) >> 16; }
__device__ __forceinline__ unsigned pk2(float lo, float hi) { return f2bf(lo) | (f2bf(hi) << 16); }
__device__ __forceinline__ float bflo(unsigned w) { return __builtin_bit_cast(float, w << 16); }
__device__ __forceinline__ float bfhi(unsigned w) { return __builtin_bit_cast(float, w & 0xffff0000u); }
__device__ __forceinline__ float u2f(unsigned u) { return __builtin_bit_cast(float, u); }
__device__ __forceinline__ float bf2f(bf16_t b) { return __builtin_bit_cast(float, (unsigned)b << 16); }
__device__ __forceinline__ float sigm(float x) { return 1.f / (1.f + __expf(-x)); }
__device__ __forceinline__ float siluf(float x) { return x * sigm(x); }
__device__ __forceinline__ float wave_sum(float v) {
#pragma unroll
    for (int o = 1; o < 64; o <<= 1) v += __shfl_xor(v, o);
    return v;
}
__device__ __forceinline__ float neg_expm1(float x) {
    float p = 1.f + x * (1.f / 8.f); p = 1.f + x * (1.f / 7.f) * p; p = 1.f + x * (1.f / 6.f) * p; p = 1.f + x * (1.f / 5.f) * p; p = 1.f + x * 0.25f * p; p = 1.f + x * (1.f / 3.f) * p; p = 1.f + x * 0.5f * p;
    const float big = 1.f - __builtin_amdgcn_exp2f(x * 1.44269504089f);
    return x > -0.35f ? -x * p : big;
}
__device__ __forceinline__ float log_sigmoid(float x) { return fminf(x, 0.f) - log1pf(expf(-fabsf(x))); }
__host__ __device__ __forceinline__ int src_col(int np) { if (np < 2048) { const int p = np >> 8, j = np & 255; return j < 128 ? 128 * p + j : 1024 + 128 * p + (j - 128); } return np; }

#define XB_TMO      128
#define XB_XCNT(j)  (256  + 64 * (j))
#define XB_XSUB(j)  (1280 + 64 * (j))
#define XB_XGEN(j)  (2304 + 64 * (j))
#define XB_TOP      3328
#define XB_TOPGEN   3392
#define XCD_BAR_WORDS 3456
#define XB_SPIN_CAP (1u << 18)
__device__ __forceinline__ unsigned xb_ld(unsigned* p)              { return __hip_atomic_load(p, __ATOMIC_RELAXED, __HIP_MEMORY_SCOPE_AGENT); }
__device__ __forceinline__ unsigned xb_add(unsigned* p, unsigned v) { return __hip_atomic_fetch_add(p, v, __ATOMIC_RELAXED, __HIP_MEMORY_SCOPE_AGENT); }
__device__ __forceinline__ unsigned xb_xcc_id() { return (unsigned)__builtin_amdgcn_s_getreg((3 << 11) | 20) & 0xFu; }
#define XB_SPIN(cond, bar) do { unsigned _sp = 0; while (cond) { __builtin_amdgcn_s_sleep(1); \
    if ((++_sp & 255u) == 0u) { if (xb_ld(&(bar)[XB_TMO])) break; if (_sp > XB_SPIN_CAP) { atomicAdd(&(bar)[XB_TMO], 1u); break; } } } } while (0)
struct XcdBarrier { unsigned* bar; unsigned x; volatile LAS unsigned* st; int wave; };
__device__ __forceinline__ XcdBarrier xcd_barrier_post(unsigned* bar, volatile LAS unsigned* st) {
    XcdBarrier b; b.bar = bar; b.x = xb_xcc_id(); b.st = st;
    if (threadIdx.x == 0) (void)xb_add(&bar[XB_XCNT(b.x)], 1u);
    return b;
}
__device__ __forceinline__ void xcd_barrier_complete(unsigned* bar, unsigned x, unsigned& nloc, unsigned& nx) {
    const unsigned G = gridDim.x * gridDim.y * gridDim.z;
    unsigned sum, cnt, mine, sp = 0u;
    for (;;) {
        sum = 0u; cnt = 0u; mine = 0u;
#pragma unroll
        for (unsigned j = 0; j < 16; ++j) { const unsigned c = xb_ld(&bar[XB_XCNT(j)]); sum += c; cnt += (c > 0u) ? 1u : 0u; mine = (j == x) ? c : mine; }
        if (sum == G) break;
        __builtin_amdgcn_s_sleep(1);
        if ((++sp & 255u) == 0u) { if (xb_ld(&bar[XB_TMO])) break; if (sp > XB_SPIN_CAP) { atomicAdd(&bar[XB_TMO], 1u); break; } }
    }
    nloc = mine > 0u ? mine : 1u; nx = cnt > 0u ? cnt : 1u;
}
__device__ __forceinline__ void xcd_barrier(const XcdBarrier& b) {
    asm volatile("s_waitcnt vmcnt(0)" ::: "memory");
    __syncthreads();
    if (opaque_tid(b.wave) == 0) {
        unsigned* bar = b.bar;
        __builtin_amdgcn_s_waitcnt(0);
        unsigned nloc = b.st[0], nx = b.st[1];
        if (nloc == 0u) { xcd_barrier_complete(bar, b.x, nloc, nx); b.st[0] = nloc; b.st[1] = nx; }
        const unsigned old = xb_add(&bar[XB_XSUB(b.x)], 1u);
        const unsigned gen = old / nloc;
        if (old + 1u == (gen + 1u) * nloc) {
            __builtin_amdgcn_fence(__ATOMIC_RELEASE, "agent");
            asm volatile("s_waitcnt vmcnt(0)" ::: "memory");
            const unsigned og = xb_add(&bar[XB_TOP], 1u);
            const unsigned tg = og / nx;
            if (og + 1u == (tg + 1u) * nx) xb_add(&bar[XB_TOPGEN], 1u);
            else XB_SPIN(xb_ld(&bar[XB_TOPGEN]) == tg, bar);
            __builtin_amdgcn_fence(__ATOMIC_ACQUIRE, "agent");
            xb_add(&bar[XB_XGEN(b.x)], 1u);
            asm volatile("s_waitcnt vmcnt(0)" ::: "memory");
        } else {
            XB_SPIN(xb_ld(&bar[XB_XGEN(b.x)]) == gen, bar);
            __builtin_amdgcn_fence(__ATOMIC_ACQUIRE, "agent");
            asm volatile("s_waitcnt vmcnt(0)" ::: "memory");
        }
    }
    __syncthreads();
}

struct Frame {
    LAS unsigned char* lds;
    int tid, lane, wave, bid, G;
    const float *x, *norm_g, *w_in, *cdw_w, *cdw_b, *cln_g, *cln_b, *lcw, *lcb, *wa, *ba, *wx, *bx, *lam, *w_out, *final_g;
    float* out;
    bf16_t *WinT, *WoutT, *XB, *U, *Y;
    float *SSQ; unsigned long long* SUM; bf16_t* WgT; unsigned* ctl;
};

namespace pg8 {
#define PG8_LAS __attribute__((address_space(3)))
typedef unsigned short bf16_t;
typedef short bf16x8 __attribute__((ext_vector_type(8)));
typedef float f32x4 __attribute__((ext_vector_type(4)));
typedef unsigned u32x4 __attribute__((ext_vector_type(4)));
constexpr int BM = 256, BK = 64, HALF = 128, HTB = HALF * BK * 2  , STAGE_BYTES = 8 * HTB, NXCD = 8, WGM = 8;

__host__ __device__ __forceinline__ int lds_byte(int r, int c) { const int st = (r >> 4) * 2 + (c >> 5), rr = r & 15, cc = c & 31, ob = rr * 64 + cc * 2; return st * 1024 + (ob ^ (((ob >> 9) & 1) << 5)); }
__host__ __device__ __forceinline__ void stage_rc(int b, int& R, int& C) { const int st = b / 1024, sb = b % 1024, swz = sb ^ (((sb >> 9) & 1) << 5); R = (st >> 1) * 16 + swz / 64; C = (st & 1) * 32 + (swz % 64) / 2; }
__host__ __device__ __forceinline__ int perm32(int rho) { const int n = rho >> 4, i = rho & 15; return 8 * (i >> 2) + 4 * n + (i & 3); }

struct Unit { int pm, pn; };
struct Gemm { const bf16_t* A; const bf16_t* Bt; int M, N, K; };

struct StaticOrder {
    int nM, nN, nwg, G, c;
    __host__ __device__ void init(int M, int N, int G_, int c_) { nM = M / BM; nN = N / BM; nwg = nM * nN; G = G_; c = c_; }
    __host__ __device__ bool next(int i, Unit& u) const {
        const long L = (long)i * G + c; if (L >= nwg) return false;
        int wgid = (int)L; { const int q = nwg / NXCD, r = nwg % NXCD, xcd = wgid % NXCD, off = wgid / NXCD; wgid = (xcd < r ? xcd * (q + 1) : r * (q + 1) + (xcd - r) * q) + off; }
        const int nig = WGM * nN, gid = wgid / nig, fm = gid * WGM, gsz = (nM - fm) < WGM ? (nM - fm) : WGM;
        u.pm = fm + ((wgid % nig) % gsz); u.pn = (wgid % nig) / gsz; return true;
    }
    __device__ __forceinline__ void a_ready(const Unit&, int) const {}
    __device__ __forceinline__ void done(const Unit&) const {}
};


__device__ __forceinline__ unsigned cvt_pk_bf16(float lo, float hi) { unsigned r; asm volatile("v_cvt_pk_bf16_f32 %0, %1, %2" : "=v"(r) : "v"(lo), "v"(hi)); return r; }
__device__ __forceinline__ float fsigm(float x) { return __builtin_amdgcn_rcpf(1.f + __builtin_amdgcn_exp2f(x * -1.44269504089f)); }
constexpr int RTAB_OFF = STAGE_BYTES;

struct OrderRstd : StaticOrder {
    const float* ssq; PG8_LAS float* rtab; int wave;
    __device__ __forceinline__ void a_ready(const Unit& u, int ui) const {
        const int t_ = opaque_tid(wave), wid = wave, lane = t_ & 63, rl = wid * 32 + (lane & 31), half = lane >> 5;
        const float* p = ssq + (size_t)(half * 16) * 8192 + u.pm * BM + rl; float s = 0.f;
#pragma unroll
        for (int q = 0; q < 16; ++q) s += p[(size_t)q * 8192];
        s += __shfl_xor(s, 32);
        if (lane < 32) rtab[(ui & 1) * 256 + rl] = 1.0f / sqrtf(s * (1.0f / 2048.0f) + 1e-6f);
    }
};
struct EpiIn {
    static constexpr bool PERM = true, AFTER_DRAIN = false;
    bf16_t* U; const PG8_LAS float* rtab;
    __device__ __forceinline__ void operator()(const f32x4 (&acc)[2][2][4][2], const Unit& u, int wr, int wc, int fr, int fq, int ui) const {
        const PG8_LAS float* rt = rtab + (ui & 1) * 256 + wr * 64 + fr;
        if (u.pn < 8) {
            bf16_t* base = U + (size_t)(u.pm * BM + wr * 64 + fr) * 4096 + 128 * u.pn + wc * 32 + 8 * fq;
#pragma unroll
            for (int ai = 0; ai < 2; ++ai)
#pragma unroll
                for (int m = 0; m < 4; ++m) { const float rs = rt[ai * HALF + m * 16];
                    const f32x4 v0 = acc[ai][0][m][0] * rs, v1 = acc[ai][0][m][1] * rs, g0 = acc[ai][1][m][0] * rs, g1 = acc[ai][1][m][1] * rs;
                    u32x4 w; w.x = cvt_pk_bf16(v0[0] * fsigm(g0[0]), v0[1] * fsigm(g0[1])); w.y = cvt_pk_bf16(v0[2] * fsigm(g0[2]), v0[3] * fsigm(g0[3]));
                    w.z = cvt_pk_bf16(v1[0] * fsigm(g1[0]), v1[1] * fsigm(g1[1])); w.w = cvt_pk_bf16(v1[2] * fsigm(g1[2]), v1[3] * fsigm(g1[3]));
                    *(u32x4*)(base + (size_t)(ai * HALF + m * 16) * 4096) = w; }
        } else {
            const bool act = (u.pn < 12) || (u.pn >= 16);
            bf16_t* base = U + (size_t)(u.pm * BM + wr * 64 + fr) * 4096 + (256 * u.pn - 1024) + wc * 32 + 8 * fq;
#pragma unroll
            for (int ai = 0; ai < 2; ++ai)
#pragma unroll
                for (int m = 0; m < 4; ++m) { const float rs = rt[ai * HALF + m * 16];
#pragma unroll
                    for (int bj = 0; bj < 2; ++bj) { f32x4 v0 = acc[ai][bj][m][0] * rs, v1 = acc[ai][bj][m][1] * rs;
                        if (act) {
#pragma unroll
                            for (int e = 0; e < 4; ++e) { v0[e] = v0[e] * fsigm(v0[e]); v1[e] = v1[e] * fsigm(v1[e]); } }
                        u32x4 w; w.x = cvt_pk_bf16(v0[0], v0[1]); w.y = cvt_pk_bf16(v0[2], v0[3]); w.z = cvt_pk_bf16(v1[0], v1[1]); w.w = cvt_pk_bf16(v1[2], v1[3]);
                        *(u32x4*)(base + (size_t)(ai * HALF + m * 16) * 4096 + bj * HALF) = w; } }
        }
    }
};
struct EpiOut {
    static constexpr bool PERM = true, AFTER_DRAIN = false;
    const float* xold; float* out; bf16_t* XB; float* ssq;
    __device__ __forceinline__ void operator()(const f32x4 (&acc)[2][2][4][2], const Unit& u, int wr, int wc, int fr, int fq, int) const {
#pragma unroll
        for (int ai = 0; ai < 2; ++ai)
#pragma unroll
            for (int m = 0; m < 4; ++m) { const int row = u.pm * BM + ai * HALF + wr * 64 + m * 16 + fr; const size_t off = (size_t)row * 2048 + u.pn * BM + wc * 32 + 8 * fq; float s = 0.f;
#pragma unroll
                for (int bj = 0; bj < 2; ++bj) { const f32x4 x0 = *(const f32x4*)(xold + off + bj * HALF), x1 = *(const f32x4*)(xold + off + bj * HALF + 4);
                    const f32x4 v0 = x0 + acc[ai][bj][m][0], v1 = x1 + acc[ai][bj][m][1];
                    *(f32x4*)(out + off + bj * HALF) = v0; *(f32x4*)(out + off + bj * HALF + 4) = v1;
                    u32x4 w; w.x = cvt_pk_bf16(v0[0], v0[1]); w.y = cvt_pk_bf16(v0[2], v0[3]); w.z = cvt_pk_bf16(v1[0], v1[1]); w.w = cvt_pk_bf16(v1[2], v1[3]);
                    *(u32x4*)(XB + off + bj * HALF) = w;
                    s += (v0[0] * v0[0] + v0[1] * v0[1]) + (v0[2] * v0[2] + v0[3] * v0[3]) + (v1[0] * v1[0] + v1[1] * v1[1]) + (v1[2] * v1[2] + v1[3] * v1[3]); }
                s += __shfl_xor(s, 16); s += __shfl_xor(s, 32);
                if (fq == 0) ssq[(size_t)(u.pn * 4 + wc) * 8192 + row] = s;
                if (m & 1) asm volatile("" ::: "memory"); }
    }
};

template <class Epi, class Sched, bool ALIGN_EPI = false, bool SP2 = false>
__device__ __forceinline__ void gemm_phase(PG8_LAS unsigned char* lds, const Gemm g, const Sched& S, const Epi& E, const int wave_in) {
    const int tid = opaque_tid(wave_in), wid = wave_in,
        lane = tid & 63, wr = wid >> 2, wc = wid & 3, fr = lane & 15, fq = lane >> 4;
    const int K = g.K, nt = K / BK;
    unsigned voffA[2], voffB[2];
#pragma unroll
    for (int i = 0; i < 2; ++i) { int R, C; stage_rc(tid * 16 + i * 8192, R, C); const int Rb = Epi::PERM ? ((R & ~31) + perm32(R & 31)) : R;
        voffA[i] = (unsigned)(R * K + C) * 2u; voffB[i] = (unsigned)(Rb * K + C) * 2u; }
    const size_t kstep = (size_t)(BK * 2);
    const size_t hstep = (size_t)HALF * K * 2;
    const size_t tstep = 2 * hstep;
    const unsigned ldsw = (unsigned)wid * 1024u;
    const int aoff = lds_byte(wr * 64 + fr, fq * 8), boff = lds_byte(wc * 32 + fr, fq * 8);
#define PG8_SA(b, h) (((b) * 2 + (h)) * HTB)
#define PG8_SB(b, h) ((4 + (b) * 2 + (h)) * HTB)
#define PG8_STAGE(bufoff, gbase, voff) do { _Pragma("unroll") for (int _i = 0; _i < 2; ++_i) \
        __builtin_amdgcn_global_load_lds((const unsigned*)((const char*)(gbase) + (voff)[_i]), (PG8_LAS unsigned*)(lds + (bufoff) + ldsw + _i * 8192), 16, 0, 0); } while (0)
#define PG8_LDA(dst, b, h) do { _Pragma("unroll") for (int m = 0; m < 4; ++m) _Pragma("unroll") for (int k = 0; k < 2; ++k) dst[m][k] = *(const PG8_LAS bf16x8*)(lds + PG8_SA(b, h) + aoff + m * 2048 + k * 1024); } while (0)
#define PG8_LDB(dst, b, h) do { _Pragma("unroll") for (int n = 0; n < 2; ++n) _Pragma("unroll") for (int k = 0; k < 2; ++k) dst[n][k] = *(const PG8_LAS bf16x8*)(lds + PG8_SB(b, h) + boff + n * 2048 + k * 1024); } while (0)
#define PG8_MMA(ai, bj, At, Bt) do { __builtin_amdgcn_s_setprio(1); _Pragma("unroll") for (int m = 0; m < 4; ++m) _Pragma("unroll") for (int n = 0; n < 2; ++n) _Pragma("unroll") for (int k = 0; k < 2; ++k) \
        acc[ai][bj][m][n] = __builtin_amdgcn_mfma_f32_16x16x32_bf16(Bt[n][k], At[m][k], acc[ai][bj][m][n], 0, 0, 0); __builtin_amdgcn_s_setprio(0); } while (0)
#define PG8_WAIT_V(n) asm volatile("s_waitcnt vmcnt(" #n ")" ::: "memory")
#define PG8_WAIT_L(n) asm volatile("s_waitcnt lgkmcnt(" #n ")" ::: "memory")
#define PG8_BAR __builtin_amdgcn_s_barrier()
#define PG8_SCHED __builtin_amdgcn_sched_barrier(0)
    Unit cur, nxt; int ui = 0;
    if (!S.next(0, cur)) return;
    f32x4 acc[2][2][4][2];
#pragma unroll
    for (int a = 0; a < 2; ++a)
#pragma unroll
        for (int b = 0; b < 2; ++b)
#pragma unroll
            for (int m = 0; m < 4; ++m)
#pragma unroll
                for (int n = 0; n < 2; ++n) acc[a][b][m][n] = (f32x4){0.f, 0.f, 0.f, 0.f};
    bf16x8 At[4][2], B0[2][2], B1[2][2];
    const char* cA = (const char*)g.A + (size_t)cur.pm * tstep; const char* cB = (const char*)g.Bt + (size_t)cur.pn * tstep;
    S.a_ready(cur, 0);
    if constexpr (SP2) {
        PG8_STAGE(PG8_SB(0, 0), cB, voffB); PG8_STAGE(PG8_SB(0, 1), cB + hstep, voffB); PG8_STAGE(PG8_SA(0, 0), cA, voffA); PG8_STAGE(PG8_SA(0, 1), cA + hstep, voffA);
        if (wr == 1) PG8_BAR;
        PG8_WAIT_V(2); PG8_BAR;
        PG8_STAGE(PG8_SB(1, 0), cB + kstep, voffB); PG8_STAGE(PG8_SA(1, 0), cA + kstep, voffA); PG8_STAGE(PG8_SB(1, 1), cB + hstep + kstep, voffB);
        PG8_WAIT_V(6); PG8_BAR;
    } else {
        PG8_STAGE(PG8_SB(0, 0), cB, voffB); PG8_STAGE(PG8_SA(0, 0), cA, voffA); PG8_STAGE(PG8_SB(0, 1), cB + hstep, voffB); PG8_STAGE(PG8_SA(0, 1), cA + hstep, voffA);
        if (wr == 1) PG8_BAR;
        PG8_WAIT_V(4); PG8_BAR;
        PG8_STAGE(PG8_SB(1, 0), cB + kstep, voffB); PG8_STAGE(PG8_SA(1, 0), cA + kstep, voffA); PG8_STAGE(PG8_SB(1, 1), cB + hstep + kstep, voffB);
        PG8_WAIT_V(6); PG8_BAR;
    }
    for (;;) {
        const bool has_next = S.next(ui + 1, nxt);
        const char* nA = has_next ? (const char*)g.A + (size_t)nxt.pm * tstep : cA; const char* nB = has_next ? (const char*)g.Bt + (size_t)nxt.pn * tstep : cB;
        for (int t = 0; t < nt; t += 2) {
            const bool last = (t == nt - 2);
            const char* a1 = cA + (size_t)(t + 1) * kstep;
            const char* a2 = last ? nA : cA + (size_t)(t + 2) * kstep; const char* b2 = last ? nB : cB + (size_t)(t + 2) * kstep;
            const char* a3 = a2 + kstep; const char* b3 = b2 + kstep;
            if (last && has_next) S.a_ready(nxt, ui + 1);
            if constexpr (SP2) {
            PG8_LDB(B0, 0, 0); PG8_LDB(B1, 0, 1); PG8_SCHED; PG8_LDA(At, 0, 0); PG8_STAGE(PG8_SA(1, 1), a1 + hstep, voffA);
            PG8_WAIT_V(8); PG8_WAIT_L(0); PG8_BAR; PG8_MMA(0, 0, At, B0); PG8_MMA(0, 1, At, B1); PG8_BAR; PG8_SCHED;
            PG8_LDA(At, 0, 1); PG8_STAGE(PG8_SB(0, 0), b2, voffB); PG8_STAGE(PG8_SB(0, 1), b2 + hstep, voffB); PG8_STAGE(PG8_SA(0, 0), a2, voffA);
            PG8_WAIT_V(8); PG8_WAIT_L(0); PG8_BAR; PG8_MMA(1, 0, At, B0); PG8_MMA(1, 1, At, B1); PG8_BAR; PG8_SCHED;
            PG8_LDB(B0, 1, 0); PG8_LDB(B1, 1, 1); PG8_SCHED; PG8_LDA(At, 1, 0); PG8_STAGE(PG8_SA(0, 1), a2 + hstep, voffA);
            PG8_WAIT_V(8); PG8_WAIT_L(0); PG8_BAR; PG8_MMA(0, 0, At, B0); PG8_MMA(0, 1, At, B1); PG8_BAR; PG8_SCHED;
            PG8_LDA(At, 1, 1); PG8_STAGE(PG8_SB(1, 0), b3, voffB); PG8_STAGE(PG8_SB(1, 1), b3 + hstep, voffB); PG8_STAGE(PG8_SA(1, 0), a3, voffA);
            PG8_WAIT_V(8); PG8_WAIT_L(0); PG8_BAR; PG8_MMA(1, 0, At, B0); PG8_MMA(1, 1, At, B1); PG8_BAR; PG8_SCHED;
            } else {
            PG8_LDB(B0, 0, 0); PG8_SCHED; PG8_LDA(At, 0, 0); PG8_STAGE(PG8_SA(1, 1), a1 + hstep, voffA);
            PG8_WAIT_L(8); PG8_BAR; PG8_WAIT_L(0); PG8_MMA(0, 0, At, B0); PG8_BAR; PG8_SCHED;
            PG8_LDB(B1, 0, 1); PG8_STAGE(PG8_SB(0, 0), b2, voffB);
            PG8_BAR; PG8_WAIT_L(0); PG8_MMA(0, 1, At, B1); PG8_BAR;
            PG8_LDA(At, 0, 1); PG8_STAGE(PG8_SA(0, 0), a2, voffA);
            PG8_BAR; PG8_WAIT_L(0); PG8_MMA(1, 0, At, B0); PG8_BAR; PG8_SCHED;
            PG8_STAGE(PG8_SB(0, 1), b2 + hstep, voffB);
            PG8_WAIT_V(6); PG8_BAR; PG8_MMA(1, 1, At, B1); PG8_BAR;
            PG8_LDB(B0, 1, 0); PG8_SCHED; PG8_LDA(At, 1, 0); PG8_STAGE(PG8_SA(0, 1), a2 + hstep, voffA);
            PG8_WAIT_L(8); PG8_BAR; PG8_WAIT_L(0); PG8_MMA(0, 0, At, B0); PG8_BAR; PG8_SCHED;
            PG8_LDB(B1, 1, 1); PG8_STAGE(PG8_SB(1, 0), b3, voffB);
            PG8_BAR; PG8_WAIT_L(0); PG8_MMA(0, 1, At, B1); PG8_BAR;
            PG8_LDA(At, 1, 1); PG8_STAGE(PG8_SA(1, 0), a3, voffA);
            PG8_BAR; PG8_WAIT_L(0); PG8_MMA(1, 0, At, B0); PG8_BAR; PG8_SCHED;
            PG8_STAGE(PG8_SB(1, 1), b3 + hstep, voffB);
            PG8_WAIT_V(6); PG8_BAR; PG8_MMA(1, 1, At, B1); PG8_BAR;
            }
        }
        if constexpr (ALIGN_EPI) { if (wr == 0) PG8_BAR; }
        if constexpr (!Epi::AFTER_DRAIN) { E(acc, cur, wr, wc, fr, fq, ui); S.done(cur); }
        if (!has_next) break;
#pragma unroll
        for (int a = 0; a < 2; ++a)
#pragma unroll
            for (int b = 0; b < 2; ++b)
#pragma unroll
                for (int m = 0; m < 4; ++m)
#pragma unroll
                    for (int n = 0; n < 2; ++n) acc[a][b][m][n] = (f32x4){0.f, 0.f, 0.f, 0.f};
        cur = nxt; cA = nA; cB = nB; ++ui;
        if constexpr (ALIGN_EPI) { if (wr == 1) PG8_BAR; }
    }
    PG8_WAIT_V(0);
    if constexpr (!ALIGN_EPI) { if (wr == 0) PG8_BAR; }
    PG8_BAR;
    if constexpr (Epi::AFTER_DRAIN) { E.fused(acc, cur, wr, wc, fr, fq, lds, wid, lane); S.done(cur); }
#undef PG8_SA
#undef PG8_SB
#undef PG8_STAGE
#undef PG8_LDA
#undef PG8_LDB
#undef PG8_MMA
#undef PG8_WAIT_V
#undef PG8_WAIT_L
#undef PG8_BAR
#undef PG8_SCHED
}
}

__device__ __forceinline__ int opaque_tid(int wave) { int ln = __builtin_amdgcn_mbcnt_hi(~0u, __builtin_amdgcn_mbcnt_lo(~0u, 0u)); asm volatile("" : "+v"(ln)); return wave * 64 + ln; }
#define PHASE_TID(F) do { const int _t = opaque_tid((F).wave); (F).tid = _t; (F).lane = _t & 63; } while (0)
__device__ __forceinline__ void transpose_item(const float* W, int K, int N, bf16_t* WT, int dst_row0, int src_col0, const float* gk, LAS float* scr, int k0, int lane) {
    f32x4 v[16]; const int r0 = lane >> 4, c4 = (lane & 15) * 4;
    const float* wp = W + (size_t)(k0 + r0) * N + src_col0 + c4;
#pragma unroll
    for (int i = 0; i < 16; ++i) v[i] = *(const f32x4*)(wp + (size_t)(4 * i) * N);
    if (gk) {
#pragma unroll
        for (int i = 0; i < 16; ++i) v[i] = v[i] * gk[k0 + r0 + 4 * i]; }
#pragma unroll
    for (int i = 0; i < 16; ++i) { LAS float* d = scr + (r0 + 4 * i) * 65 + c4; d[0] = v[i][0]; d[1] = v[i][1]; d[2] = v[i][2]; d[3] = v[i][3]; }
    asm volatile("s_waitcnt lgkmcnt(0)" ::: "memory");
    const int c = lane & 7;
#pragma unroll
    for (int j = 0; j < 8; ++j) { const int n = (lane >> 3) + 8 * j; const LAS float* sp = scr + (8 * c) * 65 + n;
        u32x4 o; o.x = pk2(sp[0 * 65], sp[1 * 65]); o.y = pk2(sp[2 * 65], sp[3 * 65]); o.z = pk2(sp[4 * 65], sp[5 * 65]); o.w = pk2(sp[6 * 65], sp[7 * 65]);
        *(u32x4*)(WT + (size_t)(dst_row0 + n) * K + k0 + 8 * c) = o; }
    asm volatile("s_waitcnt lgkmcnt(0)" ::: "memory");
}
__device__ __forceinline__ void p_prologue(Frame& F) {
    PHASE_TID(F);
    LAS float* scr = (LAS float*)(F.lds + F.wave * 17408);
    const int gw = F.bid * NWAVES + F.wave, NGW = F.G * NWAVES;
    constexpr int I_IN = (D / 64) * (DIN / 64), I_OUT = (D / 64) * (D / 64), I_G = NHEAD * 2 * (HD / 64) * (HD / 64), I_L = I_IN + I_OUT + I_G;
    for (int it = gw; it < DEPTH * I_L; it += NGW) {
        const int l = it / I_L; int r = it % I_L;
        if (r >= I_IN + I_OUT) { r -= I_IN + I_OUT; const int hg = r >> 2, kb = (r >> 1) & 1, nb = r & 1, h = hg >> 1, gsel = hg & 1;
            transpose_item((gsel ? F.wx : F.wa) + (size_t)(l * NHEAD + h) * HD * HD, HD, HD, F.WgT + (size_t)((l * NHEAD + h) * 2 + gsel) * HD * HD, 64 * nb, 64 * nb, nullptr, scr, 64 * kb, F.lane);
        } else if (r < I_IN) { const int kb = r / (DIN / 64), nb = r % (DIN / 64);
            transpose_item(F.w_in + (size_t)l * D * DIN, D, DIN, F.WinT + (size_t)l * DIN * D, 64 * nb, src_col(64 * nb), F.norm_g + l * D, scr, 64 * kb, F.lane);
        } else { r -= I_IN; const int kb = r / (D / 64), nb = r % (D / 64);
            transpose_item(F.w_out + (size_t)l * D * D, D, D, F.WoutT + (size_t)l * D * D, 64 * nb, 64 * nb, nullptr, scr, 64 * kb, F.lane); }
    }
    for (int m = gw; m < S; m += NGW) {
        const f32x4* xr = (const f32x4*)(F.x + (size_t)m * D) + F.lane; u32x2* ob = (u32x2*)(F.XB + (size_t)m * D) + F.lane; float s = 0.f;
#pragma unroll
        for (int j = 0; j < 8; ++j) { const f32x4 v = xr[64 * j]; s += (v.x * v.x + v.y * v.y) + (v.z * v.z + v.w * v.w); u32x2 w; w.x = pk2(v.x, v.y); w.y = pk2(v.z, v.w); ob[64 * j] = w; }
        s = wave_sum(s);
        if (F.lane < 32) F.SSQ[F.lane * S + m] = F.lane == 0 ? s : 0.f;
    }
}

#define DPP_MOV(x, ctrl) __builtin_bit_cast(float, __builtin_amdgcn_update_dpp(0, __builtin_bit_cast(int, (float)(x)), (ctrl), 0xf, 0xf, true))
template <int NV> __device__ __forceinline__ void block_sum(float (&v)[NV], LAS float* red  , int wave, int lane) {
#pragma unroll
    for (int i = 0; i < NV; ++i) v[i] += DPP_MOV(v[i], 0x128);
#pragma unroll
    for (int i = 0; i < NV; ++i) v[i] += DPP_MOV(v[i], 0x124);
#pragma unroll
    for (int i = 0; i < NV; ++i) v[i] += DPP_MOV(v[i], 0x4E);
#pragma unroll
    for (int i = 0; i < NV; ++i) v[i] += DPP_MOV(v[i], 0xB1);
    __builtin_amdgcn_sched_barrier(0);
    float t[NV];
#pragma unroll
    for (int i = 0; i < NV; ++i) t[i] = __shfl_xor(v[i], 16);
#pragma unroll
    for (int i = 0; i < NV; ++i) v[i] += t[i];
    __builtin_amdgcn_sched_barrier(0);
#pragma unroll
    for (int i = 0; i < NV; ++i) t[i] = __shfl_xor(v[i], 32);
#pragma unroll
    for (int i = 0; i < NV; ++i) v[i] += t[i];
    __builtin_amdgcn_sched_barrier(0);
    if (lane == 0) {
#pragma unroll
        for (int i = 0; i < NV; ++i) red[i * 8 + wave] = v[i]; }
    __syncthreads();
#pragma unroll
    for (int i = 0; i < NV; ++i) { const LAS f32x4* p = (const LAS f32x4*)(red + i * 8); const f32x4 a = p[0], b = p[1]; v[i] = ((a.x + a.y) + (a.z + a.w)) + ((b.x + b.y) + (b.z + b.w)); }
    __syncthreads();
}
constexpr int CT = 16;
__device__ __forceinline__ void conv_item(Frame& F, int l, int item) {
    LAS unsigned char* cs = F.lds;
    LAS float* red = (LAS float*)(F.lds + 62 * 2048);
    const int t0 = item * 32, c0 = 2 * F.tid;
    const auto rus = MAKE_RSRC(F.U, (size_t)S * UW * 2); const int c16 = F.tid & 127, rb = F.tid >> 7; u32x4 v[16];
#pragma unroll
    for (int i = 0; i < 16; ++i) { const int row = rb + 4 * i, sidx = t0 - 30 + row; v[i] = (u32x4){0u, 0u, 0u, 0u};
        if (row < 62 && sidx >= 0) v[i] = __builtin_bit_cast(u32x4, __builtin_amdgcn_raw_buffer_load_b128(rus, c16 * 16, sidx * (UW * 2), 0)); }
    f32x2 wv[31];
    const auto rw = MAKE_RSRC(F.cdw_w + (size_t)l * CW * DC, CW * DC * 4);
#pragma unroll
    for (int j = 0; j < 31; ++j) wv[j] = __builtin_bit_cast(f32x2, __builtin_amdgcn_raw_buffer_load_b64(rw, c0 * 4, (30 - j) * DC * 4, 0));
    const f32x2 bias = *(const f32x2*)(F.cdw_b + l * DC + c0);
    const f32x2 lg = *(const f32x2*)(F.cln_g + l * DC + c0), lb = *(const f32x2*)(F.cln_b + l * DC + c0);
    const auto ru = MAKE_RSRC(F.U, (size_t)S * UW * 2); const auto ry = MAKE_RSRC(F.Y, (size_t)S * D * 2);
    unsigned zwq[32];
#pragma unroll
    for (int i = 0; i < 32; ++i) zwq[i] = __builtin_amdgcn_raw_buffer_load_b32(ru, (1024 + c0) * 2, (t0 + i) * (UW * 2), 0);
#pragma unroll
    for (int i = 0; i < 16; ++i) { const int row = rb + 4 * i; if (row < 62) *(LAS u32x4*)(cs + row * 2048 + c16 * 16) = v[i]; }
    __syncthreads();
#pragma unroll 1
    for (int hb_ = 0; hb_ < ((PROBE_DUP & 64) ? 2 : 1) * (32 / CT); ++hb_) { const int hb = hb_ % (32 / CT);
        f32x2 acc[CT];
#pragma unroll
        for (int i = 0; i < CT; ++i) acc[i] = bias;
        const LAS unsigned char* cp = cs + (hb * CT) * 2048 + F.tid * 4;
        unsigned cwq[CT + 30];
#pragma unroll
        for (int si = 0; si < CT + 30; ++si) cwq[si] = *(const LAS unsigned*)(cp + si * 2048);
        static_assert(CT + 30 == 46, "operand lists below");
        asm volatile("" : "+v"(cwq[0]), "+v"(cwq[1]), "+v"(cwq[2]), "+v"(cwq[3]), "+v"(cwq[4]), "+v"(cwq[5]), "+v"(cwq[6]), "+v"(cwq[7]), "+v"(cwq[8]), "+v"(cwq[9]), "+v"(cwq[10]), "+v"(cwq[11]), "+v"(cwq[12]), "+v"(cwq[13]), "+v"(cwq[14]), "+v"(cwq[15]));
        asm volatile("" : "+v"(cwq[16]), "+v"(cwq[17]), "+v"(cwq[18]), "+v"(cwq[19]), "+v"(cwq[20]), "+v"(cwq[21]), "+v"(cwq[22]), "+v"(cwq[23]), "+v"(cwq[24]), "+v"(cwq[25]), "+v"(cwq[26]), "+v"(cwq[27]), "+v"(cwq[28]), "+v"(cwq[29]), "+v"(cwq[30]), "+v"(cwq[31]));
        asm volatile("" : "+v"(cwq[32]), "+v"(cwq[33]), "+v"(cwq[34]), "+v"(cwq[35]), "+v"(cwq[36]), "+v"(cwq[37]), "+v"(cwq[38]), "+v"(cwq[39]), "+v"(cwq[40]), "+v"(cwq[41]), "+v"(cwq[42]), "+v"(cwq[43]), "+v"(cwq[44]), "+v"(cwq[45]));
#pragma unroll
        for (int si = 0; si < CT + 30; ++si) {
            const unsigned cw = cwq[si];
            const f32x2 xv = (f32x2){bflo(cw), bfhi(cw)};
#pragma unroll
            for (int i = 0; i < CT; ++i) { const int j = i + 30 - si; if (j >= 0 && j <= 30) acc[i] = wv[j] * xv + acc[i]; }
            static_assert(CT == 16, "operand list below");
            asm volatile("" : "+v"(acc[0]), "+v"(acc[1]), "+v"(acc[2]), "+v"(acc[3]), "+v"(acc[4]), "+v"(acc[5]), "+v"(acc[6]), "+v"(acc[7]),
                              "+v"(acc[8]), "+v"(acc[9]), "+v"(acc[10]), "+v"(acc[11]), "+v"(acc[12]), "+v"(acc[13]), "+v"(acc[14]), "+v"(acc[15]));
        }
        float a0[CT], a1[CT];
#pragma unroll
        for (int i = 0; i < CT; ++i) { a0[i] = acc[i].x; a1[i] = acc[i].y; }
        float sv[CT];
#pragma unroll
        for (int i = 0; i < CT; ++i) sv[i] = a0[i] + a1[i];
        block_sum<CT>(sv, red, F.wave, F.lane);
#pragma unroll
        for (int i = 0; i < CT; ++i) { const float mean = sv[i] * (1.f / DC); a0[i] -= mean; a1[i] -= mean; sv[i] = a0[i] * a0[i] + a1[i] * a1[i]; }
        block_sum<CT>(sv, red, F.wave, F.lane);
#pragma unroll
        for (int i = 0; i < CT; ++i) {
            const int t = t0 + hb * CT + i;
            const float rstd = __builtin_amdgcn_rsqf(sv[i] * (1.f / DC) + LN_EPS);
            const unsigned zw = hb ? zwq[CT + i] : zwq[i];
            const float n0 = a0[i] * rstd * lg.x + lb.x, n1 = a1[i] * rstd * lg.y + lb.y;
            const float y0 = n0 * pg8::fsigm(n0) * bflo(zw), y1 = n1 * pg8::fsigm(n1) * bfhi(zw);
            __builtin_amdgcn_raw_buffer_store_b32(pk2(y0, y1), ry, c0 * 2, t * (D * 2), 0);
        }
    }
    __syncthreads();
}
#define DPP_ROW_SHR(x, oldv, d) __builtin_bit_cast(float, __builtin_amdgcn_update_dpp(__builtin_bit_cast(int, (float)(oldv)), __builtin_bit_cast(int, (float)(x)), 0x110 + (d), 0xf, 0xf, false))
#define DPP_ROW_BCAST15(x) __builtin_bit_cast(float, __builtin_amdgcn_update_dpp(0, __builtin_bit_cast(int, (float)(x)), 0x15F, 0xf, 0xf, false))
__device__ __forceinline__ unsigned* lru_flag(Frame& F, int l, int c, int h) { return F.ctl + CW_LRU + 64 * ((l * NLCH + c) * NHEAD + h); }
__device__ __forceinline__ void lru_item(Frame& F, int l, int item) {
    const int c = item >> 3, h = item & 7, t0 = c * LCH, ch0 = h * HD;
    LAS unsigned char* xhi = F.lds; LAS unsigned char* xlo = F.lds + LCH * XROW;
    const int tid = F.tid, lane = F.lane, w = F.wave, fr = lane & 15, fq = lane >> 4;
    const auto ru = MAKE_RSRC(F.U, (size_t)S * UW * 2); const auto ry = MAKE_RSRC(F.Y, (size_t)S * D * 2);
    const int chl = ch0 + 16 * w + 4 * fq;
    const f32x4 vba = *(const f32x4*)(F.ba + l * DL + chl), vbx = *(const f32x4*)(F.bx + l * DL + chl), vlam = *(const f32x4*)(F.lam + l * DL + chl);
    float c8[4];
#pragma unroll
    for (int j = 0; j < 4; ++j) c8[j] = 8.f * log_sigmoid(vlam[j]);
    bf16x8 br[4], bi[4];
    { const bf16_t* wg = F.WgT + (size_t)((l * NHEAD + h) * 2) * HD * HD + (size_t)(16 * w + fr) * HD + 8 * fq;
#pragma unroll
      for (int kk = 0; kk < 4; ++kk) { br[kk] = *(const bf16x8*)(wg + 32 * kk); bi[kk] = *(const bf16x8*)(wg + HD * HD + 32 * kk); } }
    {
        const int tg = tid >> 4, cg = tid & 15, tb = 8 * tg;
        const float* cw = F.lcw + (size_t)l * LW * DL + ch0 + 8 * cg;
        f32x4 wk[4][2];
#pragma unroll
        for (int k = 0; k < 4; ++k) { wk[k][0] = *(const f32x4*)(cw + (size_t)k * DL); wk[k][1] = *(const f32x4*)(cw + (size_t)k * DL + 4); }
        const f32x4 bb0 = *(const f32x4*)(F.lcb + l * DL + ch0 + 8 * cg), bb1 = *(const f32x4*)(F.lcb + l * DL + ch0 + 8 * cg + 4);
        u32x4 rows[11];
#pragma unroll
        for (int r = 0; r < 11; ++r) { const int sidx = t0 + tb - 3 + r; rows[r] = (u32x4){0u, 0u, 0u, 0u};
            if (sidx >= 0) rows[r] = __builtin_bit_cast(u32x4, __builtin_amdgcn_raw_buffer_load_b128(ru, (2048 + ch0 + 8 * cg) * 2, sidx * (UW * 2), 0)); }
#pragma unroll
        for (int i = 0; i < 8; ++i) {
            f32x4 a0 = bb0, a1 = bb1;
#pragma unroll
            for (int k = 0; k < 4; ++k) { const u32x4 q = rows[i + k];
                a0[0] += wk[k][0][0] * bflo(q.x); a0[1] += wk[k][0][1] * bfhi(q.x); a0[2] += wk[k][0][2] * bflo(q.y); a0[3] += wk[k][0][3] * bfhi(q.y);
                a1[0] += wk[k][1][0] * bflo(q.z); a1[1] += wk[k][1][1] * bfhi(q.z); a1[2] += wk[k][1][2] * bflo(q.w); a1[3] += wk[k][1][3] * bfhi(q.w); }
            u32x4 hi; hi.x = pk2(a0[0], a0[1]); hi.y = pk2(a0[2], a0[3]); hi.z = pk2(a1[0], a1[1]); hi.w = pk2(a1[2], a1[3]);
            u32x4 lo; lo.x = pk2(a0[0] - bflo(hi.x), a0[1] - bfhi(hi.x)); lo.y = pk2(a0[2] - bflo(hi.y), a0[3] - bfhi(hi.y)); lo.z = pk2(a1[0] - bflo(hi.z), a1[1] - bfhi(hi.z)); lo.w = pk2(a1[2] - bflo(hi.w), a1[3] - bfhi(hi.w));
            *(LAS u32x4*)(xhi + (tb + i) * XROW + cg * 16) = hi; *(LAS u32x4*)(xlo + (tb + i) * XROW + cg * 16) = lo; }
    }
    __syncthreads();
    float hl[16][4], pc[16][4], HC[4], PC[4];
#pragma unroll
    for (int j = 0; j < 4; ++j) { HC[j] = 0.f; PC[j] = 1.f; }
#pragma unroll
    for (int m = 0; m < 16; ++m) {
        f32x4 ar = (f32x4){0.f, 0.f, 0.f, 0.f}, ai = (f32x4){0.f, 0.f, 0.f, 0.f};
        const LAS unsigned char* rowp = xhi + (16 * m + fr) * XROW;
#pragma unroll
        for (int kk = 0; kk < 4; ++kk) { const bf16x8 a = *(const LAS bf16x8*)(rowp + (32 * kk + 8 * fq) * 2);
            ar = __builtin_amdgcn_mfma_f32_16x16x32_bf16(br[kk], a, ar, 0, 0, 0); ai = __builtin_amdgcn_mfma_f32_16x16x32_bf16(bi[kk], a, ai, 0, 0, 0); }
        const u32x2 qh = *(const LAS u32x2*)(rowp + (16 * w + 4 * fq) * 2), ql = *(const LAS u32x2*)(rowp + LCH * XROW + (16 * w + 4 * fq) * 2);
        const float xcv[4] = {bflo(qh.x) + bflo(ql.x), bfhi(qh.x) + bfhi(ql.x), bflo(qh.y) + bflo(ql.y), bfhi(qh.y) + bfhi(ql.y)};
        float Aj[4], Bj[4];
#pragma unroll
        for (int j = 0; j < 4; ++j) {
            const float r = pg8::fsigm(ar[j] + vba[j]), ig = pg8::fsigm(ai[j] + vbx[j]), la = c8[j] * r;
            Aj[j] = __builtin_amdgcn_exp2f(la * 1.44269504089f); Bj[j] = __builtin_amdgcn_sqrtf(neg_expm1(2.f * la)) * (ig * xcv[j]); }
#define LRU_PIN asm volatile("" : "+v"(Aj[0]), "+v"(Aj[1]), "+v"(Aj[2]), "+v"(Aj[3]), "+v"(Bj[0]), "+v"(Bj[1]), "+v"(Bj[2]), "+v"(Bj[3]))
#define LRU_SCAN_STEP(d) { float ap[4], bp[4]; \
            _Pragma("unroll") for (int j = 0; j < 4; ++j) { ap[j] = DPP_ROW_SHR(Aj[j], 1.0f, d); bp[j] = DPP_ROW_SHR(Bj[j], 0.0f, d); } \
            _Pragma("unroll") for (int j = 0; j < 4; ++j) { Bj[j] = Aj[j] * bp[j] + Bj[j]; Aj[j] = ap[j] * Aj[j]; } LRU_PIN; }
        LRU_PIN; LRU_SCAN_STEP(1) LRU_SCAN_STEP(2) LRU_SCAN_STEP(4) LRU_SCAN_STEP(8)
#undef LRU_SCAN_STEP
#undef LRU_PIN
#pragma unroll
        for (int j = 0; j < 4; ++j) { hl[m][j] = Bj[j] + Aj[j] * HC[j]; pc[m][j] = Aj[j] * PC[j]; }
#pragma unroll
        for (int j = 0; j < 4; ++j) { HC[j] = DPP_ROW_BCAST15(hl[m][j]); PC[j] = DPP_ROW_BCAST15(pc[m][j]); }
    }
    const int vo_u = (fr * UW + 3072 + chl) * 2, vo_y = (fr * D + DC + chl) * 2;
    u32x2 zq[16];
#pragma unroll
    for (int m = 0; m < 16; ++m) zq[m] = __builtin_bit_cast(u32x2, __builtin_amdgcn_raw_buffer_load_b64(ru, vo_u, (t0 + 16 * m) * (UW * 2), 0));
    if (fr == 15) { unsigned long long* sp = F.SUM + (size_t)(l * NLCH + c) * DL + chl;
#pragma unroll
        for (int j = 0; j < 4; ++j) __hip_atomic_store(sp + j, ((unsigned long long)__builtin_bit_cast(unsigned, HC[j]) << 32) | __builtin_bit_cast(unsigned, PC[j]), __ATOMIC_RELAXED, __HIP_MEMORY_SCOPE_AGENT); }
    asm volatile("s_waitcnt vmcnt(0)" ::: "memory");
    __syncthreads();
    if (tid == 0) __hip_atomic_store(lru_flag(F, l, c, h), 1u, __ATOMIC_RELAXED, __HIP_MEMORY_SCOPE_AGENT);
    float Hin[4] = {0.f, 0.f, 0.f, 0.f};
    if (c > 0) {
        if (w == 0) {
            unsigned* fp = lru_flag(F, l, lane < c ? lane : 0, h); unsigned spins = 0;
            for (;;) { const unsigned v = __hip_atomic_load(fp, __ATOMIC_RELAXED, __HIP_MEMORY_SCOPE_AGENT); if (__all(v != 0u)) break; __builtin_amdgcn_s_sleep(2); if (++spins > (1u << 20)) break; }
            __builtin_amdgcn_fence(__ATOMIC_ACQUIRE, "agent");
            asm volatile("s_waitcnt vmcnt(0)" ::: "memory");
        }
        __syncthreads();
        const unsigned long long* sp = F.SUM + (size_t)(l * NLCH) * DL + chl;
        u32x4 q[2][2];
#pragma unroll
        for (int g = 0; g < 2; ++g) { const int cc = fr + 16 * g; q[g][0] = (u32x4){0x3f800000u, 0u, 0x3f800000u, 0u}; q[g][1] = q[g][0];
            if (cc < c) { q[g][0] = *(const u32x4*)(sp + (size_t)cc * DL); q[g][1] = *(const u32x4*)(sp + (size_t)cc * DL + 2); } }
#pragma unroll
        for (int j = 0; j < 4; ++j) { float Hq[2];
#pragma unroll
            for (int g = 0; g < 2; ++g) { const u32x4 qq = q[g][j >> 1]; float A = (j & 1) ? u2f(qq.z) : u2f(qq.x), B = (j & 1) ? u2f(qq.w) : u2f(qq.y);
#define LRU_SCAN_STEP(d) { const float ap = DPP_ROW_SHR(A, 1.0f, d), bp = DPP_ROW_SHR(B, 0.0f, d); B = A * bp + B; A = ap * A; }
                LRU_SCAN_STEP(1) LRU_SCAN_STEP(2) LRU_SCAN_STEP(4) LRU_SCAN_STEP(8)
#undef LRU_SCAN_STEP
                const float At = DPP_ROW_BCAST15(A), Bt = DPP_ROW_BCAST15(B);
                Hq[g] = g == 0 ? Bt : At * Hq[0] + Bt; }
            Hin[j] = Hq[1]; }
    }
#pragma unroll
    for (int m = 0; m < 16; ++m) { const int trow = t0 + 16 * m; const unsigned zx = zq[m].x, zy = zq[m].y;
        const float y0 = (hl[m][0] + pc[m][0] * Hin[0]) * bflo(zx), y1 = (hl[m][1] + pc[m][1] * Hin[1]) * bfhi(zx), y2 = (hl[m][2] + pc[m][2] * Hin[2]) * bflo(zy), y3 = (hl[m][3] + pc[m][3] * Hin[3]) * bfhi(zy);
        u32x2 o; o.x = pk2(y0, y1); o.y = pk2(y2, y3);
        __builtin_amdgcn_raw_buffer_store_b64(o, ry, vo_y, trow * (D * 2), 0); }
    __syncthreads();
}
__device__ __forceinline__ void p_mix(Frame& F, int l) {
    PHASE_TID(F);
    constexpr int NCONV = S / 32, NLRU = NLCH * NHEAD;
    for (int rep = 0; rep < ((PROBE_DUP & 8) ? 2 : 1); ++rep)
    for (int it = F.bid; it < NLRU; it += F.G) { PHASE_TID(F); lru_item(F, l, it); }
    for (int rep = 0; rep < ((PROBE_DUP & 16) ? 2 : 1); ++rep)
    for (int it = F.bid; it < NCONV; it += F.G) { PHASE_TID(F); conv_item(F, l, it); }
}
__device__ __forceinline__ void p_final(Frame& F) {
    PHASE_TID(F);
    const int gw = F.bid * NWAVES + F.wave, NGW = F.G * NWAVES;
    for (int m = gw; m < S; m += NGW) {
        float ss = 0.f;
#pragma unroll
        for (int p = 0; p < 32; ++p) ss += F.SSQ[p * S + m];
        const float rstd = 1.f / sqrtf(ss * (1.f / D) + RMS_EPS);
        f32x4* orow = (f32x4*)(F.out + (size_t)m * D) + F.lane; const f32x4* gr = (const f32x4*)F.final_g + F.lane;
#pragma unroll
        for (int j = 0; j < 8; ++j) orow[64 * j] = orow[64 * j] * rstd * gr[64 * j];
    }
}

constexpr int PH_PER_LAYER = 3, NPH = 1 + DEPTH * PH_PER_LAYER + 1;
struct Args { const float* in[16]; float* out; unsigned char* ws; int ph_lo, ph_hi; };
__global__ void __launch_bounds__(NTHREADS, 2) mk_fwd(Args a) {
    extern __shared__ __attribute__((aligned(16))) unsigned char lds_raw[];
    Frame F;
    F.lds = (LAS unsigned char*)lds_raw;
    F.wave = __builtin_amdgcn_readfirstlane(threadIdx.x >> 6); F.tid = threadIdx.x; F.lane = F.tid & 63; F.bid = blockIdx.x; F.G = gridDim.x;
    F.x = a.in[0]; F.norm_g = a.in[1]; F.w_in = a.in[2]; F.cdw_w = a.in[3]; F.cdw_b = a.in[4]; F.cln_g = a.in[5]; F.cln_b = a.in[6]; F.lcw = a.in[7]; F.lcb = a.in[8];
    F.wa = a.in[9]; F.ba = a.in[10]; F.wx = a.in[11]; F.bx = a.in[12]; F.lam = a.in[13]; F.w_out = a.in[14]; F.final_g = a.in[15]; F.out = a.out;
    unsigned char* ws = a.ws;
    F.WinT = (bf16_t*)(ws + WS_WINT); F.WoutT = (bf16_t*)(ws + WS_WOUTT); F.XB = (bf16_t*)(ws + WS_XB); F.U = (bf16_t*)(ws + WS_U); F.Y = (bf16_t*)(ws + WS_Y);
    F.SSQ = (float*)(ws + WS_SSQ); F.SUM = (unsigned long long*)(ws + WS_SUM); F.WgT = (bf16_t*)(ws + WS_WG); F.ctl = (unsigned*)(ws + WS_CTL);
    volatile LAS unsigned* bst = (volatile LAS unsigned*)(F.lds + LDS_BYTES - 64);
    if (F.tid < 16) bst[F.tid] = 0u;
    __syncthreads();
    XcdBarrier bar; bar.bar = (unsigned*)(ws + WS_CTL) + CW_BAR; bar.x = 0; bar.st = bst;
    if (MK_ONE_LAUNCH) bar = xcd_barrier_post((unsigned*)(ws + WS_CTL) + CW_BAR, bst);
    bar.wave = F.wave;
    for (int ph = a.ph_lo; ph < a.ph_hi; ++ph) {
      const int jj = (ph == 0 || ph == NPH - 1) ? -1 : (ph - 1) % PH_PER_LAYER;
      const int reps = ((PROBE_DUP & 1) && ph == 0) || ((PROBE_DUP & 2) && jj == 0) || ((PROBE_DUP & 4) && jj == 1) ? 2 : 1;
      for (int rep = 0; rep < reps; ++rep) {
        if (rep) xcd_barrier(bar);
        if (ph == 0) p_prologue(F);
        else if (ph == NPH - 1) p_final(F);
        else { const int l = (ph - 1) / PH_PER_LAYER, j = (ph - 1) % PH_PER_LAYER;
            if (j == 0) { pg8::Gemm g{F.XB, F.WinT + (size_t)l * DIN * D, S, DIN, D}; pg8::OrderRstd Sd; Sd.init(S, DIN, F.G, F.bid); Sd.ssq = F.SSQ; Sd.rtab = (LAS float*)(F.lds + pg8::RTAB_OFF); Sd.wave = F.wave;
                pg8::EpiIn E{F.U, (const LAS float*)(F.lds + pg8::RTAB_OFF)};
                pg8::gemm_phase<pg8::EpiIn, pg8::OrderRstd, true, true>(F.lds, g, Sd, E, F.wave); }
            else if (j == 1) p_mix(F, l);
            else { pg8::Gemm g{F.Y, F.WoutT + (size_t)l * D * D, S, D, D}; pg8::StaticOrder Sd; Sd.init(S, D, F.G, F.bid);
                pg8::EpiOut E{l == 0 ? F.x : F.out, F.out, F.XB, F.SSQ};
                pg8::gemm_phase<pg8::EpiOut, pg8::StaticOrder, true, true>(F.lds, g, Sd, E, F.wave); }
        }
      }
        if (ph + 1 < a.ph_hi) xcd_barrier(bar);
    }
}

extern "C" void kernel_launch(void* const* d_in, const int* in_sizes, int n_in, void* d_out, int out_size, void* d_ws, size_t ws_size, hipStream_t stream) {
    static int grid = 0;
    if (grid == 0) {
        if (n_in != 16 || in_sizes[0] != S * D || out_size != S * D || ws_size < WS_END) { fprintf(stderr, "kernel_launch: unexpected shapes (n_in %d, in0 %d, out %d, ws %zu)\n", n_in, n_in > 0 ? in_sizes[0] : -1, out_size, ws_size); grid = -1; return; }
        int dev = 0, cus = 0, per_cu = 0;
        if (hipGetDevice(&dev) != hipSuccess || hipDeviceGetAttribute(&cus, hipDeviceAttributeMultiprocessorCount, dev) != hipSuccess) { grid = -1; return; }
        if (hipFuncSetAttribute((const void*)mk_fwd, hipFuncAttributeMaxDynamicSharedMemorySize, LDS_BYTES) != hipSuccess) { fprintf(stderr, "kernel_launch: hipFuncSetAttribute failed\n"); grid = -1; return; }
        if (hipOccupancyMaxActiveBlocksPerMultiprocessor(&per_cu, (const void*)mk_fwd, NTHREADS, LDS_BYTES) != hipSuccess || per_cu < 1) fprintf(stderr, "kernel_launch: occupancy query says %d per CU\n", per_cu);
        (void)hipGetLastError();
        grid = cus;
    }
    if (grid < 0) return;
    (void)hipMemsetAsync((char*)d_ws + WS_CTL, 0, CTL_ZERO_BYTES, stream);
    Args a{};
    for (int i = 0; i < 16; ++i) a.in[i] = (const float*)d_in[i];
    a.out = (float*)d_out; a.ws = (unsigned char*)d_ws;
#if MK_ONE_LAUNCH
    a.ph_lo = 0; a.ph_hi = NPH;
    hipLaunchKernelGGL(mk_fwd, dim3(grid), dim3(NTHREADS), LDS_BYTES, stream, a);
#else
    for (int ph = 0; ph < NPH; ++ph) { a.ph_lo = ph; a.ph_hi = ph + 1; hipLaunchKernelGGL(mk_fwd, dim3(grid), dim3(NTHREADS), LDS_BYTES, stream, a); }
#endif
}
```

```cpp
#include <hip/hip_runtime.h>
#include <cstdio>
#include <cstdint>

#ifndef MK_ONE_LAUNCH
#define MK_ONE_LAUNCH 1
#endif

#ifndef PROBE_DUP
#define PROBE_DUP 0
#endif
#define LAS __attribute__((address_space(3)))
#define GAS __attribute__((address_space(1)))
typedef unsigned short bf16_t;
typedef short bf16x8 __attribute__((ext_vector_type(8)));
typedef float f32x4 __attribute__((ext_vector_type(4)));
typedef float f32x2 __attribute__((ext_vector_type(2)));
typedef unsigned u32x4 __attribute__((ext_vector_type(4)));
typedef unsigned u32x2 __attribute__((ext_vector_type(2)));

constexpr int S = 8192, D = 2048, DEPTH = 4, DC = 1024, DL = 1024, DIN = 5120, NHEAD = 8, HD = 128, CW = 31, LW = 4;
constexpr int UW = 4096;
constexpr float RMS_EPS = 1e-6f, LN_EPS = 1e-5f;
constexpr int NTHREADS = 512, NWAVES = 8;
constexpr int LDS_BYTES = 147456;
constexpr int LCH = 256, NLCH = S / LCH;
constexpr int XROW = 272;
constexpr int CW_BAR = 4096, CW_LRU = 16384;

constexpr size_t MiB = 1u << 20;
constexpr size_t WS_CTL = 0, CTL_ZERO_BYTES = 1 * MiB;
constexpr size_t WS_WINT = 2 * MiB;
constexpr size_t WS_WOUTT = 82 * MiB;
constexpr size_t WS_XB = 114 * MiB;
constexpr size_t WS_U = 146 * MiB;
constexpr size_t WS_Y = 210 * MiB;
constexpr size_t WS_SSQ = 242 * MiB;
constexpr size_t WS_SUM = 243 * MiB;
constexpr size_t WS_WG = 244 * MiB;
constexpr size_t WS_END = 246 * MiB;

__device__ __forceinline__ int opaque_tid(int wave);
#define MAKE_RSRC(p, bytes) __builtin_amdgcn_make_buffer_rsrc((void*)(p), 0, (int)(bytes), 0x00020000)
__device__ __forceinline__ unsigned f2bf(float f) { unsigned u = __builtin_bit_cast(unsigned, f); return (u + 0x7fffu + ((u >> 16) & 1u)) >> 16; }
__device__ __forceinline__ unsigned pk2(float lo, float hi) { return f2bf(lo) | (f2bf(hi) << 16); }
__device__ __forceinline__ float bflo(unsigned w) { return __builtin_bit_cast(float, w << 16); }
__device__ __forceinline__ float bfhi(unsigned w) { return __builtin_bit_cast(float, w & 0xffff0000u); }
__device__ __forceinline__ float u2f(unsigned u) { return __builtin_bit_cast(float, u); }
__device__ __forceinline__ float bf2f(bf16_t b) { return __builtin_bit_cast(float, (unsigned)b << 16); }
__device__ __forceinline__ float sigm(float x) { return 1.f / (1.f + __expf(-x)); }
__device__ __forceinline__ float siluf(float x) { return x * sigm(x); }
__device__ __forceinline__ float wave_sum(float v) {
#pragma unroll
    for (int o = 1; o < 64; o <<= 1) v += __shfl_xor(v, o);
    return v;
}
__device__ __forceinline__ float neg_expm1(float x) {
    float p = 1.f + x * (1.f / 8.f); p = 1.f + x * (1.f / 7.f) * p; p = 1.f + x * (1.f / 6.f) * p; p = 1.f + x * (1.f / 5.f) * p; p = 1.f + x * 0.25f * p; p = 1.f + x * (1.f / 3.f) * p; p = 1.f + x * 0.5f * p;
    const float big = 1.f - __builtin_amdgcn_exp2f(x * 1.44269504089f);
    return x > -0.35f ? -x * p : big;
}
__device__ __forceinline__ float log_sigmoid(float x) { return fminf(x, 0.f) - log1pf(expf(-fabsf(x))); }
__host__ __device__ __forceinline__ int src_col(int np) { if (np < 2048) { const int p = np >> 8, j = np & 255; return j < 128 ? 128 * p + j : 1024 + 128 * p + (j - 128); } return np; }

#define XB_TMO      128
#define XB_XCNT(j)  (256  + 64 * (j))
#define XB_XSUB(j)  (1280 + 64 * (j))
#define XB_XGEN(j)  (2304 + 64 * (j))
#define XB_TOP      3328
#define XB_TOPGEN   3392
#define XCD_BAR_WORDS 3456
#define XB_SPIN_CAP (1u << 18)
__device__ __forceinline__ unsigned xb_ld(unsigned* p)              { return __hip_atomic_load(p, __ATOMIC_RELAXED, __HIP_MEMORY_SCOPE_AGENT); }
__device__ __forceinline__ unsigned xb_add(unsigned* p, unsigned v) { return __hip_atomic_fetch_add(p, v, __ATOMIC_RELAXED, __HIP_MEMORY_SCOPE_AGENT); }
__device__ __forceinline__ unsigned xb_xcc_id() { return (unsigned)__builtin_amdgcn_s_getreg((3 << 11) | 20) & 0xFu; }
#define XB_SPIN(cond, bar) do { unsigned _sp = 0; while (cond) { __builtin_amdgcn_s_sleep(1); \
    if ((++_sp & 255u) == 0u) { if (xb_ld(&(bar)[XB_TMO])) break; if (_sp > XB_SPIN_CAP) { atomicAdd(&(bar)[XB_TMO], 1u); break; } } } } while (0)
struct XcdBarrier { unsigned* bar; unsigned x; volatile LAS unsigned* st; int wave; };
__device__ __forceinline__ XcdBarrier xcd_barrier_post(unsigned* bar, volatile LAS unsigned* st) {
    XcdBarrier b; b.bar = bar; b.x = xb_xcc_id(); b.st = st;
    if (threadIdx.x == 0) (void)xb_add(&bar[XB_XCNT(b.x)], 1u);
    return b;
}
__device__ __forceinline__ void xcd_barrier_complete(unsigned* bar, unsigned x, unsigned& nloc, unsigned& nx) {
    const unsigned G = gridDim.x * gridDim.y * gridDim.z;
    unsigned sum, cnt, mine, sp = 0u;
    for (;;) {
        sum = 0u; cnt = 0u; mine = 0u;
#pragma unroll
        for (unsigned j = 0; j < 16; ++j) { const unsigned c = xb_ld(&bar[XB_XCNT(j)]); sum += c; cnt += (c > 0u) ? 1u : 0u; mine = (j == x) ? c : mine; }
        if (sum == G) break;
        __builtin_amdgcn_s_sleep(1);
        if ((++sp & 255u) == 0u) { if (xb_ld(&bar[XB_TMO])) break; if (sp > XB_SPIN_CAP) { atomicAdd(&bar[XB_TMO], 1u); break; } }
    }
    nloc = mine > 0u ? mine : 1u; nx = cnt > 0u ? cnt : 1u;
}
__device__ __forceinline__ void xcd_barrier(const XcdBarrier& b) {
    asm volatile("s_waitcnt vmcnt(0)" ::: "memory");
    __syncthreads();
    if (opaque_tid(b.wave) == 0) {
        unsigned* bar = b.bar;
        __builtin_amdgcn_s_waitcnt(0);
        unsigned nloc = b.st[0], nx = b.st[1];
        if (nloc == 0u) { xcd_barrier_complete(bar, b.x, nloc, nx); b.st[0] = nloc; b.st[1] = nx; }
        const unsigned old = xb_add(&bar[XB_XSUB(b.x)], 1u);
        const unsigned gen = old / nloc;
        if (old + 1u == (gen + 1u) * nloc) {
            __builtin_amdgcn_fence(__ATOMIC_RELEASE, "agent");
            asm volatile("s_waitcnt vmcnt(0)" ::: "memory");
            const unsigned og = xb_add(&bar[XB_TOP], 1u);
            const unsigned tg = og / nx;
            if (og + 1u == (tg + 1u) * nx) xb_add(&bar[XB_TOPGEN], 1u);
            else XB_SPIN(xb_ld(&bar[XB_TOPGEN]) == tg, bar);
            __builtin_amdgcn_fence(__ATOMIC_ACQUIRE, "agent");
            xb_add(&bar[XB_XGEN(b.x)], 1u);
            asm volatile("s_waitcnt vmcnt(0)" ::: "memory");
        } else {
            XB_SPIN(xb_ld(&bar[XB_XGEN(b.x)]) == gen, bar);
            __builtin_amdgcn_fence(__ATOMIC_ACQUIRE, "agent");
            asm volatile("s_waitcnt vmcnt(0)" ::: "memory");
        }
    }
    __syncthreads();
}

struct Frame {
    LAS unsigned char* lds;
    int tid, lane, wave, bid, G;
    const float *x, *norm_g, *w_in, *cdw_w, *cdw_b, *cln_g, *cln_b, *lcw, *lcb, *wa, *ba, *wx, *bx, *lam, *w_out, *final_g;
    float* out;
    bf16_t *WinT, *WoutT, *XB, *U, *Y;
    float *SSQ; unsigned long long* SUM; bf16_t* WgT; unsigned* ctl;
};

namespace pg8 {
#define PG8_LAS __attribute__((address_space(3)))
typedef unsigned short bf16_t;
typedef short bf16x8 __attribute__((ext_vector_type(8)));
typedef float f32x4 __attribute__((ext_vector_type(4)));
typedef unsigned u32x4 __attribute__((ext_vector_type(4)));
constexpr int BM = 256, BK = 64, HALF = 128, HTB = HALF * BK * 2  , STAGE_BYTES = 8 * HTB, NXCD = 8, WGM = 8;

__host__ __device__ __forceinline__ int lds_byte(int r, int c) { const int st = (r >> 4) * 2 + (c >> 5), rr = r & 15, cc = c & 31, ob = rr * 64 + cc * 2; return st * 1024 + (ob ^ (((ob >> 9) & 1) << 5)); }
__host__ __device__ __forceinline__ void stage_rc(int b, int& R, int& C) { const int st = b / 1024, sb = b % 1024, swz = sb ^ (((sb >> 9) & 1) << 5); R = (st >> 1) * 16 + swz / 64; C = (st & 1) * 32 + (swz % 64) / 2; }
__host__ __device__ __forceinline__ int perm32(int rho) { const int n = rho >> 4, i = rho & 15; return 8 * (i >> 2) + 4 * n + (i & 3); }

struct Unit { int pm, pn; };
struct Gemm { const bf16_t* A; const bf16_t* Bt; int M, N, K; };

struct StaticOrder {
    int nM, nN, nwg, G, c;
    __host__ __device__ void init(int M, int N, int G_, int c_) { nM = M / BM; nN = N / BM; nwg = nM * nN; G = G_; c = c_; }
    __host__ __device__ bool next(int i, Unit& u) const {
        const long L = (long)i * G + c; if (L >= nwg) return false;
        int wgid = (int)L; { const int q = nwg / NXCD, r = nwg % NXCD, xcd = wgid % NXCD, off = wgid / NXCD; wgid = (xcd < r ? xcd * (q + 1) : r * (q + 1) + (xcd - r) * q) + off; }
        const int nig = WGM * nN, gid = wgid / nig, fm = gid * WGM, gsz = (nM - fm) < WGM ? (nM - fm) : WGM;
        u.pm = fm + ((wgid % nig) % gsz); u.pn = (wgid % nig) / gsz; return true;
    }
    __device__ __forceinline__ void a_ready(const Unit&, int) const {}
    __device__ __forceinline__ void done(const Unit&) const {}
};


__device__ __forceinline__ unsigned cvt_pk_bf16(float lo, float hi) { unsigned r; asm volatile("v_cvt_pk_bf16_f32 %0, %1, %2" : "=v"(r) : "v"(lo), "v"(hi)); return r; }
__device__ __forceinline__ float fsigm(float x) { return __builtin_amdgcn_rcpf(1.f + __builtin_amdgcn_exp2f(x * -1.44269504089f)); }
constexpr int RTAB_OFF = STAGE_BYTES;

struct OrderRstd : StaticOrder {
    const float* ssq; PG8_LAS float* rtab; int wave;
    __device__ __forceinline__ void a_ready(const Unit& u, int ui) const {
        const int t_ = opaque_tid(wave), wid = wave, lane = t_ & 63, rl = wid * 32 + (lane & 31), half = lane >> 5;
        const float* p = ssq + (size_t)(half * 16) * 8192 + u.pm * BM + rl; float s = 0.f;
#pragma unroll
        for (int q = 0; q < 16; ++q) s += p[(size_t)q * 8192];
        s += __shfl_xor(s, 32);
        if (lane < 32) rtab[(ui & 1) * 256 + rl] = 1.0f / sqrtf(s * (1.0f / 2048.0f) + 1e-6f);
    }
};
struct EpiIn {
    static constexpr bool PERM = true, AFTER_DRAIN = false;
    bf16_t* U; const PG8_LAS float* rtab;
    __device__ __forceinline__ void operator()(const f32x4 (&acc)[2][2][4][2], const Unit& u, int wr, int wc, int fr, int fq, int ui) const {
        const PG8_LAS float* rt = rtab + (ui & 1) * 256 + wr * 64 + fr;
        if (u.pn < 8) {
            bf16_t* base = U + (size_t)(u.pm * BM + wr * 64 + fr) * 4096 + 128 * u.pn + wc * 32 + 8 * fq;
#pragma unroll
            for (int ai = 0; ai < 2; ++ai)
#pragma unroll
                for (int m = 0; m < 4; ++m) { const float rs = rt[ai * HALF + m * 16];
                    const f32x4 v0 = acc[ai][0][m][0] * rs, v1 = acc[ai][0][m][1] * rs, g0 = acc[ai][1][m][0] * rs, g1 = acc[ai][1][m][1] * rs;
                    u32x4 w; w.x = cvt_pk_bf16(v0[0] * fsigm(g0[0]), v0[1] * fsigm(g0[1])); w.y = cvt_pk_bf16(v0[2] * fsigm(g0[2]), v0[3] * fsigm(g0[3]));
                    w.z = cvt_pk_bf16(v1[0] * fsigm(g1[0]), v1[1] * fsigm(g1[1])); w.w = cvt_pk_bf16(v1[2] * fsigm(g1[2]), v1[3] * fsigm(g1[3]));
                    *(u32x4*)(base + (size_t)(ai * HALF + m * 16) * 4096) = w; }
        } else {
            const bool act = (u.pn < 12) || (u.pn >= 16);
            bf16_t* base = U + (size_t)(u.pm * BM + wr * 64 + fr) * 4096 + (256 * u.pn - 1024) + wc * 32 + 8 * fq;
#pragma unroll
            for (int ai = 0; ai < 2; ++ai)
#pragma unroll
                for (int m = 0; m < 4; ++m) { const float rs = rt[ai * HALF + m * 16];
#pragma unroll
                    for (int bj = 0; bj < 2; ++bj) { f32x4 v0 = acc[ai][bj][m][0] * rs, v1 = acc[ai][bj][m][1] * rs;
                        if (act) {
#pragma unroll
                            for (int e = 0; e < 4; ++e) { v0[e] = v0[e] * fsigm(v0[e]); v1[e] = v1[e] * fsigm(v1[e]); } }
                        u32x4 w; w.x = cvt_pk_bf16(v0[0], v0[1]); w.y = cvt_pk_bf16(v0[2], v0[3]); w.z = cvt_pk_bf16(v1[0], v1[1]); w.w = cvt_pk_bf16(v1[2], v1[3]);
                        *(u32x4*)(base + (size_t)(ai * HALF + m * 16) * 4096 + bj * HALF) = w; } }
        }
    }
};
struct EpiOut {
    static constexpr bool PERM = true, AFTER_DRAIN = false;
    const float* xold; float* out; bf16_t* XB; float* ssq;
    __device__ __forceinline__ void operator()(const f32x4 (&acc)[2][2][4][2], const Unit& u, int wr, int wc, int fr, int fq, int) const {
#pragma unroll
        for (int ai = 0; ai < 2; ++ai)
#pragma unroll
            for (int m = 0; m < 4; ++m) { const int row = u.pm * BM + ai * HALF + wr * 64 + m * 16 + fr; const size_t off = (size_t)row * 2048 + u.pn * BM + wc * 32 + 8 * fq; float s = 0.f;
#pragma unroll
                for (int bj = 0; bj < 2; ++bj) { const f32x4 x0 = *(const f32x4*)(xold + off + bj * HALF), x1 = *(const f32x4*)(xold + off + bj * HALF + 4);
                    const f32x4 v0 = x0 + acc[ai][bj][m][0], v1 = x1 + acc[ai][bj][m][1];
                    *(f32x4*)(out + off + bj * HALF) = v0; *(f32x4*)(out + off + bj * HALF + 4) = v1;
                    u32x4 w; w.x = cvt_pk_bf16(v0[0], v0[1]); w.y = cvt_pk_bf16(v0[2], v0[3]); w.z = cvt_pk_bf16(v1[0], v1[1]); w.w = cvt_pk_bf16(v1[2], v1[3]);
                    *(u32x4*)(XB + off + bj * HALF) = w;
                    s += (v0[0] * v0[0] + v0[1] * v0[1]) + (v0[2] * v0[2] + v0[3] * v0[3]) + (v1[0] * v1[0] + v1[1] * v1[1]) + (v1[2] * v1[2] + v1[3] * v1[3]); }
                s += __shfl_xor(s, 16); s += __shfl_xor(s, 32);
                if (fq == 0) ssq[(size_t)(u.pn * 4 + wc) * 8192 + row] = s;
                if (m & 1) asm volatile("" ::: "memory"); }
    }
};

template <class Epi, class Sched, bool ALIGN_EPI = false, bool SP2 = false>
__device__ __forceinline__ void gemm_phase(PG8_LAS unsigned char* lds, const Gemm g, const Sched& S, const Epi& E, const int wave_in) {
    const int tid = opaque_tid(wave_in), wid = wave_in,
        lane = tid & 63, wr = wid >> 2, wc = wid & 3, fr = lane & 15, fq = lane >> 4;
    const int K = g.K, nt = K / BK;
    unsigned voffA[2], voffB[2];
#pragma unroll
    for (int i = 0; i < 2; ++i) { int R, C; stage_rc(tid * 16 + i * 8192, R, C); const int Rb = Epi::PERM ? ((R & ~31) + perm32(R & 31)) : R;
        voffA[i] = (unsigned)(R * K + C) * 2u; voffB[i] = (unsigned)(Rb * K + C) * 2u; }
    const size_t kstep = (size_t)(BK * 2);
    const size_t hstep = (size_t)HALF * K * 2;
    const size_t tstep = 2 * hstep;
    const unsigned ldsw = (unsigned)wid * 1024u;
    const int aoff = lds_byte(wr * 64 + fr, fq * 8), boff = lds_byte(wc * 32 + fr, fq * 8);
#define PG8_SA(b, h) (((b) * 2 + (h)) * HTB)
#define PG8_SB(b, h) ((4 + (b) * 2 + (h)) * HTB)
#define PG8_STAGE(bufoff, gbase, voff) do { _Pragma("unroll") for (int _i = 0; _i < 2; ++_i) \
        __builtin_amdgcn_global_load_lds((const unsigned*)((const char*)(gbase) + (voff)[_i]), (PG8_LAS unsigned*)(lds + (bufoff) + ldsw + _i * 8192), 16, 0, 0); } while (0)
#define PG8_LDA(dst, b, h) do { _Pragma("unroll") for (int m = 0; m < 4; ++m) _Pragma("unroll") for (int k = 0; k < 2; ++k) dst[m][k] = *(const PG8_LAS bf16x8*)(lds + PG8_SA(b, h) + aoff + m * 2048 + k * 1024); } while (0)
#define PG8_LDB(dst, b, h) do { _Pragma("unroll") for (int n = 0; n < 2; ++n) _Pragma("unroll") for (int k = 0; k < 2; ++k) dst[n][k] = *(const PG8_LAS bf16x8*)(lds + PG8_SB(b, h) + boff + n * 2048 + k * 1024); } while (0)
#define PG8_MMA(ai, bj, At, Bt) do { __builtin_amdgcn_s_setprio(1); _Pragma("unroll") for (int m = 0; m < 4; ++m) _Pragma("unroll") for (int n = 0; n < 2; ++n) _Pragma("unroll") for (int k = 0; k < 2; ++k) \
        acc[ai][bj][m][n] = __builtin_amdgcn_mfma_f32_16x16x32_bf16(Bt[n][k], At[m][k], acc[ai][bj][m][n], 0, 0, 0); __builtin_amdgcn_s_setprio(0); } while (0)
#define PG8_WAIT_V(n) asm volatile("s_waitcnt vmcnt(" #n ")" ::: "memory")
#define PG8_WAIT_L(n) asm volatile("s_waitcnt lgkmcnt(" #n ")" ::: "memory")
#define PG8_BAR __builtin_amdgcn_s_barrier()
#define PG8_SCHED __builtin_amdgcn_sched_barrier(0)
    Unit cur, nxt; int ui = 0;
    if (!S.next(0, cur)) return;
    f32x4 acc[2][2][4][2];
#pragma unroll
    for (int a = 0; a < 2; ++a)
#pragma unroll
        for (int b = 0; b < 2; ++b)
#pragma unroll
            for (int m = 0; m < 4; ++m)
#pragma unroll
                for (int n = 0; n < 2; ++n) acc[a][b][m][n] = (f32x4){0.f, 0.f, 0.f, 0.f};
    bf16x8 At[4][2], B0[2][2], B1[2][2];
    const char* cA = (const char*)g.A + (size_t)cur.pm * tstep; const char* cB = (const char*)g.Bt + (size_t)cur.pn * tstep;
    S.a_ready(cur, 0);
    if constexpr (SP2) {
        PG8_STAGE(PG8_SB(0, 0), cB, voffB); PG8_STAGE(PG8_SB(0, 1), cB + hstep, voffB); PG8_STAGE(PG8_SA(0, 0), cA, voffA); PG8_STAGE(PG8_SA(0, 1), cA + hstep, voffA);
        if (wr == 1) PG8_BAR;
        PG8_WAIT_V(2); PG8_BAR;
        PG8_STAGE(PG8_SB(1, 0), cB + kstep, voffB); PG8_STAGE(PG8_SA(1, 0), cA + kstep, voffA); PG8_STAGE(PG8_SB(1, 1), cB + hstep + kstep, voffB);
        PG8_WAIT_V(6); PG8_BAR;
    } else {
        PG8_STAGE(PG8_SB(0, 0), cB, voffB); PG8_STAGE(PG8_SA(0, 0), cA, voffA); PG8_STAGE(PG8_SB(0, 1), cB + hstep, voffB); PG8_STAGE(PG8_SA(0, 1), cA + hstep, voffA);
        if (wr == 1) PG8_BAR;
        PG8_WAIT_V(4); PG8_BAR;
        PG8_STAGE(PG8_SB(1, 0), cB + kstep, voffB); PG8_STAGE(PG8_SA(1, 0), cA + kstep, voffA); PG8_STAGE(PG8_SB(1, 1), cB + hstep + kstep, voffB);
        PG8_WAIT_V(6); PG8_BAR;
    }
    for (;;) {
        const bool has_next = S.next(ui + 1, nxt);
        const char* nA = has_next ? (const char*)g.A + (size_t)nxt.pm * tstep : cA; const char* nB = has_next ? (const char*)g.Bt + (size_t)nxt.pn * tstep : cB;
        for (int t = 0; t < nt; t += 2) {
            const bool last = (t == nt - 2);
            const char* a1 = cA + (size_t)(t + 1) * kstep;
            const char* a2 = last ? nA : cA + (size_t)(t + 2) * kstep; const char* b2 = last ? nB : cB + (size_t)(t + 2) * kstep;
            const char* a3 = a2 + kstep; const char* b3 = b2 + kstep;
            if (last && has_next) S.a_ready(nxt, ui + 1);
            if constexpr (SP2) {
            PG8_LDB(B0, 0, 0); PG8_LDB(B1, 0, 1); PG8_SCHED; PG8_LDA(At, 0, 0); PG8_STAGE(PG8_SA(1, 1), a1 + hstep, voffA);
            PG8_WAIT_V(8); PG8_WAIT_L(0); PG8_BAR; PG8_MMA(0, 0, At, B0); PG8_MMA(0, 1, At, B1); PG8_BAR; PG8_SCHED;
            PG8_LDA(At, 0, 1); PG8_STAGE(PG8_SB(0, 0), b2, voffB); PG8_STAGE(PG8_SB(0, 1), b2 + hstep, voffB); PG8_STAGE(PG8_SA(0, 0), a2, voffA);
            PG8_WAIT_V(8); PG8_WAIT_L(0); PG8_BAR; PG8_MMA(1, 0, At, B0); PG8_MMA(1, 1, At, B1); PG8_BAR; PG8_SCHED;
            PG8_LDB(B0, 1, 0); PG8_LDB(B1, 1, 1); PG8_SCHED; PG8_LDA(At, 1, 0); PG8_STAGE(PG8_SA(0, 1), a2 + hstep, voffA);
            PG8_WAIT_V(8); PG8_WAIT_L(0); PG8_BAR; PG8_MMA(0, 0, At, B0); PG8_MMA(0, 1, At, B1); PG8_BAR; PG8_SCHED;
            PG8_LDA(At, 1, 1); PG8_STAGE(PG8_SB(1, 0), b3, voffB); PG8_STAGE(PG8_SB(1, 1), b3 + hstep, voffB); PG8_STAGE(PG8_SA(1, 0), a3, voffA);
            PG8_WAIT_V(8); PG8_WAIT_L(0); PG8_BAR; PG8_MMA(1, 0, At, B0); PG8_MMA(1, 1, At, B1); PG8_BAR; PG8_SCHED;
            } else {
            PG8_LDB(B0, 0, 0); PG8_SCHED; PG8_LDA(At, 0, 0); PG8_STAGE(PG8_SA(1, 1), a1 + hstep, voffA);
            PG8_WAIT_L(8); PG8_BAR; PG8_WAIT_L(0); PG8_MMA(0, 0, At, B0); PG8_BAR; PG8_SCHED;
            PG8_LDB(B1, 0, 1); PG8_STAGE(PG8_SB(0, 0), b2, voffB);
            PG8_BAR; PG8_WAIT_L(0); PG8_MMA(0, 1, At, B1); PG8_BAR;
            PG8_LDA(At, 0, 1); PG8_STAGE(PG8_SA(0, 0), a2, voffA);
            PG8_BAR; PG8_WAIT_L(0); PG8_MMA(1, 0, At, B0); PG8_BAR; PG8_SCHED;
            PG8_STAGE(PG8_SB(0, 1), b2 + hstep, voffB);
            PG8_WAIT_V(6); PG8_BAR; PG8_MMA(1, 1, At, B1); PG8_BAR;
            PG8_LDB(B0, 1, 0); PG8_SCHED; PG8_LDA(At, 1, 0); PG8_STAGE(PG8_SA(0, 1), a2 + hstep, voffA);
            PG8_WAIT_L(8); PG8_BAR; PG8_WAIT_L(0); PG8_MMA(0, 0, At, B0); PG8_BAR; PG8_SCHED;
            PG8_LDB(B1, 1, 1); PG8_STAGE(PG8_SB(1, 0), b3, voffB);
            PG8_BAR; PG8_WAIT_L(0); PG8_MMA(0, 1, At, B1); PG8_BAR;
            PG8_LDA(At, 1, 1); PG8_STAGE(PG8_SA(1, 0), a3, voffA);
            PG8_BAR; PG8_WAIT_L(0); PG8_MMA(1, 0, At, B0); PG8_BAR; PG8_SCHED;
            PG8_STAGE(PG8_SB(1, 1), b3 + hstep, voffB);
            PG8_WAIT_V(6); PG8_BAR; PG8_MMA(1, 1, At, B1); PG8_BAR;
            }
        }
        if constexpr (ALIGN_EPI) { if (wr == 0) PG8_BAR; }
        if constexpr (!Epi::AFTER_DRAIN) { E(acc, cur, wr, wc, fr, fq, ui); S.done(cur); }
        if (!has_next) break;
#pragma unroll
        for (int a = 0; a < 2; ++a)
#pragma unroll
            for (int b = 0; b < 2; ++b)
#pragma unroll
                for (int m = 0; m < 4; ++m)
#pragma unroll
                    for (int n = 0; n < 2; ++n) acc[a][b][m][n] = (f32x4){0.f, 0.f, 0.f, 0.f};
        cur = nxt; cA = nA; cB = nB; ++ui;
        if constexpr (ALIGN_EPI) { if (wr == 1) PG8_BAR; }
    }
    PG8_WAIT_V(0);
    if constexpr (!ALIGN_EPI) { if (wr == 0) PG8_BAR; }
    PG8_BAR;
    if constexpr (Epi::AFTER_DRAIN) { E.fused(acc, cur, wr, wc, fr, fq, lds, wid, lane); S.done(cur); }
#undef PG8_SA
#undef PG8_SB
#undef PG8_STAGE
#undef PG8_LDA
#undef PG8_LDB
#undef PG8_MMA
#undef PG8_WAIT_V
#undef PG8_WAIT_L
#undef PG8_BAR
#undef PG8_SCHED
}
}

__device__ __forceinline__ int opaque_tid(int wave) { int ln = __builtin_amdgcn_mbcnt_hi(~0u, __builtin_amdgcn_mbcnt_lo(~0u, 0u)); asm volatile("" : "+v"(ln)); return wave * 64 + ln; }
#define PHASE_TID(F) do { const int _t = opaque_tid((F).wave); (F).tid = _t; (F).lane = _t & 63; } while (0)
__device__ __forceinline__ void transpose_item(const float* W, int K, int N, bf16_t* WT, int dst_row0, int src_col0, const float* gk, LAS float* scr, int k0, int lane) {
    f32x4 v[16]; const int r0 = lane >> 4, c4 = (lane & 15) * 4;
    const float* wp = W + (size_t)(k0 + r0) * N + src_col0 + c4;
#pragma unroll
    for (int i = 0; i < 16; ++i) v[i] = *(const f32x4*)(wp + (size_t)(4 * i) * N);
    if (gk) {
#pragma unroll
        for (int i = 0; i < 16; ++i) v[i] = v[i] * gk[k0 + r0 + 4 * i]; }
#pragma unroll
    for (int i = 0; i < 16; ++i) { LAS float* d = scr + (r0 + 4 * i) * 65 + c4; d[0] = v[i][0]; d[1] = v[i][1]; d[2] = v[i][2]; d[3] = v[i][3]; }
    asm volatile("s_waitcnt lgkmcnt(0)" ::: "memory");
    const int c = lane & 7;
#pragma unroll
    for (int j = 0; j < 8; ++j) { const int n = (lane >> 3) + 8 * j; const LAS float* sp = scr + (8 * c) * 65 + n;
        u32x4 o; o.x = pk2(sp[0 * 65], sp[1 * 65]); o.y = pk2(sp[2 * 65], sp[3 * 65]); o.z = pk2(sp[4 * 65], sp[5 * 65]); o.w = pk2(sp[6 * 65], sp[7 * 65]);
        *(u32x4*)(WT + (size_t)(dst_row0 + n) * K + k0 + 8 * c) = o; }
    asm volatile("s_waitcnt lgkmcnt(0)" ::: "memory");
}
__device__ __forceinline__ void p_prologue(Frame& F) {
    PHASE_TID(F);
    LAS float* scr = (LAS float*)(F.lds + F.wave * 17408);
    const int gw = F.bid * NWAVES + F.wave, NGW = F.G * NWAVES;
    constexpr int I_IN = (D / 64) * (DIN / 64), I_OUT = (D / 64) * (D / 64), I_G = NHEAD * 2 * (HD / 64) * (HD / 64), I_L = I_IN + I_OUT + I_G;
    for (int it = gw; it < DEPTH * I_L; it += NGW) {
        const int l = it / I_L; int r = it % I_L;
        if (r >= I_IN + I_OUT) { r -= I_IN + I_OUT; const int hg = r >> 2, kb = (r >> 1) & 1, nb = r & 1, h = hg >> 1, gsel = hg & 1;
            transpose_item((gsel ? F.wx : F.wa) + (size_t)(l * NHEAD + h) * HD * HD, HD, HD, F.WgT + (size_t)((l * NHEAD + h) * 2 + gsel) * HD * HD, 64 * nb, 64 * nb, nullptr, scr, 64 * kb, F.lane);
        } else if (r < I_IN) { const int kb = r / (DIN / 64), nb = r % (DIN / 64);
            transpose_item(F.w_in + (size_t)l * D * DIN, D, DIN, F.WinT + (size_t)l * DIN * D, 64 * nb, src_col(64 * nb), F.norm_g + l * D, scr, 64 * kb, F.lane);
        } else { r -= I_IN; const int kb = r / (D / 64), nb = r % (D / 64);
            transpose_item(F.w_out + (size_t)l * D * D, D, D, F.WoutT + (size_t)l * D * D, 64 * nb, 64 * nb, nullptr, scr, 64 * kb, F.lane); }
    }
    for (int m = gw; m < S; m += NGW) {
        const f32x4* xr = (const f32x4*)(F.x + (size_t)m * D) + F.lane; u32x2* ob = (u32x2*)(F.XB + (size_t)m * D) + F.lane; float s = 0.f;
#pragma unroll
        for (int j = 0; j < 8; ++j) { const f32x4 v = xr[64 * j]; s += (v.x * v.x + v.y * v.y) + (v.z * v.z + v.w * v.w); u32x2 w; w.x = pk2(v.x, v.y); w.y = pk2(v.z, v.w); ob[64 * j] = w; }
        s = wave_sum(s);
        if (F.lane < 32) F.SSQ[F.lane * S + m] = F.lane == 0 ? s : 0.f;
    }
}

#define DPP_MOV(x, ctrl) __builtin_bit_cast(float, __builtin_amdgcn_update_dpp(0, __builtin_bit_cast(int, (float)(x)), (ctrl), 0xf, 0xf, true))
template <int NV> __device__ __forceinline__ void block_sum(float (&v)[NV], LAS float* red  , int wave, int lane) {
#pragma unroll
    for (int i = 0; i < NV; ++i) v[i] += DPP_MOV(v[i], 0x128);
#pragma unroll
    for (int i = 0; i < NV; ++i) v[i] += DPP_MOV(v[i], 0x124);
#pragma unroll
    for (int i = 0; i < NV; ++i) v[i] += DPP_MOV(v[i], 0x4E);
#pragma unroll
    for (int i = 0; i < NV; ++i) v[i] += DPP_MOV(v[i], 0xB1);
    __builtin_amdgcn_sched_barrier(0);
    float t[NV];
#pragma unroll
    for (int i = 0; i < NV; ++i) t[i] = __shfl_xor(v[i], 16);
#pragma unroll
    for (int i = 0; i < NV; ++i) v[i] += t[i];
    __builtin_amdgcn_sched_barrier(0);
#pragma unroll
    for (int i = 0; i < NV; ++i) t[i] = __shfl_xor(v[i], 32);
#pragma unroll
    for (int i = 0; i < NV; ++i) v[i] += t[i];
    __builtin_amdgcn_sched_barrier(0);
    if (lane == 0) {
#pragma unroll
        for (int i = 0; i < NV; ++i) red[i * 8 + wave] = v[i]; }
    __syncthreads();
#pragma unroll
    for (int i = 0; i < NV; ++i) { const LAS f32x4* p = (const LAS f32x4*)(red + i * 8); const f32x4 a = p[0], b = p[1]; v[i] = ((a.x + a.y) + (a.z + a.w)) + ((b.x + b.y) + (b.z + b.w)); }
    __syncthreads();
}
constexpr int CT = 16;
__device__ __forceinline__ void conv_item(Frame& F, int l, int item) {
    LAS unsigned char* cs = F.lds;
    LAS float* red = (LAS float*)(F.lds + 62 * 2048);
    const int t0 = item * 32, c0 = 2 * F.tid;
    const auto rus = MAKE_RSRC(F.U, (size_t)S * UW * 2); const int c16 = F.tid & 127, rb = F.tid >> 7; u32x4 v[16];
#pragma unroll
    for (int i = 0; i < 16; ++i) { const int row = rb + 4 * i, sidx = t0 - 30 + row; v[i] = (u32x4){0u, 0u, 0u, 0u};
        if (row < 62 && sidx >= 0) v[i] = __builtin_bit_cast(u32x4, __builtin_amdgcn_raw_buffer_load_b128(rus, c16 * 16, sidx * (UW * 2), 0)); }
    f32x2 wv[31];
    const auto rw = MAKE_RSRC(F.cdw_w + (size_t)l * CW * DC, CW * DC * 4);
#pragma unroll
    for (int j = 0; j < 31; ++j) wv[j] = __builtin_bit_cast(f32x2, __builtin_amdgcn_raw_buffer_load_b64(rw, c0 * 4, (30 - j) * DC * 4, 0));
    const f32x2 bias = *(const f32x2*)(F.cdw_b + l * DC + c0);
    const f32x2 lg = *(const f32x2*)(F.cln_g + l * DC + c0), lb = *(const f32x2*)(F.cln_b + l * DC + c0);
    const auto ru = MAKE_RSRC(F.U, (size_t)S * UW * 2); const auto ry = MAKE_RSRC(F.Y, (size_t)S * D * 2);
    unsigned zwq[32];
#pragma unroll
    for (int i = 0; i < 32; ++i) zwq[i] = __builtin_amdgcn_raw_buffer_load_b32(ru, (1024 + c0) * 2, (t0 + i) * (UW * 2), 0);
#pragma unroll
    for (int i = 0; i < 16; ++i) { const int row = rb + 4 * i; if (row < 62) *(LAS u32x4*)(cs + row * 2048 + c16 * 16) = v[i]; }
    __syncthreads();
#pragma unroll 1
    for (int hb_ = 0; hb_ < ((PROBE_DUP & 64) ? 2 : 1) * (32 / CT); ++hb_) { const int hb = hb_ % (32 / CT);
        f32x2 acc[CT];
#pragma unroll
        for (int i = 0; i < CT; ++i) acc[i] = bias;
        const LAS unsigned char* cp = cs + (hb * CT) * 2048 + F.tid * 4;
        unsigned cwq[CT + 30];
#pragma unroll
        for (int si = 0; si < CT + 30; ++si) cwq[si] = *(const LAS unsigned*)(cp + si * 2048);
        static_assert(CT + 30 == 46, "operand lists below");
        asm volatile("" : "+v"(cwq[0]), "+v"(cwq[1]), "+v"(cwq[2]), "+v"(cwq[3]), "+v"(cwq[4]), "+v"(cwq[5]), "+v"(cwq[6]), "+v"(cwq[7]), "+v"(cwq[8]), "+v"(cwq[9]), "+v"(cwq[10]), "+v"(cwq[11]), "+v"(cwq[12]), "+v"(cwq[13]), "+v"(cwq[14]), "+v"(cwq[15]));
        asm volatile("" : "+v"(cwq[16]), "+v"(cwq[17]), "+v"(cwq[18]), "+v"(cwq[19]), "+v"(cwq[20]), "+v"(cwq[21]), "+v"(cwq[22]), "+v"(cwq[23]), "+v"(cwq[24]), "+v"(cwq[25]), "+v"(cwq[26]), "+v"(cwq[27]), "+v"(cwq[28]), "+v"(cwq[29]), "+v"(cwq[30]), "+v"(cwq[31]));
        asm volatile("" : "+v"(cwq[32]), "+v"(cwq[33]), "+v"(cwq[34]), "+v"(cwq[35]), "+v"(cwq[36]), "+v"(cwq[37]), "+v"(cwq[38]), "+v"(cwq[39]), "+v"(cwq[40]), "+v"(cwq[41]), "+v"(cwq[42]), "+v"(cwq[43]), "+v"(cwq[44]), "+v"(cwq[45]));
#pragma unroll
        for (int si = 0; si < CT + 30; ++si) {
            const unsigned cw = cwq[si];
            const f32x2 xv = (f32x2){bflo(cw), bfhi(cw)};
#pragma unroll
            for (int i = 0; i < CT; ++i) { const int j = i + 30 - si; if (j >= 0 && j <= 30) acc[i] = wv[j] * xv + acc[i]; }
            static_assert(CT == 16, "operand list below");
            asm volatile("" : "+v"(acc[0]), "+v"(acc[1]), "+v"(acc[2]), "+v"(acc[3]), "+v"(acc[4]), "+v"(acc[5]), "+v"(acc[6]), "+v"(acc[7]),
                              "+v"(acc[8]), "+v"(acc[9]), "+v"(acc[10]), "+v"(acc[11]), "+v"(acc[12]), "+v"(acc[13]), "+v"(acc[14]), "+v"(acc[15]));
        }
        float a0[CT], a1[CT];
#pragma unroll
        for (int i = 0; i < CT; ++i) { a0[i] = acc[i].x; a1[i] = acc[i].y; }
        float sv[CT];
#pragma unroll
        for (int i = 0; i < CT; ++i) sv[i] = a0[i] + a1[i];
        block_sum<CT>(sv, red, F.wave, F.lane);
#pragma unroll
        for (int i = 0; i < CT; ++i) { const float mean = sv[i] * (1.f / DC); a0[i] -= mean; a1[i] -= mean; sv[i] = a0[i] * a0[i] + a1[i] * a1[i]; }
        block_sum<CT>(sv, red, F.wave, F.lane);
#pragma unroll
        for (int i = 0; i < CT; ++i) {
            const int t = t0 + hb * CT + i;
            const float rstd = __builtin_amdgcn_rsqf(sv[i] * (1.f / DC) + LN_EPS);
            const unsigned zw = hb ? zwq[CT + i] : zwq[i];
            const float n0 = a0[i] * rstd * lg.x + lb.x, n1 = a1[i] * rstd * lg.y + lb.y;
            const float y0 = n0 * pg8::fsigm(n0) * bflo(zw), y1 = n1 * pg8::fsigm(n1) * bfhi(zw);
            __builtin_amdgcn_raw_buffer_store_b32(pk2(y0, y1), ry, c0 * 2, t * (D * 2), 0);
        }
    }
    __syncthreads();
}
#define DPP_ROW_SHR(x, oldv, d) __builtin_bit_cast(float, __builtin_amdgcn_update_dpp(__builtin_bit_cast(int, (float)(oldv)), __builtin_bit_cast(int, (float)(x)), 0x110 + (d), 0xf, 0xf, false))
#define DPP_ROW_BCAST15(x) __builtin_bit_cast(float, __builtin_amdgcn_update_dpp(0, __builtin_bit_cast(int, (float)(x)), 0x15F, 0xf, 0xf, true))
__device__ __forceinline__ unsigned* lru_flag(Frame& F, int l, int c, int h) { return F.ctl + CW_LRU + 64 * ((l * NLCH + c) * NHEAD + h); }
__device__ __forceinline__ void lru_item(Frame& F, int l, int item) {
    const int c = item >> 3, h = item & 7, t0 = c * LCH, ch0 = h * HD;
    LAS unsigned char* xhi = F.lds; LAS unsigned char* xlo = F.lds + LCH * XROW;
    const int tid = F.tid, lane = F.lane, w = F.wave, fr = lane & 15, fq = lane >> 4;
    const auto ru = MAKE_RSRC(F.U, (size_t)S * UW * 2); const auto ry = MAKE_RSRC(F.Y, (size_t)S * D * 2);
    const int chl = ch0 + 16 * w + 4 * fq;
    const f32x4 vba = *(const f32x4*)(F.ba + l * DL + chl), vbx = *(const f32x4*)(F.bx + l * DL + chl), vlam = *(const f32x4*)(F.lam + l * DL + chl);
    float c8l[4], c8x[4], nba[4], nbx[4], keep[4];
#pragma unroll
    for (int j = 0; j < 4; ++j) { const float c8 = 8.f * log_sigmoid(vlam[j]); c8l[j] = c8 * 1.44269504089f; c8x[j] = 2.f * c8; nba[j] = vba[j] * -1.44269504089f; nbx[j] = vbx[j] * -1.44269504089f; }
    keep[0] = fr < 1 ? 1.f : 0.f; keep[1] = fr < 2 ? 1.f : 0.f; keep[2] = fr < 4 ? 1.f : 0.f; keep[3] = fr < 8 ? 1.f : 0.f;
    bf16x8 br[4], bi[4];
    { const bf16_t* wg = F.WgT + (size_t)((l * NHEAD + h) * 2) * HD * HD + (size_t)(16 * w + fr) * HD + 8 * fq;
#pragma unroll
      for (int kk = 0; kk < 4; ++kk) { br[kk] = *(const bf16x8*)(wg + 32 * kk); bi[kk] = *(const bf16x8*)(wg + HD * HD + 32 * kk); } }
    {
        const int tg = tid >> 4, cg = tid & 15, tb = 8 * tg;
        const float* cw = F.lcw + (size_t)l * LW * DL + ch0 + 8 * cg;
        f32x4 wk[4][2];
#pragma unroll
        for (int k = 0; k < 4; ++k) { wk[k][0] = *(const f32x4*)(cw + (size_t)k * DL); wk[k][1] = *(const f32x4*)(cw + (size_t)k * DL + 4); }
        const f32x4 bb0 = *(const f32x4*)(F.lcb + l * DL + ch0 + 8 * cg), bb1 = *(const f32x4*)(F.lcb + l * DL + ch0 + 8 * cg + 4);
        u32x4 rows[11];
#pragma unroll
        for (int r = 0; r < 11; ++r) { const int sidx = t0 + tb - 3 + r; rows[r] = (u32x4){0u, 0u, 0u, 0u};
            if (sidx >= 0) rows[r] = __builtin_bit_cast(u32x4, __builtin_amdgcn_raw_buffer_load_b128(ru, (2048 + ch0 + 8 * cg) * 2, sidx * (UW * 2), 0)); }
#pragma unroll
        for (int i = 0; i < 8; ++i) {
            f32x4 a0 = bb0, a1 = bb1;
#pragma unroll
            for (int k = 0; k < 4; ++k) { const u32x4 q = rows[i + k];
                a0[0] += wk[k][0][0] * bflo(q.x); a0[1] += wk[k][0][1] * bfhi(q.x); a0[2] += wk[k][0][2] * bflo(q.y); a0[3] += wk[k][0][3] * bfhi(q.y);
                a1[0] += wk[k][1][0] * bflo(q.z); a1[1] += wk[k][1][1] * bfhi(q.z); a1[2] += wk[k][1][2] * bflo(q.w); a1[3] += wk[k][1][3] * bfhi(q.w); }
            u32x4 hi; hi.x = pk2(a0[0], a0[1]); hi.y = pk2(a0[2], a0[3]); hi.z = pk2(a1[0], a1[1]); hi.w = pk2(a1[2], a1[3]);
            u32x4 lo; lo.x = pk2(a0[0] - bflo(hi.x), a0[1] - bfhi(hi.x)); lo.y = pk2(a0[2] - bflo(hi.y), a0[3] - bfhi(hi.y)); lo.z = pk2(a1[0] - bflo(hi.z), a1[1] - bfhi(hi.z)); lo.w = pk2(a1[2] - bflo(hi.w), a1[3] - bfhi(hi.w));
            *(LAS u32x4*)(xhi + (tb + i) * XROW + cg * 16) = hi; *(LAS u32x4*)(xlo + (tb + i) * XROW + cg * 16) = lo; }
    }
    __syncthreads();
    float hl[16][4], pc[16][4], HC[4], PC[4];
#pragma unroll
    for (int j = 0; j < 4; ++j) { HC[j] = 0.f; PC[j] = 1.f; }
#pragma unroll
    for (int m = 0; m < 16; ++m) {
        f32x4 ar = (f32x4){0.f, 0.f, 0.f, 0.f}, ai = (f32x4){0.f, 0.f, 0.f, 0.f};
        const LAS unsigned char* rowp = xhi + (16 * m + fr) * XROW;
#pragma unroll
        for (int kk = 0; kk < 4; ++kk) { const bf16x8 a = *(const LAS bf16x8*)(rowp + (32 * kk + 8 * fq) * 2);
            ar = __builtin_amdgcn_mfma_f32_16x16x32_bf16(br[kk], a, ar, 0, 0, 0); ai = __builtin_amdgcn_mfma_f32_16x16x32_bf16(bi[kk], a, ai, 0, 0, 0); }
        const u32x2 qh = *(const LAS u32x2*)(rowp + (16 * w + 4 * fq) * 2), ql = *(const LAS u32x2*)(rowp + LCH * XROW + (16 * w + 4 * fq) * 2);
        const float xcv[4] = {bflo(qh.x) + bflo(ql.x), bfhi(qh.x) + bfhi(ql.x), bflo(qh.y) + bflo(ql.y), bfhi(qh.y) + bfhi(ql.y)};
        float Aj[4], Bj[4], xq[4];
#pragma unroll
        for (int j = 0; j < 4; ++j) {
            const float r = __builtin_amdgcn_rcpf(1.f + __builtin_amdgcn_exp2f(ar[j] * -1.44269504089f + nba[j])), ig = __builtin_amdgcn_rcpf(1.f + __builtin_amdgcn_exp2f(ai[j] * -1.44269504089f + nbx[j]));
            const float x = c8x[j] * r; xq[j] = x;
            float p = x * (1.f / 5040.f) + (1.f / 720.f); p = p * x + (1.f / 120.f); p = p * x + (1.f / 24.f); p = p * x + (1.f / 6.f); p = p * x + 0.5f; p = p * x + 1.f;
            Aj[j] = __builtin_amdgcn_exp2f(c8l[j] * r); Bj[j] = __builtin_amdgcn_sqrtf(-x * p) * (ig * xcv[j]); }
        if (__builtin_expect(__any(fminf(fminf(xq[0], xq[1]), fminf(xq[2], xq[3])) <= -0.35f), 0)) {
#pragma unroll
            for (int j = 0; j < 4; ++j) if (xq[j] <= -0.35f) { const float r = __builtin_amdgcn_rcpf(1.f + __builtin_amdgcn_exp2f(ar[j] * -1.44269504089f + nba[j])), ig = __builtin_amdgcn_rcpf(1.f + __builtin_amdgcn_exp2f(ai[j] * -1.44269504089f + nbx[j]));
                (void)r; Bj[j] = __builtin_amdgcn_sqrtf(1.f - __builtin_amdgcn_exp2f(xq[j] * 1.44269504089f)) * (ig * xcv[j]); } }
#define LRU_PIN asm volatile("" : "+v"(Aj[0]), "+v"(Aj[1]), "+v"(Aj[2]), "+v"(Aj[3]), "+v"(Bj[0]), "+v"(Bj[1]), "+v"(Bj[2]), "+v"(Bj[3]))
#define DPP_SHR0(x, d) __builtin_bit_cast(float, __builtin_amdgcn_update_dpp(0, __builtin_bit_cast(int, (float)(x)), 0x110 + (d), 0xf, 0xf, true))
#define LRU_SCAN_STEP(d, kd) { \
            _Pragma("unroll") for (int j = 0; j < 4; ++j) { Bj[j] = DPP_SHR0(Bj[j], d) * Aj[j] + Bj[j]; } \
            _Pragma("unroll") for (int j = 0; j < 4; ++j) { const float t = DPP_SHR0(Aj[j], d) + keep[kd]; Aj[j] = Aj[j] * t; } LRU_PIN; }
        LRU_PIN; LRU_SCAN_STEP(1, 0) LRU_SCAN_STEP(2, 1) LRU_SCAN_STEP(4, 2) LRU_SCAN_STEP(8, 3)
#undef LRU_SCAN_STEP
#undef LRU_PIN
#pragma unroll
        for (int j = 0; j < 4; ++j) { hl[m][j] = Bj[j] + Aj[j] * HC[j]; pc[m][j] = Aj[j] * PC[j]; }
#pragma unroll
        for (int j = 0; j < 4; ++j) { HC[j] = DPP_ROW_BCAST15(hl[m][j]); PC[j] = DPP_ROW_BCAST15(pc[m][j]); }
    }
    const int vo_u = (fr * UW + 3072 + chl) * 2, vo_y = (fr * D + DC + chl) * 2;
    u32x2 zq[16];
#pragma unroll
    for (int m = 0; m < 16; ++m) zq[m] = __builtin_bit_cast(u32x2, __builtin_amdgcn_raw_buffer_load_b64(ru, vo_u, (t0 + 16 * m) * (UW * 2), 0));
    if (fr == 15) { unsigned long long* sp = F.SUM + (size_t)(l * NLCH + c) * DL + chl;
#pragma unroll
        for (int j = 0; j < 4; ++j) __hip_atomic_store(sp + j, ((unsigned long long)__builtin_bit_cast(unsigned, HC[j]) << 32) | __builtin_bit_cast(unsigned, PC[j]), __ATOMIC_RELAXED, __HIP_MEMORY_SCOPE_AGENT); }
    asm volatile("s_waitcnt vmcnt(0)" ::: "memory");
    __syncthreads();
    if (tid == 0) __hip_atomic_store(lru_flag(F, l, c, h), 1u, __ATOMIC_RELAXED, __HIP_MEMORY_SCOPE_AGENT);
    float Hin[4] = {0.f, 0.f, 0.f, 0.f};
    if (c > 0) {
        if (w == 0) {
            unsigned* fp = lru_flag(F, l, lane < c ? lane : 0, h); unsigned spins = 0;
            for (;;) { const unsigned v = __hip_atomic_load(fp, __ATOMIC_RELAXED, __HIP_MEMORY_SCOPE_AGENT); if (__all(v != 0u)) break; __builtin_amdgcn_s_sleep(2); if (++spins > (1u << 20)) break; }
            __builtin_amdgcn_fence(__ATOMIC_ACQUIRE, "agent");
            asm volatile("s_waitcnt vmcnt(0)" ::: "memory");
        }
        __syncthreads();
        const unsigned long long* sp = F.SUM + (size_t)(l * NLCH) * DL + chl;
        u32x4 q[2][2];
#pragma unroll
        for (int g = 0; g < 2; ++g) { const int cc = fr + 16 * g; q[g][0] = (u32x4){0x3f800000u, 0u, 0x3f800000u, 0u}; q[g][1] = q[g][0];
            if (cc < c) { q[g][0] = *(const u32x4*)(sp + (size_t)cc * DL); q[g][1] = *(const u32x4*)(sp + (size_t)cc * DL + 2); } }
#pragma unroll
        for (int j = 0; j < 4; ++j) { float Hq[2];
#pragma unroll
            for (int g = 0; g < 2; ++g) { const u32x4 qq = q[g][j >> 1]; float A = (j & 1) ? u2f(qq.z) : u2f(qq.x), B = (j & 1) ? u2f(qq.w) : u2f(qq.y);
#define LRU_SCAN_STEP(d) { const float ap = DPP_ROW_SHR(A, 1.0f, d), bp = DPP_ROW_SHR(B, 0.0f, d); B = A * bp + B; A = ap * A; }
                LRU_SCAN_STEP(1) LRU_SCAN_STEP(2) LRU_SCAN_STEP(4) LRU_SCAN_STEP(8)
#undef LRU_SCAN_STEP
                const float At = DPP_ROW_BCAST15(A), Bt = DPP_ROW_BCAST15(B);
                Hq[g] = g == 0 ? Bt : At * Hq[0] + Bt; }
            Hin[j] = Hq[1]; }
    }
#pragma unroll
    for (int m = 0; m < 16; ++m) { const int trow = t0 + 16 * m; const unsigned zx = zq[m].x, zy = zq[m].y;
        const float y0 = (hl[m][0] + pc[m][0] * Hin[0]) * bflo(zx), y1 = (hl[m][1] + pc[m][1] * Hin[1]) * bfhi(zx), y2 = (hl[m][2] + pc[m][2] * Hin[2]) * bflo(zy), y3 = (hl[m][3] + pc[m][3] * Hin[3]) * bfhi(zy);
        u32x2 o; o.x = pk2(y0, y1); o.y = pk2(y2, y3);
        __builtin_amdgcn_raw_buffer_store_b64(o, ry, vo_y, trow * (D * 2), 0); }
    __syncthreads();
}
__device__ __forceinline__ void p_mix(Frame& F, int l) {
    PHASE_TID(F);
    constexpr int NCONV = S / 32, NLRU = NLCH * NHEAD;
    for (int rep = 0; rep < ((PROBE_DUP & 8) ? 2 : 1); ++rep)
    for (int it = F.bid; it < NLRU; it += F.G) { PHASE_TID(F); lru_item(F, l, it); }
    for (int rep = 0; rep < ((PROBE_DUP & 16) ? 2 : 1); ++rep)
    for (int it = F.bid; it < NCONV; it += F.G) { PHASE_TID(F); conv_item(F, l, it); }
}
__device__ __forceinline__ void p_final(Frame& F) {
    PHASE_TID(F);
    const int gw = F.bid * NWAVES + F.wave, NGW = F.G * NWAVES;
    for (int m = gw; m < S; m += NGW) {
        float ss = 0.f;
#pragma unroll
        for (int p = 0; p < 32; ++p) ss += F.SSQ[p * S + m];
        const float rstd = 1.f / sqrtf(ss * (1.f / D) + RMS_EPS);
        f32x4* orow = (f32x4*)(F.out + (size_t)m * D) + F.lane; const f32x4* gr = (const f32x4*)F.final_g + F.lane;
#pragma unroll
        for (int j = 0; j < 8; ++j) orow[64 * j] = orow[64 * j] * rstd * gr[64 * j];
    }
}

constexpr int PH_PER_LAYER = 3, NPH = 1 + DEPTH * PH_PER_LAYER + 1;
struct Args { const float* in[16]; float* out; unsigned char* ws; int ph_lo, ph_hi; };
__global__ void __launch_bounds__(NTHREADS, 2) mk_fwd(Args a) {
    extern __shared__ __attribute__((aligned(16))) unsigned char lds_raw[];
    Frame F;
    F.lds = (LAS unsigned char*)lds_raw;
    F.wave = __builtin_amdgcn_readfirstlane(threadIdx.x >> 6); F.tid = threadIdx.x; F.lane = F.tid & 63; F.bid = blockIdx.x; F.G = gridDim.x;
    F.x = a.in[0]; F.norm_g = a.in[1]; F.w_in = a.in[2]; F.cdw_w = a.in[3]; F.cdw_b = a.in[4]; F.cln_g = a.in[5]; F.cln_b = a.in[6]; F.lcw = a.in[7]; F.lcb = a.in[8];
    F.wa = a.in[9]; F.ba = a.in[10]; F.wx = a.in[11]; F.bx = a.in[12]; F.lam = a.in[13]; F.w_out = a.in[14]; F.final_g = a.in[15]; F.out = a.out;
    unsigned char* ws = a.ws;
    F.WinT = (bf16_t*)(ws + WS_WINT); F.WoutT = (bf16_t*)(ws + WS_WOUTT); F.XB = (bf16_t*)(ws + WS_XB); F.U = (bf16_t*)(ws + WS_U); F.Y = (bf16_t*)(ws + WS_Y);
    F.SSQ = (float*)(ws + WS_SSQ); F.SUM = (unsigned long long*)(ws + WS_SUM); F.WgT = (bf16_t*)(ws + WS_WG); F.ctl = (unsigned*)(ws + WS_CTL);
    volatile LAS unsigned* bst = (volatile LAS unsigned*)(F.lds + LDS_BYTES - 64);
    if (F.tid < 16) bst[F.tid] = 0u;
    __syncthreads();
    XcdBarrier bar; bar.bar = (unsigned*)(ws + WS_CTL) + CW_BAR; bar.x = 0; bar.st = bst;
    if (MK_ONE_LAUNCH) bar = xcd_barrier_post((unsigned*)(ws + WS_CTL) + CW_BAR, bst);
    bar.wave = F.wave;
    for (int ph = a.ph_lo; ph < a.ph_hi; ++ph) {
      const int jj = (ph == 0 || ph == NPH - 1) ? -1 : (ph - 1) % PH_PER_LAYER;
      const int reps = ((PROBE_DUP & 1) && ph == 0) || ((PROBE_DUP & 2) && jj == 0) || ((PROBE_DUP & 4) && jj == 1) ? 2 : 1;
      for (int rep = 0; rep < reps; ++rep) {
        if (rep) xcd_barrier(bar);
        if (ph == 0) p_prologue(F);
        else if (ph == NPH - 1) p_final(F);
        else { const int l = (ph - 1) / PH_PER_LAYER, j = (ph - 1) % PH_PER_LAYER;
            if (j == 0) { pg8::Gemm g{F.XB, F.WinT + (size_t)l * DIN * D, S, DIN, D}; pg8::OrderRstd Sd; Sd.init(S, DIN, F.G, F.bid); Sd.ssq = F.SSQ; Sd.rtab = (LAS float*)(F.lds + pg8::RTAB_OFF); Sd.wave = F.wave;
                pg8::EpiIn E{F.U, (const LAS float*)(F.lds + pg8::RTAB_OFF)};
                pg8::gemm_phase<pg8::EpiIn, pg8::OrderRstd, true, true>(F.lds, g, Sd, E, F.wave); }
            else if (j == 1) p_mix(F, l);
            else { pg8::Gemm g{F.Y, F.WoutT + (size_t)l * D * D, S, D, D}; pg8::StaticOrder Sd; Sd.init(S, D, F.G, F.bid);
                pg8::EpiOut E{l == 0 ? F.x : F.out, F.out, F.XB, F.SSQ};
                pg8::gemm_phase<pg8::EpiOut, pg8::StaticOrder, true, true>(F.lds, g, Sd, E, F.wave); }
        }
      }
        if (ph + 1 < a.ph_hi) xcd_barrier(bar);
    }
}

extern "C" void kernel_launch(void* const* d_in, const int* in_sizes, int n_in, void* d_out, int out_size, void* d_ws, size_t ws_size, hipStream_t stream) {
    static int grid = 0;
    if (grid == 0) {
        if (n_in != 16 || in_sizes[0] != S * D || out_size != S * D || ws_size < WS_END) { fprintf(stderr, "kernel_launch: unexpected shapes (n_in %d, in0 %d, out %d, ws %zu)\n", n_in, n_in > 0 ? in_sizes[0] : -1, out_size, ws_size); grid = -1; return; }
        int dev = 0, cus = 0, per_cu = 0;
        if (hipGetDevice(&dev) != hipSuccess || hipDeviceGetAttribute(&cus, hipDeviceAttributeMultiprocessorCount, dev) != hipSuccess) { grid = -1; return; }
        if (hipFuncSetAttribute((const void*)mk_fwd, hipFuncAttributeMaxDynamicSharedMemorySize, LDS_BYTES) != hipSuccess) { fprintf(stderr, "kernel_launch: hipFuncSetAttribute failed\n"); grid = -1; return; }
        if (hipOccupancyMaxActiveBlocksPerMultiprocessor(&per_cu, (const void*)mk_fwd, NTHREADS, LDS_BYTES) != hipSuccess || per_cu < 1) fprintf(stderr, "kernel_launch: occupancy query says %d per CU\n", per_cu);
        (void)hipGetLastError();
        grid = cus;
    }
    if (grid < 0) return;
    (void)hipMemsetAsync((char*)d_ws + WS_CTL, 0, CTL_ZERO_BYTES, stream);
    Args a{};
    for (int i = 0; i < 16; ++i) a.in[i] = (const float*)d_in[i];
    a.out = (float*)d_out; a.ws = (unsigned char*)d_ws;
#if MK_ONE_LAUNCH
    a.ph_lo = 0; a.ph_hi = NPH;
    hipLaunchKernelGGL(mk_fwd, dim3(grid), dim3(NTHREADS), LDS_BYTES, stream, a);
#else
    for (int ph = 0; ph < NPH; ++ph) { a.ph_lo = ph; a.ph_hi = ph + 1; hipLaunchKernelGGL(mk_fwd, dim3(grid), dim3(NTHREADS), LDS_BYTES, stream, a); }
#endif
}
```

```cpp
#include <hip/hip_runtime.h>
#include <cstdio>
#include <cstdint>

#ifndef MK_ONE_LAUNCH
#define MK_ONE_LAUNCH 1
#endif

#ifndef PROBE_DUP
#define PROBE_DUP 0
#endif
#define LAS __attribute__((address_space(3)))
#define GAS __attribute__((address_space(1)))
typedef unsigned short bf16_t;
typedef short bf16x8 __attribute__((ext_vector_type(8)));
typedef float f32x4 __attribute__((ext_vector_type(4)));
typedef float f32x2 __attribute__((ext_vector_type(2)));
typedef unsigned u32x4 __attribute__((ext_vector_type(4)));
typedef unsigned u32x2 __attribute__((ext_vector_type(2)));

constexpr int S = 8192, D = 2048, DEPTH = 4, DC = 1024, DL = 1024, DIN = 5120, NHEAD = 8, HD = 128, CW = 31, LW = 4;
constexpr int UW = 4096;
constexpr float RMS_EPS = 1e-6f, LN_EPS = 1e-5f;
constexpr int NTHREADS = 512, NWAVES = 8;
constexpr int LDS_BYTES = 147456;
constexpr int LCH = 256, NLCH = S / LCH;
constexpr int XROW = 272;
constexpr int CW_BAR = 4096, CW_LRU = 16384;

constexpr size_t MiB = 1u << 20;
constexpr size_t WS_CTL = 0, CTL_ZERO_BYTES = 1 * MiB;
constexpr size_t WS_WINT = 2 * MiB;
constexpr size_t WS_WOUTT = 82 * MiB;
constexpr size_t WS_XB = 114 * MiB;
constexpr size_t WS_U = 146 * MiB;
constexpr size_t WS_Y = 210 * MiB;
constexpr size_t WS_SSQ = 242 * MiB;
constexpr size_t WS_SUM = 243 * MiB;
constexpr size_t WS_WG = 244 * MiB;
constexpr size_t WS_END = 246 * MiB;

__device__ __forceinline__ int opaque_tid(int wave);
#define MAKE_RSRC(p, bytes) __builtin_amdgcn_make_buffer_rsrc((void*)(p), 0, (int)(bytes), 0x00020000)
__device__ __forceinline__ unsigned f2bf(float f) { unsigned u = __builtin_bit_cast(unsigned, f); return (u + 0x7fffu + ((u >> 16) & 1u)) >> 16; }
__device__ __forceinline__ unsigned pk2(float lo, float hi) { return f2bf(lo) | (f2bf(hi) << 16); }
__device__ __forceinline__ float bflo(unsigned w) { return __builtin_bit_cast(float, w << 16); }
__device__ __forceinline__ float bfhi(unsigned w) { return __builtin_bit_cast(float, w & 0xffff0000u); }
__device__ __forceinline__ float u2f(unsigned u) { return __builtin_bit_cast(float, u); }
__device__ __forceinline__ float bf2f(bf16_t b) { return __builtin_bit_cast(float, (unsigned)b << 16); }
__device__ __forceinline__ float sigm(float x) { return 1.f / (1.f + __expf(-x)); }
__device__ __forceinline__ float siluf(float x) { return x * sigm(x); }
__device__ __forceinline__ float wave_sum(float v) {
#pragma unroll
    for (int o = 1; o < 64; o <<= 1) v += __shfl_xor(v, o);
    return v;
}
__device__ __forceinline__ float neg_expm1(float x) {
    float p = 1.f + x * (1.f / 8.f); p = 1.f + x * (1.f / 7.f) * p; p = 1.f + x * (1.f / 6.f) * p; p = 1.f + x * (1.f / 5.f) * p; p = 1.f + x * 0.25f * p; p = 1.f + x * (1.f / 3.f) * p; p = 1.f + x * 0.5f * p;
    const float big = 1.f - __builtin_amdgcn_exp2f(x * 1.44269504089f);
    return x > -0.35f ? -x * p : big;
}
__device__ __forceinline__ float log_sigmoid(float x) { return fminf(x, 0.f) - log1pf(expf(-fabsf(x))); }
__host__ __device__ __forceinline__ int src_col(int np) { if (np < 2048) { const int p = np >> 8, j = np & 255; return j < 128 ? 128 * p + j : 1024 + 128 * p + (j - 128); } return np; }

#define XB_TMO      128
#define XB_XCNT(j)  (256  + 64 * (j))
#define XB_XSUB(j)  (1280 + 64 * (j))
#define XB_XGEN(j)  (2304 + 64 * (j))
#define XB_TOP      3328
#define XB_TOPGEN   3392
#define XCD_BAR_WORDS 3456
#define XB_SPIN_CAP (1u << 18)
__device__ __forceinline__ unsigned xb_ld(unsigned* p)              { return __hip_atomic_load(p, __ATOMIC_RELAXED, __HIP_MEMORY_SCOPE_AGENT); }
__device__ __forceinline__ unsigned xb_add(unsigned* p, unsigned v) { return __hip_atomic_fetch_add(p, v, __ATOMIC_RELAXED, __HIP_MEMORY_SCOPE_AGENT); }
__device__ __forceinline__ unsigned xb_xcc_id() { return (unsigned)__builtin_amdgcn_s_getreg((3 << 11) | 20) & 0xFu; }
#define XB_SPIN(cond, bar) do { unsigned _sp = 0; while (cond) { __builtin_amdgcn_s_sleep(1); \
    if ((++_sp & 255u) == 0u) { if (xb_ld(&(bar)[XB_TMO])) break; if (_sp > XB_SPIN_CAP) { atomicAdd(&(bar)[XB_TMO], 1u); break; } } } } while (0)
struct XcdBarrier { unsigned* bar; unsigned x; volatile LAS unsigned* st; int wave; };
__device__ __forceinline__ XcdBarrier xcd_barrier_post(unsigned* bar, volatile LAS unsigned* st) {
    XcdBarrier b; b.bar = bar; b.x = xb_xcc_id(); b.st = st;
    if (threadIdx.x == 0) (void)xb_add(&bar[XB_XCNT(b.x)], 1u);
    return b;
}
__device__ __forceinline__ void xcd_barrier_complete(unsigned* bar, unsigned x, unsigned& nloc, unsigned& nx) {
    const unsigned G = gridDim.x * gridDim.y * gridDim.z;
    unsigned sum, cnt, mine, sp = 0u;
    for (;;) {
        sum = 0u; cnt = 0u; mine = 0u;
#pragma unroll
        for (unsigned j = 0; j < 16; ++j) { const unsigned c = xb_ld(&bar[XB_XCNT(j)]); sum += c; cnt += (c > 0u) ? 1u : 0u; mine = (j == x) ? c : mine; }
        if (sum == G) break;
        __builtin_amdgcn_s_sleep(1);
        if ((++sp & 255u) == 0u) { if (xb_ld(&bar[XB_TMO])) break; if (sp > XB_SPIN_CAP) { atomicAdd(&bar[XB_TMO], 1u); break; } }
    }
    nloc = mine > 0u ? mine : 1u; nx = cnt > 0u ? cnt : 1u;
}
__device__ __forceinline__ void xcd_barrier(const XcdBarrier& b) {
    asm volatile("s_waitcnt vmcnt(0)" ::: "memory");
    __syncthreads();
    if (opaque_tid(b.wave) == 0) {
        unsigned* bar = b.bar;
        __builtin_amdgcn_s_waitcnt(0);
        unsigned nloc = b.st[0], nx = b.st[1];
        if (nloc == 0u) { xcd_barrier_complete(bar, b.x, nloc, nx); b.st[0] = nloc; b.st[1] = nx; }
        const unsigned old = xb_add(&bar[XB_XSUB(b.x)], 1u);
        const unsigned gen = old / nloc;
        if (old + 1u == (gen + 1u) * nloc) {
            __builtin_amdgcn_fence(__ATOMIC_RELEASE, "agent");
            asm volatile("s_waitcnt vmcnt(0)" ::: "memory");
            const unsigned og = xb_add(&bar[XB_TOP], 1u);
            const unsigned tg = og / nx;
            if (og + 1u == (tg + 1u) * nx) xb_add(&bar[XB_TOPGEN], 1u);
            else XB_SPIN(xb_ld(&bar[XB_TOPGEN]) == tg, bar);
            __builtin_amdgcn_fence(__ATOMIC_ACQUIRE, "agent");
            xb_add(&bar[XB_XGEN(b.x)], 1u);
            asm volatile("s_waitcnt vmcnt(0)" ::: "memory");
        } else {
            XB_SPIN(xb_ld(&bar[XB_XGEN(b.x)]) == gen, bar);
            __builtin_amdgcn_fence(__ATOMIC_ACQUIRE, "agent");
            asm volatile("s_waitcnt vmcnt(0)" ::: "memory");
        }
    }
    __syncthreads();
}

struct Frame {
    LAS unsigned char* lds;
    int tid, lane, wave, bid, G;
    const float *x, *norm_g, *w_in, *cdw_w, *cdw_b, *cln_g, *cln_b, *lcw, *lcb, *wa, *ba, *wx, *bx, *lam, *w_out, *final_g;
    float* out;
    bf16_t *WinT, *WoutT, *XB, *U, *Y;
    float *SSQ; unsigned long long* SUM; bf16_t* WgT; unsigned* ctl;
};

namespace pg8 {
#define PG8_LAS __attribute__((address_space(3)))
typedef unsigned short bf16_t;
typedef short bf16x8 __attribute__((ext_vector_type(8)));
typedef float f32x4 __attribute__((ext_vector_type(4)));
typedef unsigned u32x4 __attribute__((ext_vector_type(4)));
constexpr int BM = 256, BK = 64, HALF = 128, HTB = HALF * BK * 2  , STAGE_BYTES = 8 * HTB, NXCD = 8, WGM = 8;

__host__ __device__ __forceinline__ int lds_byte(int r, int c) { const int st = (r >> 4) * 2 + (c >> 5), rr = r & 15, cc = c & 31, ob = rr * 64 + cc * 2; return st * 1024 + (ob ^ (((ob >> 9) & 1) << 5)); }
__host__ __device__ __forceinline__ void stage_rc(int b, int& R, int& C) { const int st = b / 1024, sb = b % 1024, swz = sb ^ (((sb >> 9) & 1) << 5); R = (st >> 1) * 16 + swz / 64; C = (st & 1) * 32 + (swz % 64) / 2; }
__host__ __device__ __forceinline__ int perm32(int rho) { const int n = rho >> 4, i = rho & 15; return 8 * (i >> 2) + 4 * n + (i & 3); }

struct Unit { int pm, pn; };
struct Gemm { const bf16_t* A; const bf16_t* Bt; int M, N, K; };

struct StaticOrder {
    int nM, nN, nwg, G, c;
    __host__ __device__ void init(int M, int N, int G_, int c_) { nM = M / BM; nN = N / BM; nwg = nM * nN; G = G_; c = c_; }
    __host__ __device__ bool next(int i, Unit& u) const {
        const long L = (long)i * G + c; if (L >= nwg) return false;
        int wgid = (int)L; { const int q = nwg / NXCD, r = nwg % NXCD, xcd = wgid % NXCD, off = wgid / NXCD; wgid = (xcd < r ? xcd * (q + 1) : r * (q + 1) + (xcd - r) * q) + off; }
        const int nig = WGM * nN, gid = wgid / nig, fm = gid * WGM, gsz = (nM - fm) < WGM ? (nM - fm) : WGM;
        u.pm = fm + ((wgid % nig) % gsz); u.pn = (wgid % nig) / gsz; return true;
    }
    __device__ __forceinline__ void a_ready(const Unit&, int) const {}
    __device__ __forceinline__ void done(const Unit&) const {}
};


__device__ __forceinline__ unsigned cvt_pk_bf16(float lo, float hi) { unsigned r; asm volatile("v_cvt_pk_bf16_f32 %0, %1, %2" : "=v"(r) : "v"(lo), "v"(hi)); return r; }
__device__ __forceinline__ float fsigm(float x) { return __builtin_amdgcn_rcpf(1.f + __builtin_amdgcn_exp2f(x * -1.44269504089f)); }
constexpr int RTAB_OFF = STAGE_BYTES;

struct OrderRstd : StaticOrder {
    const float* ssq; PG8_LAS float* rtab; int wave;
    __device__ __forceinline__ void a_ready(const Unit& u, int ui) const {
        const int t_ = opaque_tid(wave), wid = wave, lane = t_ & 63, rl = wid * 32 + (lane & 31), half = lane >> 5;
        const float* p = ssq + (size_t)(half * 16) * 8192 + u.pm * BM + rl; float s = 0.f;
#pragma unroll
        for (int q = 0; q < 16; ++q) s += p[(size_t)q * 8192];
        s += __shfl_xor(s, 32);
        if (lane < 32) rtab[(ui & 1) * 256 + rl] = 1.0f / sqrtf(s * (1.0f / 2048.0f) + 1e-6f);
    }
};
struct EpiIn {
    static constexpr bool PERM = true, AFTER_DRAIN = false;
    bf16_t* U; const PG8_LAS float* rtab;
    __device__ __forceinline__ void operator()(const f32x4 (&acc)[2][2][4][2], const Unit& u, int wr, int wc, int fr, int fq, int ui) const {
        const PG8_LAS float* rt = rtab + (ui & 1) * 256 + wr * 64 + fr;
        if (u.pn < 8) {
            bf16_t* base = U + (size_t)(u.pm * BM + wr * 64 + fr) * 4096 + 128 * u.pn + wc * 32 + 8 * fq;
#pragma unroll
            for (int ai = 0; ai < 2; ++ai)
#pragma unroll
                for (int m = 0; m < 4; ++m) { const float rs = rt[ai * HALF + m * 16];
                    const f32x4 v0 = acc[ai][0][m][0] * rs, v1 = acc[ai][0][m][1] * rs, g0 = acc[ai][1][m][0] * rs, g1 = acc[ai][1][m][1] * rs;
                    u32x4 w; w.x = cvt_pk_bf16(v0[0] * fsigm(g0[0]), v0[1] * fsigm(g0[1])); w.y = cvt_pk_bf16(v0[2] * fsigm(g0[2]), v0[3] * fsigm(g0[3]));
                    w.z = cvt_pk_bf16(v1[0] * fsigm(g1[0]), v1[1] * fsigm(g1[1])); w.w = cvt_pk_bf16(v1[2] * fsigm(g1[2]), v1[3] * fsigm(g1[3]));
                    *(u32x4*)(base + (size_t)(ai * HALF + m * 16) * 4096) = w; }
        } else {
            const bool act = (u.pn < 12) || (u.pn >= 16);
            bf16_t* base = U + (size_t)(u.pm * BM + wr * 64 + fr) * 4096 + (256 * u.pn - 1024) + wc * 32 + 8 * fq;
#pragma unroll
            for (int ai = 0; ai < 2; ++ai)
#pragma unroll
                for (int m = 0; m < 4; ++m) { const float rs = rt[ai * HALF + m * 16];
#pragma unroll
                    for (int bj = 0; bj < 2; ++bj) { f32x4 v0 = acc[ai][bj][m][0] * rs, v1 = acc[ai][bj][m][1] * rs;
                        if (act) {
#pragma unroll
                            for (int e = 0; e < 4; ++e) { v0[e] = v0[e] * fsigm(v0[e]); v1[e] = v1[e] * fsigm(v1[e]); } }
                        u32x4 w; w.x = cvt_pk_bf16(v0[0], v0[1]); w.y = cvt_pk_bf16(v0[2], v0[3]); w.z = cvt_pk_bf16(v1[0], v1[1]); w.w = cvt_pk_bf16(v1[2], v1[3]);
                        *(u32x4*)(base + (size_t)(ai * HALF + m * 16) * 4096 + bj * HALF) = w; } }
        }
    }
};
struct EpiOut {
    static constexpr bool PERM = true, AFTER_DRAIN = false;
    float* out; bf16_t* XB; float* ssq;
    __device__ __forceinline__ void operator()(const f32x4 (&acc)[2][2][4][2], const Unit& u, int wr, int wc, int fr, int fq, int) const {
#pragma unroll
        for (int ai = 0; ai < 2; ++ai) {
            u32x4 xo[4][2];
#pragma unroll
            for (int m = 0; m < 4; ++m)
#pragma unroll
                for (int bj = 0; bj < 2; ++bj) xo[m][bj] = *(const u32x4*)(XB + (size_t)(u.pm * BM + ai * HALF + wr * 64 + m * 16 + fr) * 2048 + u.pn * BM + wc * 32 + 8 * fq + bj * HALF);
#pragma unroll
            for (int m = 0; m < 4; ++m) { const int row = u.pm * BM + ai * HALF + wr * 64 + m * 16 + fr; const size_t off = (size_t)row * 2048 + u.pn * BM + wc * 32 + 8 * fq; float s = 0.f;
#pragma unroll
                for (int bj = 0; bj < 2; ++bj) { const u32x4 q = xo[m][bj];
                    const f32x4 x0 = (f32x4){__builtin_bit_cast(float, q.x << 16), __builtin_bit_cast(float, q.x & 0xffff0000u), __builtin_bit_cast(float, q.y << 16), __builtin_bit_cast(float, q.y & 0xffff0000u)};
                    const f32x4 x1 = (f32x4){__builtin_bit_cast(float, q.z << 16), __builtin_bit_cast(float, q.z & 0xffff0000u), __builtin_bit_cast(float, q.w << 16), __builtin_bit_cast(float, q.w & 0xffff0000u)};
                    const f32x4 v0 = x0 + acc[ai][bj][m][0], v1 = x1 + acc[ai][bj][m][1];
                    if (out) { *(f32x4*)(out + off + bj * HALF) = v0; *(f32x4*)(out + off + bj * HALF + 4) = v1; }
                    else { u32x4 w; w.x = cvt_pk_bf16(v0[0], v0[1]); w.y = cvt_pk_bf16(v0[2], v0[3]); w.z = cvt_pk_bf16(v1[0], v1[1]); w.w = cvt_pk_bf16(v1[2], v1[3]);
                        *(u32x4*)(XB + off + bj * HALF) = w; }
                    s += (v0[0] * v0[0] + v0[1] * v0[1]) + (v0[2] * v0[2] + v0[3] * v0[3]) + (v1[0] * v1[0] + v1[1] * v1[1]) + (v1[2] * v1[2] + v1[3] * v1[3]); }
                s += __shfl_xor(s, 16); s += __shfl_xor(s, 32);
                if (fq == 0) ssq[(size_t)(u.pn * 4 + wc) * 8192 + row] = s; }
            asm volatile("" ::: "memory"); }
    }
};

template <class Epi, class Sched, bool ALIGN_EPI = false, bool SP2 = false>
__device__ __forceinline__ void gemm_phase(PG8_LAS unsigned char* lds, const Gemm g, const Sched& S, const Epi& E, const int wave_in) {
    const int tid = opaque_tid(wave_in), wid = wave_in,
        lane = tid & 63, wr = wid >> 2, wc = wid & 3, fr = lane & 15, fq = lane >> 4;
    const int K = g.K, nt = K / BK;
    unsigned voffA[2], voffB[2];
#pragma unroll
    for (int i = 0; i < 2; ++i) { int R, C; stage_rc(tid * 16 + i * 8192, R, C); const int Rb = Epi::PERM ? ((R & ~31) + perm32(R & 31)) : R;
        voffA[i] = (unsigned)(R * K + C) * 2u; voffB[i] = (unsigned)(Rb * K + C) * 2u; }
    const size_t kstep = (size_t)(BK * 2);
    const size_t hstep = (size_t)HALF * K * 2;
    const size_t tstep = 2 * hstep;
    const unsigned ldsw = (unsigned)wid * 1024u;
    const int aoff = lds_byte(wr * 64 + fr, fq * 8), boff = lds_byte(wc * 32 + fr, fq * 8);
#define PG8_SA(b, h) (((b) * 2 + (h)) * HTB)
#define PG8_SB(b, h) ((4 + (b) * 2 + (h)) * HTB)
#define PG8_STAGE(bufoff, gbase, voff) do { _Pragma("unroll") for (int _i = 0; _i < 2; ++_i) \
        __builtin_amdgcn_global_load_lds((const unsigned*)((const char*)(gbase) + (voff)[_i]), (PG8_LAS unsigned*)(lds + (bufoff) + ldsw + _i * 8192), 16, 0, 0); } while (0)
#define PG8_LDA(dst, b, h) do { _Pragma("unroll") for (int m = 0; m < 4; ++m) _Pragma("unroll") for (int k = 0; k < 2; ++k) dst[m][k] = *(const PG8_LAS bf16x8*)(lds + PG8_SA(b, h) + aoff + m * 2048 + k * 1024); } while (0)
#define PG8_LDB(dst, b, h) do { _Pragma("unroll") for (int n = 0; n < 2; ++n) _Pragma("unroll") for (int k = 0; k < 2; ++k) dst[n][k] = *(const PG8_LAS bf16x8*)(lds + PG8_SB(b, h) + boff + n * 2048 + k * 1024); } while (0)
#define PG8_MMA(ai, bj, At, Bt) do { __builtin_amdgcn_s_setprio(1); _Pragma("unroll") for (int m = 0; m < 4; ++m) _Pragma("unroll") for (int n = 0; n < 2; ++n) _Pragma("unroll") for (int k = 0; k < 2; ++k) \
        acc[ai][bj][m][n] = __builtin_amdgcn_mfma_f32_16x16x32_bf16(Bt[n][k], At[m][k], acc[ai][bj][m][n], 0, 0, 0); __builtin_amdgcn_s_setprio(0); } while (0)
#define PG8_WAIT_V(n) asm volatile("s_waitcnt vmcnt(" #n ")" ::: "memory")
#define PG8_WAIT_L(n) asm volatile("s_waitcnt lgkmcnt(" #n ")" ::: "memory")
#define PG8_BAR __builtin_amdgcn_s_barrier()
#define PG8_SCHED __builtin_amdgcn_sched_barrier(0)
    Unit cur, nxt; int ui = 0;
    if (!S.next(0, cur)) return;
    f32x4 acc[2][2][4][2];
#pragma unroll
    for (int a = 0; a < 2; ++a)
#pragma unroll
        for (int b = 0; b < 2; ++b)
#pragma unroll
            for (int m = 0; m < 4; ++m)
#pragma unroll
                for (int n = 0; n < 2; ++n) acc[a][b][m][n] = (f32x4){0.f, 0.f, 0.f, 0.f};
    bf16x8 At[4][2], B0[2][2], B1[2][2];
    const char* cA = (const char*)g.A + (size_t)cur.pm * tstep; const char* cB = (const char*)g.Bt + (size_t)cur.pn * tstep;
    S.a_ready(cur, 0);
    if constexpr (SP2) {
        PG8_STAGE(PG8_SB(0, 0), cB, voffB); PG8_STAGE(PG8_SB(0, 1), cB + hstep, voffB); PG8_STAGE(PG8_SA(0, 0), cA, voffA); PG8_STAGE(PG8_SA(0, 1), cA + hstep, voffA);
        if (wr == 1) PG8_BAR;
        PG8_WAIT_V(2); PG8_BAR;
        PG8_STAGE(PG8_SB(1, 0), cB + kstep, voffB); PG8_STAGE(PG8_SA(1, 0), cA + kstep, voffA); PG8_STAGE(PG8_SB(1, 1), cB + hstep + kstep, voffB);
        PG8_WAIT_V(6); PG8_BAR;
    } else {
        PG8_STAGE(PG8_SB(0, 0), cB, voffB); PG8_STAGE(PG8_SA(0, 0), cA, voffA); PG8_STAGE(PG8_SB(0, 1), cB + hstep, voffB); PG8_STAGE(PG8_SA(0, 1), cA + hstep, voffA);
        if (wr == 1) PG8_BAR;
        PG8_WAIT_V(4); PG8_BAR;
        PG8_STAGE(PG8_SB(1, 0), cB + kstep, voffB); PG8_STAGE(PG8_SA(1, 0), cA + kstep, voffA); PG8_STAGE(PG8_SB(1, 1), cB + hstep + kstep, voffB);
        PG8_WAIT_V(6); PG8_BAR;
    }
    for (;;) {
        const bool has_next = S.next(ui + 1, nxt);
        const char* nA = has_next ? (const char*)g.A + (size_t)nxt.pm * tstep : cA; const char* nB = has_next ? (const char*)g.Bt + (size_t)nxt.pn * tstep : cB;
        for (int t = 0; t < nt; t += 2) {
            const bool last = (t == nt - 2);
            const char* a1 = cA + (size_t)(t + 1) * kstep;
            const char* a2 = last ? nA : cA + (size_t)(t + 2) * kstep; const char* b2 = last ? nB : cB + (size_t)(t + 2) * kstep;
            const char* a3 = a2 + kstep; const char* b3 = b2 + kstep;
            if (last && has_next) S.a_ready(nxt, ui + 1);
            if constexpr (SP2) {
            PG8_LDB(B0, 0, 0); PG8_LDB(B1, 0, 1); PG8_SCHED; PG8_LDA(At, 0, 0); PG8_STAGE(PG8_SA(1, 1), a1 + hstep, voffA);
            PG8_WAIT_V(8); PG8_WAIT_L(0); PG8_BAR; PG8_MMA(0, 0, At, B0); PG8_MMA(0, 1, At, B1); PG8_BAR; PG8_SCHED;
            PG8_LDA(At, 0, 1); PG8_STAGE(PG8_SB(0, 0), b2, voffB); PG8_STAGE(PG8_SB(0, 1), b2 + hstep, voffB); PG8_STAGE(PG8_SA(0, 0), a2, voffA);
            PG8_WAIT_V(8); PG8_WAIT_L(0); PG8_BAR; PG8_MMA(1, 0, At, B0); PG8_MMA(1, 1, At, B1); PG8_BAR; PG8_SCHED;
            PG8_LDB(B0, 1, 0); PG8_LDB(B1, 1, 1); PG8_SCHED; PG8_LDA(At, 1, 0); PG8_STAGE(PG8_SA(0, 1), a2 + hstep, voffA);
            PG8_WAIT_V(8); PG8_WAIT_L(0); PG8_BAR; PG8_MMA(0, 0, At, B0); PG8_MMA(0, 1, At, B1); PG8_BAR; PG8_SCHED;
            PG8_LDA(At, 1, 1); PG8_STAGE(PG8_SB(1, 0), b3, voffB); PG8_STAGE(PG8_SB(1, 1), b3 + hstep, voffB); PG8_STAGE(PG8_SA(1, 0), a3, voffA);
            PG8_WAIT_V(8); PG8_WAIT_L(0); PG8_BAR; PG8_MMA(1, 0, At, B0); PG8_MMA(1, 1, At, B1); PG8_BAR; PG8_SCHED;
            } else {
            PG8_LDB(B0, 0, 0); PG8_SCHED; PG8_LDA(At, 0, 0); PG8_STAGE(PG8_SA(1, 1), a1 + hstep, voffA);
            PG8_WAIT_L(8); PG8_BAR; PG8_WAIT_L(0); PG8_MMA(0, 0, At, B0); PG8_BAR; PG8_SCHED;
            PG8_LDB(B1, 0, 1); PG8_STAGE(PG8_SB(0, 0), b2, voffB);
            PG8_BAR; PG8_WAIT_L(0); PG8_MMA(0, 1, At, B1); PG8_BAR;
            PG8_LDA(At, 0, 1); PG8_STAGE(PG8_SA(0, 0), a2, voffA);
            PG8_BAR; PG8_WAIT_L(0); PG8_MMA(1, 0, At, B0); PG8_BAR; PG8_SCHED;
            PG8_STAGE(PG8_SB(0, 1), b2 + hstep, voffB);
            PG8_WAIT_V(6); PG8_BAR; PG8_MMA(1, 1, At, B1); PG8_BAR;
            PG8_LDB(B0, 1, 0); PG8_SCHED; PG8_LDA(At, 1, 0); PG8_STAGE(PG8_SA(0, 1), a2 + hstep, voffA);
            PG8_WAIT_L(8); PG8_BAR; PG8_WAIT_L(0); PG8_MMA(0, 0, At, B0); PG8_BAR; PG8_SCHED;
            PG8_LDB(B1, 1, 1); PG8_STAGE(PG8_SB(1, 0), b3, voffB);
            PG8_BAR; PG8_WAIT_L(0); PG8_MMA(0, 1, At, B1); PG8_BAR;
            PG8_LDA(At, 1, 1); PG8_STAGE(PG8_SA(1, 0), a3, voffA);
            PG8_BAR; PG8_WAIT_L(0); PG8_MMA(1, 0, At, B0); PG8_BAR; PG8_SCHED;
            PG8_STAGE(PG8_SB(1, 1), b3 + hstep, voffB);
            PG8_WAIT_V(6); PG8_BAR; PG8_MMA(1, 1, At, B1); PG8_BAR;
            }
        }
        if constexpr (ALIGN_EPI) { if (wr == 0) PG8_BAR; }
        if constexpr (!Epi::AFTER_DRAIN) { E(acc, cur, wr, wc, fr, fq, ui); S.done(cur); }
        if (!has_next) break;
#pragma unroll
        for (int a = 0; a < 2; ++a)
#pragma unroll
            for (int b = 0; b < 2; ++b)
#pragma unroll
                for (int m = 0; m < 4; ++m)
#pragma unroll
                    for (int n = 0; n < 2; ++n) acc[a][b][m][n] = (f32x4){0.f, 0.f, 0.f, 0.f};
        cur = nxt; cA = nA; cB = nB; ++ui;
        if constexpr (ALIGN_EPI) { if (wr == 1) PG8_BAR; }
    }
    PG8_WAIT_V(0);
    if constexpr (!ALIGN_EPI) { if (wr == 0) PG8_BAR; }
    PG8_BAR;
    if constexpr (Epi::AFTER_DRAIN) { E.fused(acc, cur, wr, wc, fr, fq, lds, wid, lane); S.done(cur); }
#undef PG8_SA
#undef PG8_SB
#undef PG8_STAGE
#undef PG8_LDA
#undef PG8_LDB
#undef PG8_MMA
#undef PG8_WAIT_V
#undef PG8_WAIT_L
#undef PG8_BAR
#undef PG8_SCHED
}
}

__device__ __forceinline__ int opaque_tid(int wave) { int ln = __builtin_amdgcn_mbcnt_hi(~0u, __builtin_amdgcn_mbcnt_lo(~0u, 0u)); asm volatile("" : "+v"(ln)); return wave * 64 + ln; }
#define PHASE_TID(F) do { const int _t = opaque_tid((F).wave); (F).tid = _t; (F).lane = _t & 63; } while (0)
__device__ __forceinline__ void transpose_item(const float* W, int K, int N, bf16_t* WT, int dst_row0, int src_col0, const float* gk, LAS float* scr, int k0, int lane) {
    f32x4 v[16]; const int r0 = lane >> 4, c4 = (lane & 15) * 4;
    const float* wp = W + (size_t)(k0 + r0) * N + src_col0 + c4;
#pragma unroll
    for (int i = 0; i < 16; ++i) v[i] = *(const f32x4*)(wp + (size_t)(4 * i) * N);
    if (gk) {
#pragma unroll
        for (int i = 0; i < 16; ++i) v[i] = v[i] * gk[k0 + r0 + 4 * i]; }
#pragma unroll
    for (int i = 0; i < 16; ++i) { LAS float* d = scr + (r0 + 4 * i) * 65 + c4; d[0] = v[i][0]; d[1] = v[i][1]; d[2] = v[i][2]; d[3] = v[i][3]; }
    asm volatile("s_waitcnt lgkmcnt(0)" ::: "memory");
    const int c = lane & 7;
#pragma unroll
    for (int j = 0; j < 8; ++j) { const int n = (lane >> 3) + 8 * j; const LAS float* sp = scr + (8 * c) * 65 + n;
        u32x4 o; o.x = pk2(sp[0 * 65], sp[1 * 65]); o.y = pk2(sp[2 * 65], sp[3 * 65]); o.z = pk2(sp[4 * 65], sp[5 * 65]); o.w = pk2(sp[6 * 65], sp[7 * 65]);
        *(u32x4*)(WT + (size_t)(dst_row0 + n) * K + k0 + 8 * c) = o; }
    asm volatile("s_waitcnt lgkmcnt(0)" ::: "memory");
}
__device__ __forceinline__ void p_prologue(Frame& F) {
    PHASE_TID(F);
    LAS float* scr = (LAS float*)(F.lds + F.wave * 17408);
    const int gw = F.bid * NWAVES + F.wave, NGW = F.G * NWAVES;
    constexpr int I_IN = (D / 64) * (DIN / 64), I_OUT = (D / 64) * (D / 64), I_G = NHEAD * 2 * (HD / 64) * (HD / 64), I_L = I_IN + I_OUT + I_G;
    for (int it = gw; it < DEPTH * I_L; it += NGW) {
        const int l = it / I_L; int r = it % I_L;
        if (r >= I_IN + I_OUT) { r -= I_IN + I_OUT; const int hg = r >> 2, kb = (r >> 1) & 1, nb = r & 1, h = hg >> 1, gsel = hg & 1;
            transpose_item((gsel ? F.wx : F.wa) + (size_t)(l * NHEAD + h) * HD * HD, HD, HD, F.WgT + (size_t)((l * NHEAD + h) * 2 + gsel) * HD * HD, 64 * nb, 64 * nb, nullptr, scr, 64 * kb, F.lane);
        } else if (r < I_IN) { const int kb = r / (DIN / 64), nb = r % (DIN / 64);
            transpose_item(F.w_in + (size_t)l * D * DIN, D, DIN, F.WinT + (size_t)l * DIN * D, 64 * nb, src_col(64 * nb), F.norm_g + l * D, scr, 64 * kb, F.lane);
        } else { r -= I_IN; const int kb = r / (D / 64), nb = r % (D / 64);
            transpose_item(F.w_out + (size_t)l * D * D, D, D, F.WoutT + (size_t)l * D * D, 64 * nb, 64 * nb, nullptr, scr, 64 * kb, F.lane); }
    }
    for (int m = gw; m < S; m += NGW) {
        const f32x4* xr = (const f32x4*)(F.x + (size_t)m * D) + F.lane; u32x2* ob = (u32x2*)(F.XB + (size_t)m * D) + F.lane; float s = 0.f;
#pragma unroll
        for (int j = 0; j < 8; ++j) { const f32x4 v = xr[64 * j]; s += (v.x * v.x + v.y * v.y) + (v.z * v.z + v.w * v.w); u32x2 w; w.x = pk2(v.x, v.y); w.y = pk2(v.z, v.w); ob[64 * j] = w; }
        s = wave_sum(s);
        if (F.lane < 32) F.SSQ[F.lane * S + m] = F.lane == 0 ? s : 0.f;
    }
}

#define DPP_MOV(x, ctrl) __builtin_bit_cast(float, __builtin_amdgcn_update_dpp(0, __builtin_bit_cast(int, (float)(x)), (ctrl), 0xf, 0xf, true))
template <int NV> __device__ __forceinline__ void block_sum(float (&v)[NV], LAS float* red  , int wave, int lane) {
#pragma unroll
    for (int i = 0; i < NV; ++i) v[i] += DPP_MOV(v[i], 0x128);
#pragma unroll
    for (int i = 0; i < NV; ++i) v[i] += DPP_MOV(v[i], 0x124);
#pragma unroll
    for (int i = 0; i < NV; ++i) v[i] += DPP_MOV(v[i], 0x4E);
#pragma unroll
    for (int i = 0; i < NV; ++i) v[i] += DPP_MOV(v[i], 0xB1);
    __builtin_amdgcn_sched_barrier(0);
    float t[NV];
#pragma unroll
    for (int i = 0; i < NV; ++i) t[i] = __shfl_xor(v[i], 16);
#pragma unroll
    for (int i = 0; i < NV; ++i) v[i] += t[i];
    __builtin_amdgcn_sched_barrier(0);
#pragma unroll
    for (int i = 0; i < NV; ++i) t[i] = __shfl_xor(v[i], 32);
#pragma unroll
    for (int i = 0; i < NV; ++i) v[i] += t[i];
    __builtin_amdgcn_sched_barrier(0);
    if (lane == 0) {
#pragma unroll
        for (int i = 0; i < NV; ++i) red[i * 8 + wave] = v[i]; }
    __syncthreads();
#pragma unroll
    for (int i = 0; i < NV; ++i) { const LAS f32x4* p = (const LAS f32x4*)(red + i * 8); const f32x4 a = p[0], b = p[1]; v[i] = ((a.x + a.y) + (a.z + a.w)) + ((b.x + b.y) + (b.z + b.w)); }
    __syncthreads();
}
constexpr int CT = 16;
__device__ __forceinline__ void conv_item(Frame& F, int l, int item) {
    LAS unsigned char* cs = F.lds;
    LAS float* red = (LAS float*)(F.lds + 62 * 2048);
    const int t0 = item * 32, c0 = 2 * F.tid;
    const auto rus = MAKE_RSRC(F.U, (size_t)S * UW * 2); const int c16 = F.tid & 127, rb = F.tid >> 7; u32x4 v[16];
#pragma unroll
    for (int i = 0; i < 16; ++i) { const int row = rb + 4 * i, sidx = t0 - 30 + row; v[i] = (u32x4){0u, 0u, 0u, 0u};
        if (row < 62 && sidx >= 0) v[i] = __builtin_bit_cast(u32x4, __builtin_amdgcn_raw_buffer_load_b128(rus, c16 * 16, sidx * (UW * 2), 0)); }
    f32x2 wv[31];
    const auto rw = MAKE_RSRC(F.cdw_w + (size_t)l * CW * DC, CW * DC * 4);
#pragma unroll
    for (int j = 0; j < 31; ++j) wv[j] = __builtin_bit_cast(f32x2, __builtin_amdgcn_raw_buffer_load_b64(rw, c0 * 4, (30 - j) * DC * 4, 0));
    const f32x2 bias = *(const f32x2*)(F.cdw_b + l * DC + c0);
    const f32x2 lg = *(const f32x2*)(F.cln_g + l * DC + c0), lb = *(const f32x2*)(F.cln_b + l * DC + c0);
    const auto ru = MAKE_RSRC(F.U, (size_t)S * UW * 2); const auto ry = MAKE_RSRC(F.Y, (size_t)S * D * 2);
    unsigned zwq[32];
#pragma unroll
    for (int i = 0; i < 32; ++i) zwq[i] = __builtin_amdgcn_raw_buffer_load_b32(ru, (1024 + c0) * 2, (t0 + i) * (UW * 2), 0);
#pragma unroll
    for (int i = 0; i < 16; ++i) { const int row = rb + 4 * i; if (row < 62) *(LAS u32x4*)(cs + row * 2048 + c16 * 16) = v[i]; }
    __syncthreads();
#pragma unroll 1
    for (int hb_ = 0; hb_ < ((PROBE_DUP & 64) ? 2 : 1) * (32 / CT); ++hb_) { const int hb = hb_ % (32 / CT);
        f32x2 acc[CT];
#pragma unroll
        for (int i = 0; i < CT; ++i) acc[i] = bias;
        const LAS unsigned char* cp = cs + (hb * CT) * 2048 + F.tid * 4;
        unsigned cwq[CT + 30];
#pragma unroll
        for (int si = 0; si < CT + 30; ++si) cwq[si] = *(const LAS unsigned*)(cp + si * 2048);
        static_assert(CT + 30 == 46, "operand lists below");
        asm volatile("" : "+v"(cwq[0]), "+v"(cwq[1]), "+v"(cwq[2]), "+v"(cwq[3]), "+v"(cwq[4]), "+v"(cwq[5]), "+v"(cwq[6]), "+v"(cwq[7]), "+v"(cwq[8]), "+v"(cwq[9]), "+v"(cwq[10]), "+v"(cwq[11]), "+v"(cwq[12]), "+v"(cwq[13]), "+v"(cwq[14]), "+v"(cwq[15]));
        asm volatile("" : "+v"(cwq[16]), "+v"(cwq[17]), "+v"(cwq[18]), "+v"(cwq[19]), "+v"(cwq[20]), "+v"(cwq[21]), "+v"(cwq[22]), "+v"(cwq[23]), "+v"(cwq[24]), "+v"(cwq[25]), "+v"(cwq[26]), "+v"(cwq[27]), "+v"(cwq[28]), "+v"(cwq[29]), "+v"(cwq[30]), "+v"(cwq[31]));
        asm volatile("" : "+v"(cwq[32]), "+v"(cwq[33]), "+v"(cwq[34]), "+v"(cwq[35]), "+v"(cwq[36]), "+v"(cwq[37]), "+v"(cwq[38]), "+v"(cwq[39]), "+v"(cwq[40]), "+v"(cwq[41]), "+v"(cwq[42]), "+v"(cwq[43]), "+v"(cwq[44]), "+v"(cwq[45]));
#pragma unroll
        for (int si = 0; si < CT + 30; ++si) {
            const unsigned cw = cwq[si];
            const f32x2 xv = (f32x2){bflo(cw), bfhi(cw)};
#pragma unroll
            for (int i = 0; i < CT; ++i) { const int j = i + 30 - si; if (j >= 0 && j <= 30) acc[i] = wv[j] * xv + acc[i]; }
            static_assert(CT == 16, "operand list below");
            asm volatile("" : "+v"(acc[0]), "+v"(acc[1]), "+v"(acc[2]), "+v"(acc[3]), "+v"(acc[4]), "+v"(acc[5]), "+v"(acc[6]), "+v"(acc[7]),
                              "+v"(acc[8]), "+v"(acc[9]), "+v"(acc[10]), "+v"(acc[11]), "+v"(acc[12]), "+v"(acc[13]), "+v"(acc[14]), "+v"(acc[15]));
        }
        float a0[CT], a1[CT];
#pragma unroll
        for (int i = 0; i < CT; ++i) { a0[i] = acc[i].x; a1[i] = acc[i].y; }
        float sv[CT];
#pragma unroll
        for (int i = 0; i < CT; ++i) sv[i] = a0[i] + a1[i];
        block_sum<CT>(sv, red, F.wave, F.lane);
#pragma unroll
        for (int i = 0; i < CT; ++i) { const float mean = sv[i] * (1.f / DC); a0[i] -= mean; a1[i] -= mean; sv[i] = a0[i] * a0[i] + a1[i] * a1[i]; }
        block_sum<CT>(sv, red, F.wave, F.lane);
#pragma unroll
        for (int i = 0; i < CT; ++i) {
            const int t = t0 + hb * CT + i;
            const float rstd = __builtin_amdgcn_rsqf(sv[i] * (1.f / DC) + LN_EPS);
            const unsigned zw = hb ? zwq[CT + i] : zwq[i];
            const float n0 = a0[i] * rstd * lg.x + lb.x, n1 = a1[i] * rstd * lg.y + lb.y;
            const float y0 = n0 * pg8::fsigm(n0) * bflo(zw), y1 = n1 * pg8::fsigm(n1) * bfhi(zw);
            __builtin_amdgcn_raw_buffer_store_b32(pk2(y0, y1), ry, c0 * 2, t * (D * 2), 0);
        }
    }
    __syncthreads();
}
#define DPP_ROW_SHR(x, oldv, d) __builtin_bit_cast(float, __builtin_amdgcn_update_dpp(__builtin_bit_cast(int, (float)(oldv)), __builtin_bit_cast(int, (float)(x)), 0x110 + (d), 0xf, 0xf, false))
#define DPP_ROW_BCAST15(x) __builtin_bit_cast(float, __builtin_amdgcn_update_dpp(0, __builtin_bit_cast(int, (float)(x)), 0x15F, 0xf, 0xf, true))
__device__ __forceinline__ unsigned* lru_flag(Frame& F, int l, int c, int h) { return F.ctl + CW_LRU + 64 * ((l * NLCH + c) * NHEAD + h); }
__device__ __forceinline__ void lru_item(Frame& F, int l, int item) {
    const int c = item >> 3, h = item & 7, t0 = c * LCH, ch0 = h * HD;
    LAS unsigned char* xhi = F.lds; LAS unsigned char* xlo = F.lds + LCH * XROW;
    const int tid = F.tid, lane = F.lane, w = F.wave, fr = lane & 15, fq = lane >> 4;
    const auto ru = MAKE_RSRC(F.U, (size_t)S * UW * 2); const auto ry = MAKE_RSRC(F.Y, (size_t)S * D * 2);
    const int chl = ch0 + 16 * w + 4 * fq;
    const f32x4 vba = *(const f32x4*)(F.ba + l * DL + chl), vbx = *(const f32x4*)(F.bx + l * DL + chl), vlam = *(const f32x4*)(F.lam + l * DL + chl);
    float c8l[4], c8x[4], nba[4], nbx[4], keep[4];
#pragma unroll
    for (int j = 0; j < 4; ++j) { const float c8 = 8.f * log_sigmoid(vlam[j]); c8l[j] = c8 * 1.44269504089f; c8x[j] = 2.f * c8; nba[j] = vba[j] * -1.44269504089f; nbx[j] = vbx[j] * -1.44269504089f; }
    keep[0] = fr < 1 ? 1.f : 0.f; keep[1] = fr < 2 ? 1.f : 0.f; keep[2] = fr < 4 ? 1.f : 0.f; keep[3] = fr < 8 ? 1.f : 0.f;
    bf16x8 br[4], bi[4];
    { const bf16_t* wg = F.WgT + (size_t)((l * NHEAD + h) * 2) * HD * HD + (size_t)(16 * w + fr) * HD + 8 * fq;
#pragma unroll
      for (int kk = 0; kk < 4; ++kk) { br[kk] = *(const bf16x8*)(wg + 32 * kk); bi[kk] = *(const bf16x8*)(wg + HD * HD + 32 * kk); } }
    {
        const int tg = tid >> 4, cg = tid & 15, tb = 8 * tg;
        const float* cw = F.lcw + (size_t)l * LW * DL + ch0 + 8 * cg;
        f32x4 wk[4][2];
#pragma unroll
        for (int k = 0; k < 4; ++k) { wk[k][0] = *(const f32x4*)(cw + (size_t)k * DL); wk[k][1] = *(const f32x4*)(cw + (size_t)k * DL + 4); }
        const f32x4 bb0 = *(const f32x4*)(F.lcb + l * DL + ch0 + 8 * cg), bb1 = *(const f32x4*)(F.lcb + l * DL + ch0 + 8 * cg + 4);
        u32x4 rows[11];
#pragma unroll
        for (int r = 0; r < 11; ++r) { const int sidx = t0 + tb - 3 + r; rows[r] = (u32x4){0u, 0u, 0u, 0u};
            if (sidx >= 0) rows[r] = __builtin_bit_cast(u32x4, __builtin_amdgcn_raw_buffer_load_b128(ru, (2048 + ch0 + 8 * cg) * 2, sidx * (UW * 2), 0)); }
#pragma unroll
        for (int i = 0; i < 8; ++i) {
            f32x4 a0 = bb0, a1 = bb1;
#pragma unroll
            for (int k = 0; k < 4; ++k) { const u32x4 q = rows[i + k];
                a0[0] += wk[k][0][0] * bflo(q.x); a0[1] += wk[k][0][1] * bfhi(q.x); a0[2] += wk[k][0][2] * bflo(q.y); a0[3] += wk[k][0][3] * bfhi(q.y);
                a1[0] += wk[k][1][0] * bflo(q.z); a1[1] += wk[k][1][1] * bfhi(q.z); a1[2] += wk[k][1][2] * bflo(q.w); a1[3] += wk[k][1][3] * bfhi(q.w); }
            u32x4 hi; hi.x = pk2(a0[0], a0[1]); hi.y = pk2(a0[2], a0[3]); hi.z = pk2(a1[0], a1[1]); hi.w = pk2(a1[2], a1[3]);
            u32x4 lo; lo.x = pk2(a0[0] - bflo(hi.x), a0[1] - bfhi(hi.x)); lo.y = pk2(a0[2] - bflo(hi.y), a0[3] - bfhi(hi.y)); lo.z = pk2(a1[0] - bflo(hi.z), a1[1] - bfhi(hi.z)); lo.w = pk2(a1[2] - bflo(hi.w), a1[3] - bfhi(hi.w));
            *(LAS u32x4*)(xhi + (tb + i) * XROW + cg * 16) = hi; *(LAS u32x4*)(xlo + (tb + i) * XROW + cg * 16) = lo; }
    }
    __syncthreads();
    float hl[16][4], pc[16][4], HC[4], PC[4];
#pragma unroll
    for (int j = 0; j < 4; ++j) { HC[j] = 0.f; PC[j] = 1.f; }
#pragma unroll
    for (int m = 0; m < 16; ++m) {
        f32x4 ar = (f32x4){0.f, 0.f, 0.f, 0.f}, ai = (f32x4){0.f, 0.f, 0.f, 0.f};
        const LAS unsigned char* rowp = xhi + (16 * m + fr) * XROW;
#pragma unroll
        for (int kk = 0; kk < 4; ++kk) { const bf16x8 a = *(const LAS bf16x8*)(rowp + (32 * kk + 8 * fq) * 2);
            ar = __builtin_amdgcn_mfma_f32_16x16x32_bf16(br[kk], a, ar, 0, 0, 0); ai = __builtin_amdgcn_mfma_f32_16x16x32_bf16(bi[kk], a, ai, 0, 0, 0); }
        const u32x2 qh = *(const LAS u32x2*)(rowp + (16 * w + 4 * fq) * 2), ql = *(const LAS u32x2*)(rowp + LCH * XROW + (16 * w + 4 * fq) * 2);
        const float xcv[4] = {bflo(qh.x) + bflo(ql.x), bfhi(qh.x) + bfhi(ql.x), bflo(qh.y) + bflo(ql.y), bfhi(qh.y) + bfhi(ql.y)};
        float Aj[4], Bj[4], xq[4];
#pragma unroll
        for (int j = 0; j < 4; ++j) {
            const float r = __builtin_amdgcn_rcpf(1.f + __builtin_amdgcn_exp2f(ar[j] * -1.44269504089f + nba[j])), ig = __builtin_amdgcn_rcpf(1.f + __builtin_amdgcn_exp2f(ai[j] * -1.44269504089f + nbx[j]));
            const float x = c8x[j] * r; xq[j] = x;
            float p = x * (1.f / 5040.f) + (1.f / 720.f); p = p * x + (1.f / 120.f); p = p * x + (1.f / 24.f); p = p * x + (1.f / 6.f); p = p * x + 0.5f; p = p * x + 1.f;
            Aj[j] = __builtin_amdgcn_exp2f(c8l[j] * r); Bj[j] = __builtin_amdgcn_sqrtf(-x * p) * (ig * xcv[j]); }
        if (__builtin_expect(__any(fminf(fminf(xq[0], xq[1]), fminf(xq[2], xq[3])) <= -0.35f), 0)) {
#pragma unroll
            for (int j = 0; j < 4; ++j) if (xq[j] <= -0.35f) { const float r = __builtin_amdgcn_rcpf(1.f + __builtin_amdgcn_exp2f(ar[j] * -1.44269504089f + nba[j])), ig = __builtin_amdgcn_rcpf(1.f + __builtin_amdgcn_exp2f(ai[j] * -1.44269504089f + nbx[j]));
                (void)r; Bj[j] = __builtin_amdgcn_sqrtf(1.f - __builtin_amdgcn_exp2f(xq[j] * 1.44269504089f)) * (ig * xcv[j]); } }
#define LRU_PIN asm volatile("" : "+v"(Aj[0]), "+v"(Aj[1]), "+v"(Aj[2]), "+v"(Aj[3]), "+v"(Bj[0]), "+v"(Bj[1]), "+v"(Bj[2]), "+v"(Bj[3]))
#define DPP_SHR0(x, d) __builtin_bit_cast(float, __builtin_amdgcn_update_dpp(0, __builtin_bit_cast(int, (float)(x)), 0x110 + (d), 0xf, 0xf, true))
#define LRU_SCAN_STEP(d, kd) { \
            _Pragma("unroll") for (int j = 0; j < 4; ++j) { Bj[j] = DPP_SHR0(Bj[j], d) * Aj[j] + Bj[j]; } \
            _Pragma("unroll") for (int j = 0; j < 4; ++j) { const float t = DPP_SHR0(Aj[j], d) + keep[kd]; Aj[j] = Aj[j] * t; } LRU_PIN; }
        LRU_PIN; LRU_SCAN_STEP(1, 0) LRU_SCAN_STEP(2, 1) LRU_SCAN_STEP(4, 2) LRU_SCAN_STEP(8, 3)
#undef LRU_SCAN_STEP
#undef LRU_PIN
#pragma unroll
        for (int j = 0; j < 4; ++j) { hl[m][j] = Bj[j] + Aj[j] * HC[j]; pc[m][j] = Aj[j] * PC[j]; }
#pragma unroll
        for (int j = 0; j < 4; ++j) { HC[j] = DPP_ROW_BCAST15(hl[m][j]); PC[j] = DPP_ROW_BCAST15(pc[m][j]); }
    }
    const int vo_u = (fr * UW + 3072 + chl) * 2, vo_y = (fr * D + DC + chl) * 2;
    u32x2 zq[16];
#pragma unroll
    for (int m = 0; m < 16; ++m) zq[m] = __builtin_bit_cast(u32x2, __builtin_amdgcn_raw_buffer_load_b64(ru, vo_u, (t0 + 16 * m) * (UW * 2), 0));
    if (fr == 15) { unsigned long long* sp = F.SUM + (size_t)(l * NLCH + c) * DL + chl;
#pragma unroll
        for (int j = 0; j < 4; ++j) __hip_atomic_store(sp + j, ((unsigned long long)__builtin_bit_cast(unsigned, HC[j]) << 32) | __builtin_bit_cast(unsigned, PC[j]), __ATOMIC_RELAXED, __HIP_MEMORY_SCOPE_AGENT); }
    asm volatile("s_waitcnt vmcnt(0)" ::: "memory");
    __syncthreads();
    if (tid == 0) __hip_atomic_store(lru_flag(F, l, c, h), 1u, __ATOMIC_RELAXED, __HIP_MEMORY_SCOPE_AGENT);
    float Hin[4] = {0.f, 0.f, 0.f, 0.f};
    if (c > 0) {
        if (w == 0) {
            unsigned* fp = lru_flag(F, l, lane < c ? lane : 0, h); unsigned spins = 0;
            for (;;) { const unsigned v = __hip_atomic_load(fp, __ATOMIC_RELAXED, __HIP_MEMORY_SCOPE_AGENT); if (__all(v != 0u)) break; __builtin_amdgcn_s_sleep(2); if (++spins > (1u << 20)) break; }
            __builtin_amdgcn_fence(__ATOMIC_ACQUIRE, "agent");
            asm volatile("s_waitcnt vmcnt(0)" ::: "memory");
        }
        __syncthreads();
        const unsigned long long* sp = F.SUM + (size_t)(l * NLCH) * DL + chl;
        u32x4 q[2][2];
#pragma unroll
        for (int g = 0; g < 2; ++g) { const int cc = fr + 16 * g; q[g][0] = (u32x4){0x3f800000u, 0u, 0x3f800000u, 0u}; q[g][1] = q[g][0];
            if (cc < c) { q[g][0] = *(const u32x4*)(sp + (size_t)cc * DL); q[g][1] = *(const u32x4*)(sp + (size_t)cc * DL + 2); } }
#pragma unroll
        for (int j = 0; j < 4; ++j) { float Hq[2];
#pragma unroll
            for (int g = 0; g < 2; ++g) { const u32x4 qq = q[g][j >> 1]; float A = (j & 1) ? u2f(qq.z) : u2f(qq.x), B = (j & 1) ? u2f(qq.w) : u2f(qq.y);
#define LRU_SCAN_STEP(d) { const float ap = DPP_ROW_SHR(A, 1.0f, d), bp = DPP_ROW_SHR(B, 0.0f, d); B = A * bp + B; A = ap * A; }
                LRU_SCAN_STEP(1) LRU_SCAN_STEP(2) LRU_SCAN_STEP(4) LRU_SCAN_STEP(8)
#undef LRU_SCAN_STEP
                const float At = DPP_ROW_BCAST15(A), Bt = DPP_ROW_BCAST15(B);
                Hq[g] = g == 0 ? Bt : At * Hq[0] + Bt; }
            Hin[j] = Hq[1]; }
    }
#pragma unroll
    for (int m = 0; m < 16; ++m) { const int trow = t0 + 16 * m; const unsigned zx = zq[m].x, zy = zq[m].y;
        const float y0 = (hl[m][0] + pc[m][0] * Hin[0]) * bflo(zx), y1 = (hl[m][1] + pc[m][1] * Hin[1]) * bfhi(zx), y2 = (hl[m][2] + pc[m][2] * Hin[2]) * bflo(zy), y3 = (hl[m][3] + pc[m][3] * Hin[3]) * bfhi(zy);
        u32x2 o; o.x = pk2(y0, y1); o.y = pk2(y2, y3);
        __builtin_amdgcn_raw_buffer_store_b64(o, ry, vo_y, trow * (D * 2), 0); }
    __syncthreads();
}
__device__ __forceinline__ void p_mix(Frame& F, int l) {
    PHASE_TID(F);
    constexpr int NCONV = S / 32, NLRU = NLCH * NHEAD;
    for (int rep = 0; rep < ((PROBE_DUP & 8) ? 2 : 1); ++rep)
    for (int it = F.bid; it < NLRU; it += F.G) { PHASE_TID(F); lru_item(F, l, it); }
    for (int rep = 0; rep < ((PROBE_DUP & 16) ? 2 : 1); ++rep)
    for (int it = F.bid; it < NCONV; it += F.G) { PHASE_TID(F); conv_item(F, l, it); }
}
__device__ __forceinline__ void p_final(Frame& F) {
    PHASE_TID(F);
    const int gw = F.bid * NWAVES + F.wave, NGW = F.G * NWAVES;
    for (int m = gw; m < S; m += NGW) {
        float ss = 0.f;
#pragma unroll
        for (int p = 0; p < 32; ++p) ss += F.SSQ[p * S + m];
        const float rstd = 1.f / sqrtf(ss * (1.f / D) + RMS_EPS);
        f32x4* orow = (f32x4*)(F.out + (size_t)m * D) + F.lane; const f32x4* gr = (const f32x4*)F.final_g + F.lane;
#pragma unroll
        for (int j = 0; j < 8; ++j) orow[64 * j] = orow[64 * j] * rstd * gr[64 * j];
    }
}

constexpr int PH_PER_LAYER = 3, NPH = 1 + DEPTH * PH_PER_LAYER + 1;
struct Args { const float* in[16]; float* out; unsigned char* ws; int ph_lo, ph_hi; };
__global__ void __launch_bounds__(NTHREADS, 2) mk_fwd(Args a) {
    extern __shared__ __attribute__((aligned(16))) unsigned char lds_raw[];
    Frame F;
    F.lds = (LAS unsigned char*)lds_raw;
    F.wave = __builtin_amdgcn_readfirstlane(threadIdx.x >> 6); F.tid = threadIdx.x; F.lane = F.tid & 63; F.bid = blockIdx.x; F.G = gridDim.x;
    F.x = a.in[0]; F.norm_g = a.in[1]; F.w_in = a.in[2]; F.cdw_w = a.in[3]; F.cdw_b = a.in[4]; F.cln_g = a.in[5]; F.cln_b = a.in[6]; F.lcw = a.in[7]; F.lcb = a.in[8];
    F.wa = a.in[9]; F.ba = a.in[10]; F.wx = a.in[11]; F.bx = a.in[12]; F.lam = a.in[13]; F.w_out = a.in[14]; F.final_g = a.in[15]; F.out = a.out;
    unsigned char* ws = a.ws;
    F.WinT = (bf16_t*)(ws + WS_WINT); F.WoutT = (bf16_t*)(ws + WS_WOUTT); F.XB = (bf16_t*)(ws + WS_XB); F.U = (bf16_t*)(ws + WS_U); F.Y = (bf16_t*)(ws + WS_Y);
    F.SSQ = (float*)(ws + WS_SSQ); F.SUM = (unsigned long long*)(ws + WS_SUM); F.WgT = (bf16_t*)(ws + WS_WG); F.ctl = (unsigned*)(ws + WS_CTL);
    volatile LAS unsigned* bst = (volatile LAS unsigned*)(F.lds + LDS_BYTES - 64);
    if (F.tid < 16) bst[F.tid] = 0u;
    __syncthreads();
    XcdBarrier bar; bar.bar = (unsigned*)(ws + WS_CTL) + CW_BAR; bar.x = 0; bar.st = bst;
    if (MK_ONE_LAUNCH) bar = xcd_barrier_post((unsigned*)(ws + WS_CTL) + CW_BAR, bst);
    bar.wave = F.wave;
    for (int ph = a.ph_lo; ph < a.ph_hi; ++ph) {
      const int jj = (ph == 0 || ph == NPH - 1) ? -1 : (ph - 1) % PH_PER_LAYER;
      const int reps = ((PROBE_DUP & 1) && ph == 0) || ((PROBE_DUP & 2) && jj == 0) || ((PROBE_DUP & 4) && jj == 1) ? 2 : 1;
      for (int rep = 0; rep < reps; ++rep) {
        if (rep) xcd_barrier(bar);
        if (ph == 0) p_prologue(F);
        else if (ph == NPH - 1) p_final(F);
        else { const int l = (ph - 1) / PH_PER_LAYER, j = (ph - 1) % PH_PER_LAYER;
            if (j == 0) { pg8::Gemm g{F.XB, F.WinT + (size_t)l * DIN * D, S, DIN, D}; pg8::OrderRstd Sd; Sd.init(S, DIN, F.G, F.bid); Sd.ssq = F.SSQ; Sd.rtab = (LAS float*)(F.lds + pg8::RTAB_OFF); Sd.wave = F.wave;
                pg8::EpiIn E{F.U, (const LAS float*)(F.lds + pg8::RTAB_OFF)};
                pg8::gemm_phase<pg8::EpiIn, pg8::OrderRstd, true, true>(F.lds, g, Sd, E, F.wave); }
            else if (j == 1) p_mix(F, l);
            else { pg8::Gemm g{F.Y, F.WoutT + (size_t)l * D * D, S, D, D}; pg8::StaticOrder Sd; Sd.init(S, D, F.G, F.bid);
                pg8::EpiOut E{l == DEPTH - 1 ? F.out : nullptr, F.XB, F.SSQ};
                pg8::gemm_phase<pg8::EpiOut, pg8::StaticOrder, true, true>(F.lds, g, Sd, E, F.wave); }
        }
      }
        if (ph + 1 < a.ph_hi) xcd_barrier(bar);
    }
}

extern "C" void kernel_launch(void* const* d_in, const int* in_sizes, int n_in, void* d_out, int out_size, void* d_ws, size_t ws_size, hipStream_t stream) {
    static int grid = 0;
    if (grid == 0) {
        if (n_in != 16 || in_sizes[0] != S * D || out_size != S * D || ws_size < WS_END) { fprintf(stderr, "kernel_launch: unexpected shapes (n_in %d, in0 %d, out %d, ws %zu)\n", n_in, n_in > 0 ? in_sizes[0] : -1, out_size, ws_size); grid = -1; return; }
        int dev = 0, cus = 0, per_cu = 0;
        if (hipGetDevice(&dev) != hipSuccess || hipDeviceGetAttribute(&cus, hipDeviceAttributeMultiprocessorCount, dev) != hipSuccess) { grid = -1; return; }
        if (hipFuncSetAttribute((const void*)mk_fwd, hipFuncAttributeMaxDynamicSharedMemorySize, LDS_BYTES) != hipSuccess) { fprintf(stderr, "kernel_launch: hipFuncSetAttribute failed\n"); grid = -1; return; }
        if (hipOccupancyMaxActiveBlocksPerMultiprocessor(&per_cu, (const void*)mk_fwd, NTHREADS, LDS_BYTES) != hipSuccess || per_cu < 1) fprintf(stderr, "kernel_launch: occupancy query says %d per CU\n", per_cu);
        (void)hipGetLastError();
        grid = cus;
    }
    if (grid < 0) return;
    (void)hipMemsetAsync((char*)d_ws + WS_CTL, 0, CTL_ZERO_BYTES, stream);
    Args a{};
    for (int i = 0; i < 16; ++i) a.in[i] = (const float*)d_in[i];
    a.out = (float*)d_out; a.ws = (unsigned char*)d_ws;
#if MK_ONE_LAUNCH
    a.ph_lo = 0; a.ph_hi = NPH;
    hipLaunchKernelGGL(mk_fwd, dim3(grid), dim3(NTHREADS), LDS_BYTES, stream, a);
#else
    for (int ph = 0; ph < NPH; ++ph) { a.ph_lo = ph; a.ph_hi = ph + 1; hipLaunchKernelGGL(mk_fwd, dim3(grid), dim3(NTHREADS), LDS_BYTES, stream, a); }
#endif
}
```

```cpp
#include <hip/hip_runtime.h>
#include <cstdio>
#include <cstdint>

#ifndef MK_ONE_LAUNCH
#define MK_ONE_LAUNCH 1
#endif

#ifndef PROBE_DUP
#define PROBE_DUP 0
#endif
#define LAS __attribute__((address_space(3)))
#define GAS __attribute__((address_space(1)))
typedef unsigned short bf16_t;
typedef short bf16x8 __attribute__((ext_vector_type(8)));
typedef float f32x4 __attribute__((ext_vector_type(4)));
typedef float f32x2 __attribute__((ext_vector_type(2)));
typedef unsigned u32x4 __attribute__((ext_vector_type(4)));
typedef unsigned u32x2 __attribute__((ext_vector_type(2)));

constexpr int S = 8192, D = 2048, DEPTH = 4, DC = 1024, DL = 1024, DIN = 5120, NHEAD = 8, HD = 128, CW = 31, LW = 4;
constexpr int UW = 4096;
constexpr float RMS_EPS = 1e-6f, LN_EPS = 1e-5f;
constexpr int NTHREADS = 512, NWAVES = 8;
constexpr int LDS_BYTES = 147456;
constexpr int LCH = 256, NLCH = S / LCH;
constexpr int XROW = 272;
constexpr int CW_BAR = 4096, CW_LRU = 16384;

constexpr size_t MiB = 1u << 20;
constexpr size_t WS_CTL = 0, CTL_ZERO_BYTES = 1 * MiB;
constexpr size_t WS_WINT = 2 * MiB;
constexpr size_t WS_WOUTT = 82 * MiB;
constexpr size_t WS_XB = 114 * MiB;
constexpr size_t WS_U = 146 * MiB;
constexpr size_t WS_Y = 210 * MiB;
constexpr size_t WS_SSQ = 242 * MiB;
constexpr size_t WS_SUM = 243 * MiB;
constexpr size_t WS_WG = 244 * MiB;
constexpr size_t WS_END = 246 * MiB;

__device__ __forceinline__ int opaque_tid(int wave);
#define MAKE_RSRC(p, bytes) __builtin_amdgcn_make_buffer_rsrc((void*)(p), 0, (int)(bytes), 0x00020000)
__device__ __forceinline__ unsigned f2bf(float f) { unsigned u = __builtin_bit_cast(unsigned, f); return (u + 0x7fffu + ((u >> 16) & 1u)) >> 16; }
__device__ __forceinline__ unsigned pk2(float lo, float hi) { return f2bf(lo) | (f2bf(hi) << 16); }
__device__ __forceinline__ float bflo(unsigned w) { return __builtin_bit_cast(float, w << 16); }
__device__ __forceinline__ float bfhi(unsigned w) { return __builtin_bit_cast(float, w & 0xffff0000u); }
__device__ __forceinline__ float u2f(unsigned u) { return __builtin_bit_cast(float, u); }
__device__ __forceinline__ float bf2f(bf16_t b) { return __builtin_bit_cast(float, (unsigned)b << 16); }
__device__ __forceinline__ float sigm(float x) { return 1.f / (1.f + __expf(-x)); }
__device__ __forceinline__ float siluf(float x) { return x * sigm(x); }
__device__ __forceinline__ float wave_sum(float v) {
#pragma unroll
    for (int o = 1; o < 64; o <<= 1) v += __shfl_xor(v, o);
    return v;
}
__device__ __forceinline__ float neg_expm1(float x) {
    float p = 1.f + x * (1.f / 8.f); p = 1.f + x * (1.f / 7.f) * p; p = 1.f + x * (1.f / 6.f) * p; p = 1.f + x * (1.f / 5.f) * p; p = 1.f + x * 0.25f * p; p = 1.f + x * (1.f / 3.f) * p; p = 1.f + x * 0.5f * p;
    const float big = 1.f - __builtin_amdgcn_exp2f(x * 1.44269504089f);
    return x > -0.35f ? -x * p : big;
}
__device__ __forceinline__ float log_sigmoid(float x) { return fminf(x, 0.f) - log1pf(expf(-fabsf(x))); }
__host__ __device__ __forceinline__ int src_col(int np) { if (np < 2048) { const int p = np >> 8, j = np & 255; return j < 128 ? 128 * p + j : 1024 + 128 * p + (j - 128); } return np; }

#define XB_TMO      128
#define XB_XCNT(j)  (256  + 64 * (j))
#define XB_XSUB(j)  (1280 + 64 * (j))
#define XB_XGEN(j)  (2304 + 64 * (j))
#define XB_TOP      3328
#define XB_TOPGEN   3392
#define XCD_BAR_WORDS 3456
#define XB_SPIN_CAP (1u << 18)
__device__ __forceinline__ unsigned xb_ld(unsigned* p)              { return __hip_atomic_load(p, __ATOMIC_RELAXED, __HIP_MEMORY_SCOPE_AGENT); }
__device__ __forceinline__ unsigned xb_add(unsigned* p, unsigned v) { return __hip_atomic_fetch_add(p, v, __ATOMIC_RELAXED, __HIP_MEMORY_SCOPE_AGENT); }
__device__ __forceinline__ unsigned xb_xcc_id() { return (unsigned)__builtin_amdgcn_s_getreg((3 << 11) | 20) & 0xFu; }
#define XB_SPIN(cond, bar) do { unsigned _sp = 0; while (cond) { __builtin_amdgcn_s_sleep(1); \
    if ((++_sp & 255u) == 0u) { if (xb_ld(&(bar)[XB_TMO])) break; if (_sp > XB_SPIN_CAP) { atomicAdd(&(bar)[XB_TMO], 1u); break; } } } } while (0)
struct XcdBarrier { unsigned* bar; unsigned x; volatile LAS unsigned* st; int wave; };
__device__ __forceinline__ XcdBarrier xcd_barrier_post(unsigned* bar, volatile LAS unsigned* st) {
    XcdBarrier b; b.bar = bar; b.x = xb_xcc_id(); b.st = st;
    if (threadIdx.x == 0) (void)xb_add(&bar[XB_XCNT(b.x)], 1u);
    return b;
}
__device__ __forceinline__ void xcd_barrier_complete(unsigned* bar, unsigned x, unsigned& nloc, unsigned& nx) {
    const unsigned G = gridDim.x * gridDim.y * gridDim.z;
    unsigned sum, cnt, mine, sp = 0u;
    for (;;) {
        sum = 0u; cnt = 0u; mine = 0u;
#pragma unroll
        for (unsigned j = 0; j < 16; ++j) { const unsigned c = xb_ld(&bar[XB_XCNT(j)]); sum += c; cnt += (c > 0u) ? 1u : 0u; mine = (j == x) ? c : mine; }
        if (sum == G) break;
        __builtin_amdgcn_s_sleep(1);
        if ((++sp & 255u) == 0u) { if (xb_ld(&bar[XB_TMO])) break; if (sp > XB_SPIN_CAP) { atomicAdd(&bar[XB_TMO], 1u); break; } }
    }
    nloc = mine > 0u ? mine : 1u; nx = cnt > 0u ? cnt : 1u;
}
__device__ __forceinline__ void xcd_barrier(const XcdBarrier& b) {
    asm volatile("s_waitcnt vmcnt(0)" ::: "memory");
    __syncthreads();
    if (opaque_tid(b.wave) == 0) {
        unsigned* bar = b.bar;
        __builtin_amdgcn_s_waitcnt(0);
        unsigned nloc = b.st[0], nx = b.st[1];
        if (nloc == 0u) { xcd_barrier_complete(bar, b.x, nloc, nx); b.st[0] = nloc; b.st[1] = nx; }
        const unsigned old = xb_add(&bar[XB_XSUB(b.x)], 1u);
        const unsigned gen = old / nloc;
        if (old + 1u == (gen + 1u) * nloc) {
            __builtin_amdgcn_fence(__ATOMIC_RELEASE, "agent");
            asm volatile("s_waitcnt vmcnt(0)" ::: "memory");
            const unsigned og = xb_add(&bar[XB_TOP], 1u);
            const unsigned tg = og / nx;
            if (og + 1u == (tg + 1u) * nx) xb_add(&bar[XB_TOPGEN], 1u);
            else XB_SPIN(xb_ld(&bar[XB_TOPGEN]) == tg, bar);
            __builtin_amdgcn_fence(__ATOMIC_ACQUIRE, "agent");
            xb_add(&bar[XB_XGEN(b.x)], 1u);
            asm volatile("s_waitcnt vmcnt(0)" ::: "memory");
        } else {
            XB_SPIN(xb_ld(&bar[XB_XGEN(b.x)]) == gen, bar);
            __builtin_amdgcn_fence(__ATOMIC_ACQUIRE, "agent");
            asm volatile("s_waitcnt vmcnt(0)" ::: "memory");
        }
    }
    __syncthreads();
}

struct Frame {
    LAS unsigned char* lds;
    int tid, lane, wave, bid, G;
    const float *x, *norm_g, *w_in, *cdw_w, *cdw_b, *cln_g, *cln_b, *lcw, *lcb, *wa, *ba, *wx, *bx, *lam, *w_out, *final_g;
    float* out;
    bf16_t *WinT, *WoutT, *XB, *U, *Y;
    float *SSQ; unsigned long long* SUM; bf16_t* WgT; unsigned* ctl;
};

namespace pg8 {
#define PG8_LAS __attribute__((address_space(3)))
typedef unsigned short bf16_t;
typedef short bf16x8 __attribute__((ext_vector_type(8)));
typedef float f32x4 __attribute__((ext_vector_type(4)));
typedef unsigned u32x4 __attribute__((ext_vector_type(4)));
constexpr int BM = 256, BK = 64, HALF = 128, HTB = HALF * BK * 2  , STAGE_BYTES = 8 * HTB, NXCD = 8, WGM = 8;

__host__ __device__ __forceinline__ int lds_byte(int r, int c) { const int st = (r >> 4) * 2 + (c >> 5), rr = r & 15, cc = c & 31, ob = rr * 64 + cc * 2; return st * 1024 + (ob ^ (((ob >> 9) & 1) << 5)); }
__host__ __device__ __forceinline__ void stage_rc(int b, int& R, int& C) { const int st = b / 1024, sb = b % 1024, swz = sb ^ (((sb >> 9) & 1) << 5); R = (st >> 1) * 16 + swz / 64; C = (st & 1) * 32 + (swz % 64) / 2; }
__host__ __device__ __forceinline__ int perm32(int rho) { const int n = rho >> 4, i = rho & 15; return 8 * (i >> 2) + 4 * n + (i & 3); }

struct Unit { int pm, pn; };
struct Gemm { const bf16_t* A; const bf16_t* Bt; int M, N, K; };

struct StaticOrder {
    int nM, nN, nwg, G, c;
    __host__ __device__ void init(int M, int N, int G_, int c_) { nM = M / BM; nN = N / BM; nwg = nM * nN; G = G_; c = c_; }
    __host__ __device__ bool next(int i, Unit& u) const {
        const long L = (long)i * G + c; if (L >= nwg) return false;
        int wgid = (int)L; { const int q = nwg / NXCD, r = nwg % NXCD, xcd = wgid % NXCD, off = wgid / NXCD; wgid = (xcd < r ? xcd * (q + 1) : r * (q + 1) + (xcd - r) * q) + off; }
        const int nig = WGM * nN, gid = wgid / nig, fm = gid * WGM, gsz = (nM - fm) < WGM ? (nM - fm) : WGM;
        u.pm = fm + ((wgid % nig) % gsz); u.pn = (wgid % nig) / gsz; return true;
    }
    __device__ __forceinline__ void a_ready(const Unit&, int) const {}
    __device__ __forceinline__ void done(const Unit&) const {}
};


__device__ __forceinline__ unsigned cvt_pk_bf16(float lo, float hi) { unsigned r; asm volatile("v_cvt_pk_bf16_f32 %0, %1, %2" : "=v"(r) : "v"(lo), "v"(hi)); return r; }
__device__ __forceinline__ float fsigm(float x) { return __builtin_amdgcn_rcpf(1.f + __builtin_amdgcn_exp2f(x * -1.44269504089f)); }
constexpr int RTAB_OFF = STAGE_BYTES;

struct OrderRstd : StaticOrder {
    const float* ssq; PG8_LAS float* rtab; int wave;
    __device__ __forceinline__ void a_ready(const Unit& u, int ui) const {
        const int t_ = opaque_tid(wave), wid = wave, lane = t_ & 63, rl = wid * 32 + (lane & 31), half = lane >> 5;
        const float* p = ssq + (size_t)(half * 16) * 8192 + u.pm * BM + rl; float s = 0.f;
#pragma unroll
        for (int q = 0; q < 16; ++q) s += p[(size_t)q * 8192];
        s += __shfl_xor(s, 32);
        if (lane < 32) rtab[(ui & 1) * 256 + rl] = 1.0f / sqrtf(s * (1.0f / 2048.0f) + 1e-6f);
    }
};
struct EpiIn {
    static constexpr bool PERM = true, AFTER_DRAIN = false;
    bf16_t* U; const PG8_LAS float* rtab;
    __device__ __forceinline__ void operator()(const f32x4 (&acc)[2][2][4][2], const Unit& u, int wr, int wc, int fr, int fq, int ui) const {
        const PG8_LAS float* rt = rtab + (ui & 1) * 256 + wr * 64 + fr;
        if (u.pn < 8) {
            bf16_t* base = U + (size_t)(u.pm * BM + wr * 64 + fr) * 4096 + 128 * u.pn + wc * 32 + 8 * fq;
#pragma unroll
            for (int ai = 0; ai < 2; ++ai)
#pragma unroll
                for (int m = 0; m < 4; ++m) { const float rs = rt[ai * HALF + m * 16];
                    const f32x4 v0 = acc[ai][0][m][0] * rs, v1 = acc[ai][0][m][1] * rs, g0 = acc[ai][1][m][0] * rs, g1 = acc[ai][1][m][1] * rs;
                    u32x4 w; w.x = cvt_pk_bf16(v0[0] * fsigm(g0[0]), v0[1] * fsigm(g0[1])); w.y = cvt_pk_bf16(v0[2] * fsigm(g0[2]), v0[3] * fsigm(g0[3]));
                    w.z = cvt_pk_bf16(v1[0] * fsigm(g1[0]), v1[1] * fsigm(g1[1])); w.w = cvt_pk_bf16(v1[2] * fsigm(g1[2]), v1[3] * fsigm(g1[3]));
                    *(u32x4*)(base + (size_t)(ai * HALF + m * 16) * 4096) = w; }
        } else {
            const bool act = (u.pn < 12) || (u.pn >= 16);
            bf16_t* base = U + (size_t)(u.pm * BM + wr * 64 + fr) * 4096 + (256 * u.pn - 1024) + wc * 32 + 8 * fq;
#pragma unroll
            for (int ai = 0; ai < 2; ++ai)
#pragma unroll
                for (int m = 0; m < 4; ++m) { const float rs = rt[ai * HALF + m * 16];
#pragma unroll
                    for (int bj = 0; bj < 2; ++bj) { f32x4 v0 = acc[ai][bj][m][0] * rs, v1 = acc[ai][bj][m][1] * rs;
                        if (act) {
#pragma unroll
                            for (int e = 0; e < 4; ++e) { v0[e] = v0[e] * fsigm(v0[e]); v1[e] = v1[e] * fsigm(v1[e]); } }
                        u32x4 w; w.x = cvt_pk_bf16(v0[0], v0[1]); w.y = cvt_pk_bf16(v0[2], v0[3]); w.z = cvt_pk_bf16(v1[0], v1[1]); w.w = cvt_pk_bf16(v1[2], v1[3]);
                        *(u32x4*)(base + (size_t)(ai * HALF + m * 16) * 4096 + bj * HALF) = w; } }
        }
    }
};
struct EpiOut {
    static constexpr bool PERM = true, AFTER_DRAIN = false;
    float* out; bf16_t* XB; float* ssq;
    __device__ __forceinline__ void operator()(const f32x4 (&acc)[2][2][4][2], const Unit& u, int wr, int wc, int fr, int fq, int) const {
#pragma unroll
        for (int ai = 0; ai < 2; ++ai) {
            u32x4 xo[4][2];
#pragma unroll
            for (int m = 0; m < 4; ++m)
#pragma unroll
                for (int bj = 0; bj < 2; ++bj) xo[m][bj] = *(const u32x4*)(XB + (size_t)(u.pm * BM + ai * HALF + wr * 64 + m * 16 + fr) * 2048 + u.pn * BM + wc * 32 + 8 * fq + bj * HALF);
#pragma unroll
            for (int m = 0; m < 4; ++m) { const int row = u.pm * BM + ai * HALF + wr * 64 + m * 16 + fr; const size_t off = (size_t)row * 2048 + u.pn * BM + wc * 32 + 8 * fq; float s = 0.f;
#pragma unroll
                for (int bj = 0; bj < 2; ++bj) { const u32x4 q = xo[m][bj];
                    const f32x4 x0 = (f32x4){__builtin_bit_cast(float, q.x << 16), __builtin_bit_cast(float, q.x & 0xffff0000u), __builtin_bit_cast(float, q.y << 16), __builtin_bit_cast(float, q.y & 0xffff0000u)};
                    const f32x4 x1 = (f32x4){__builtin_bit_cast(float, q.z << 16), __builtin_bit_cast(float, q.z & 0xffff0000u), __builtin_bit_cast(float, q.w << 16), __builtin_bit_cast(float, q.w & 0xffff0000u)};
                    const f32x4 v0 = x0 + acc[ai][bj][m][0], v1 = x1 + acc[ai][bj][m][1];
                    if (out) { *(f32x4*)(out + off + bj * HALF) = v0; *(f32x4*)(out + off + bj * HALF + 4) = v1; }
                    else { u32x4 w; w.x = cvt_pk_bf16(v0[0], v0[1]); w.y = cvt_pk_bf16(v0[2], v0[3]); w.z = cvt_pk_bf16(v1[0], v1[1]); w.w = cvt_pk_bf16(v1[2], v1[3]);
                        *(u32x4*)(XB + off + bj * HALF) = w; }
                    s += (v0[0] * v0[0] + v0[1] * v0[1]) + (v0[2] * v0[2] + v0[3] * v0[3]) + (v1[0] * v1[0] + v1[1] * v1[1]) + (v1[2] * v1[2] + v1[3] * v1[3]); }
                s += __shfl_xor(s, 16); s += __shfl_xor(s, 32);
                if (fq == 0) ssq[(size_t)(u.pn * 4 + wc) * 8192 + row] = s; }
            asm volatile("" ::: "memory"); }
    }
};

template <class Epi, class Sched, bool ALIGN_EPI = false, bool SP2 = false>
__device__ __forceinline__ void gemm_phase(PG8_LAS unsigned char* lds, const Gemm g, const Sched& S, const Epi& E, const int wave_in) {
    const int tid = opaque_tid(wave_in), wid = wave_in,
        lane = tid & 63, wr = wid >> 2, wc = wid & 3, fr = lane & 15, fq = lane >> 4;
    const int K = g.K, nt = K / BK;
    unsigned voffA[2], voffB[2];
#pragma unroll
    for (int i = 0; i < 2; ++i) { int R, C; stage_rc(tid * 16 + i * 8192, R, C); const int Rb = Epi::PERM ? ((R & ~31) + perm32(R & 31)) : R;
        voffA[i] = (unsigned)(R * K + C) * 2u; voffB[i] = (unsigned)(Rb * K + C) * 2u; }
    const size_t kstep = (size_t)(BK * 2);
    const size_t hstep = (size_t)HALF * K * 2;
    const size_t tstep = 2 * hstep;
    const unsigned ldsw = (unsigned)wid * 1024u;
    const int aoff = lds_byte(wr * 64 + fr, fq * 8), boff = lds_byte(wc * 32 + fr, fq * 8);
#define PG8_SA(b, h) (((b) * 2 + (h)) * HTB)
#define PG8_SB(b, h) ((4 + (b) * 2 + (h)) * HTB)
#define PG8_STAGE(bufoff, gbase, voff) do { _Pragma("unroll") for (int _i = 0; _i < 2; ++_i) \
        __builtin_amdgcn_global_load_lds((const unsigned*)((const char*)(gbase) + (voff)[_i]), (PG8_LAS unsigned*)(lds + (bufoff) + ldsw + _i * 8192), 16, 0, 0); } while (0)
#define PG8_LDA(dst, b, h) do { _Pragma("unroll") for (int m = 0; m < 4; ++m) _Pragma("unroll") for (int k = 0; k < 2; ++k) dst[m][k] = *(const PG8_LAS bf16x8*)(lds + PG8_SA(b, h) + aoff + m * 2048 + k * 1024); } while (0)
#define PG8_LDB(dst, b, h) do { _Pragma("unroll") for (int n = 0; n < 2; ++n) _Pragma("unroll") for (int k = 0; k < 2; ++k) dst[n][k] = *(const PG8_LAS bf16x8*)(lds + PG8_SB(b, h) + boff + n * 2048 + k * 1024); } while (0)
#define PG8_MMA(ai, bj, At, Bt) do { __builtin_amdgcn_s_setprio(1); _Pragma("unroll") for (int m = 0; m < 4; ++m) _Pragma("unroll") for (int n = 0; n < 2; ++n) _Pragma("unroll") for (int k = 0; k < 2; ++k) \
        acc[ai][bj][m][n] = __builtin_amdgcn_mfma_f32_16x16x32_bf16(Bt[n][k], At[m][k], acc[ai][bj][m][n], 0, 0, 0); __builtin_amdgcn_s_setprio(0); } while (0)
#define PG8_WAIT_V(n) asm volatile("s_waitcnt vmcnt(" #n ")" ::: "memory")
#define PG8_WAIT_L(n) asm volatile("s_waitcnt lgkmcnt(" #n ")" ::: "memory")
#define PG8_BAR __builtin_amdgcn_s_barrier()
#define PG8_SCHED __builtin_amdgcn_sched_barrier(0)
    Unit cur, nxt; int ui = 0;
    if (!S.next(0, cur)) return;
    f32x4 acc[2][2][4][2];
#pragma unroll
    for (int a = 0; a < 2; ++a)
#pragma unroll
        for (int b = 0; b < 2; ++b)
#pragma unroll
            for (int m = 0; m < 4; ++m)
#pragma unroll
                for (int n = 0; n < 2; ++n) acc[a][b][m][n] = (f32x4){0.f, 0.f, 0.f, 0.f};
    bf16x8 At[4][2], B0[2][2], B1[2][2];
    const char* cA = (const char*)g.A + (size_t)cur.pm * tstep; const char* cB = (const char*)g.Bt + (size_t)cur.pn * tstep;
    S.a_ready(cur, 0);
    if constexpr (SP2) {
        PG8_STAGE(PG8_SB(0, 0), cB, voffB); PG8_STAGE(PG8_SB(0, 1), cB + hstep, voffB); PG8_STAGE(PG8_SA(0, 0), cA, voffA); PG8_STAGE(PG8_SA(0, 1), cA + hstep, voffA);
        if (wr == 1) PG8_BAR;
        PG8_WAIT_V(2); PG8_BAR;
        PG8_STAGE(PG8_SB(1, 0), cB + kstep, voffB); PG8_STAGE(PG8_SA(1, 0), cA + kstep, voffA); PG8_STAGE(PG8_SB(1, 1), cB + hstep + kstep, voffB);
        PG8_WAIT_V(6); PG8_BAR;
    } else {
        PG8_STAGE(PG8_SB(0, 0), cB, voffB); PG8_STAGE(PG8_SA(0, 0), cA, voffA); PG8_STAGE(PG8_SB(0, 1), cB + hstep, voffB); PG8_STAGE(PG8_SA(0, 1), cA + hstep, voffA);
        if (wr == 1) PG8_BAR;
        PG8_WAIT_V(4); PG8_BAR;
        PG8_STAGE(PG8_SB(1, 0), cB + kstep, voffB); PG8_STAGE(PG8_SA(1, 0), cA + kstep, voffA); PG8_STAGE(PG8_SB(1, 1), cB + hstep + kstep, voffB);
        PG8_WAIT_V(6); PG8_BAR;
    }
    for (;;) {
        const bool has_next = S.next(ui + 1, nxt);
        const char* nA = has_next ? (const char*)g.A + (size_t)nxt.pm * tstep : cA; const char* nB = has_next ? (const char*)g.Bt + (size_t)nxt.pn * tstep : cB;
        for (int t = 0; t < nt; t += 2) {
            const bool last = (t == nt - 2);
            const char* a1 = cA + (size_t)(t + 1) * kstep;
            const char* a2 = last ? nA : cA + (size_t)(t + 2) * kstep; const char* b2 = last ? nB : cB + (size_t)(t + 2) * kstep;
            const char* a3 = a2 + kstep; const char* b3 = b2 + kstep;
            if (last && has_next) S.a_ready(nxt, ui + 1);
            if constexpr (SP2) {
            PG8_LDB(B0, 0, 0); PG8_LDB(B1, 0, 1); PG8_SCHED; PG8_LDA(At, 0, 0); PG8_STAGE(PG8_SA(1, 1), a1 + hstep, voffA);
            PG8_WAIT_V(8); PG8_WAIT_L(0); PG8_BAR; PG8_MMA(0, 0, At, B0); PG8_MMA(0, 1, At, B1); PG8_BAR; PG8_SCHED;
            PG8_LDA(At, 0, 1); PG8_STAGE(PG8_SB(0, 0), b2, voffB); PG8_STAGE(PG8_SB(0, 1), b2 + hstep, voffB); PG8_STAGE(PG8_SA(0, 0), a2, voffA);
            PG8_WAIT_V(8); PG8_WAIT_L(0); PG8_BAR; PG8_MMA(1, 0, At, B0); PG8_MMA(1, 1, At, B1); PG8_BAR; PG8_SCHED;
            PG8_LDB(B0, 1, 0); PG8_LDB(B1, 1, 1); PG8_SCHED; PG8_LDA(At, 1, 0); PG8_STAGE(PG8_SA(0, 1), a2 + hstep, voffA);
            PG8_WAIT_V(8); PG8_WAIT_L(0); PG8_BAR; PG8_MMA(0, 0, At, B0); PG8_MMA(0, 1, At, B1); PG8_BAR; PG8_SCHED;
            PG8_LDA(At, 1, 1); PG8_STAGE(PG8_SB(1, 0), b3, voffB); PG8_STAGE(PG8_SB(1, 1), b3 + hstep, voffB); PG8_STAGE(PG8_SA(1, 0), a3, voffA);
            PG8_WAIT_V(8); PG8_WAIT_L(0); PG8_BAR; PG8_MMA(1, 0, At, B0); PG8_MMA(1, 1, At, B1); PG8_BAR; PG8_SCHED;
            } else {
            PG8_LDB(B0, 0, 0); PG8_SCHED; PG8_LDA(At, 0, 0); PG8_STAGE(PG8_SA(1, 1), a1 + hstep, voffA);
            PG8_WAIT_L(8); PG8_BAR; PG8_WAIT_L(0); PG8_MMA(0, 0, At, B0); PG8_BAR; PG8_SCHED;
            PG8_LDB(B1, 0, 1); PG8_STAGE(PG8_SB(0, 0), b2, voffB);
            PG8_BAR; PG8_WAIT_L(0); PG8_MMA(0, 1, At, B1); PG8_BAR;
            PG8_LDA(At, 0, 1); PG8_STAGE(PG8_SA(0, 0), a2, voffA);
            PG8_BAR; PG8_WAIT_L(0); PG8_MMA(1, 0, At, B0); PG8_BAR; PG8_SCHED;
            PG8_STAGE(PG8_SB(0, 1), b2 + hstep, voffB);
            PG8_WAIT_V(6); PG8_BAR; PG8_MMA(1, 1, At, B1); PG8_BAR;
            PG8_LDB(B0, 1, 0); PG8_SCHED; PG8_LDA(At, 1, 0); PG8_STAGE(PG8_SA(0, 1), a2 + hstep, voffA);
            PG8_WAIT_L(8); PG8_BAR; PG8_WAIT_L(0); PG8_MMA(0, 0, At, B0); PG8_BAR; PG8_SCHED;
            PG8_LDB(B1, 1, 1); PG8_STAGE(PG8_SB(1, 0), b3, voffB);
            PG8_BAR; PG8_WAIT_L(0); PG8_MMA(0, 1, At, B1); PG8_BAR;
            PG8_LDA(At, 1, 1); PG8_STAGE(PG8_SA(1, 0), a3, voffA);
            PG8_BAR; PG8_WAIT_L(0); PG8_MMA(1, 0, At, B0); PG8_BAR; PG8_SCHED;
            PG8_STAGE(PG8_SB(1, 1), b3 + hstep, voffB);
            PG8_WAIT_V(6); PG8_BAR; PG8_MMA(1, 1, At, B1); PG8_BAR;
            }
        }
        if constexpr (ALIGN_EPI) { if (wr == 0) PG8_BAR; }
        if constexpr (!Epi::AFTER_DRAIN) { E(acc, cur, wr, wc, fr, fq, ui); S.done(cur); }
        if (!has_next) break;
#pragma unroll
        for (int a = 0; a < 2; ++a)
#pragma unroll
            for (int b = 0; b < 2; ++b)
#pragma unroll
                for (int m = 0; m < 4; ++m)
#pragma unroll
                    for (int n = 0; n < 2; ++n) acc[a][b][m][n] = (f32x4){0.f, 0.f, 0.f, 0.f};
        cur = nxt; cA = nA; cB = nB; ++ui;
        if constexpr (ALIGN_EPI) { if (wr == 1) PG8_BAR; }
    }
    PG8_WAIT_V(0);
    if constexpr (!ALIGN_EPI) { if (wr == 0) PG8_BAR; }
    PG8_BAR;
    if constexpr (Epi::AFTER_DRAIN) { E.fused(acc, cur, wr, wc, fr, fq, lds, wid, lane); S.done(cur); }
#undef PG8_SA
#undef PG8_SB
#undef PG8_STAGE
#undef PG8_LDA
#undef PG8_LDB
#undef PG8_MMA
#undef PG8_WAIT_V
#undef PG8_WAIT_L
#undef PG8_BAR
#undef PG8_SCHED
}
}

__device__ __forceinline__ int opaque_tid(int wave) { int ln = __builtin_amdgcn_mbcnt_hi(~0u, __builtin_amdgcn_mbcnt_lo(~0u, 0u)); asm volatile("" : "+v"(ln)); return wave * 64 + ln; }
#define PHASE_TID(F) do { const int _t = opaque_tid((F).wave); (F).tid = _t; (F).lane = _t & 63; } while (0)
__device__ __forceinline__ void transpose_item(const float* W, int K, int N, bf16_t* WT, int dst_row0, int src_col0, const float* gk, LAS float* scr, int k0, int lane) {
    f32x4 v[16]; const int r0 = lane >> 4, c4 = (lane & 15) * 4;
    const float* wp = W + (size_t)(k0 + r0) * N + src_col0 + c4;
#pragma unroll
    for (int i = 0; i < 16; ++i) v[i] = *(const f32x4*)(wp + (size_t)(4 * i) * N);
    if (gk) {
#pragma unroll
        for (int i = 0; i < 16; ++i) v[i] = v[i] * gk[k0 + r0 + 4 * i]; }
#pragma unroll
    for (int i = 0; i < 16; ++i) { LAS float* d = scr + (r0 + 4 * i) * 65 + c4; d[0] = v[i][0]; d[1] = v[i][1]; d[2] = v[i][2]; d[3] = v[i][3]; }
    asm volatile("s_waitcnt lgkmcnt(0)" ::: "memory");
    const int c = lane & 7;
#pragma unroll
    for (int j = 0; j < 8; ++j) { const int n = (lane >> 3) + 8 * j; const LAS float* sp = scr + (8 * c) * 65 + n;
        u32x4 o; o.x = pk2(sp[0 * 65], sp[1 * 65]); o.y = pk2(sp[2 * 65], sp[3 * 65]); o.z = pk2(sp[4 * 65], sp[5 * 65]); o.w = pk2(sp[6 * 65], sp[7 * 65]);
        *(u32x4*)(WT + (size_t)(dst_row0 + n) * K + k0 + 8 * c) = o; }
    asm volatile("s_waitcnt lgkmcnt(0)" ::: "memory");
}
__device__ __forceinline__ void convert_layer(Frame& F, int l, int gw, int NGW) {
    LAS float* scr = (LAS float*)(F.lds + F.wave * 17408);
    constexpr int I_IN = (D / 64) * (DIN / 64), I_OUT = (D / 64) * (D / 64), I_G = NHEAD * 2 * (HD / 64) * (HD / 64), I_L = I_IN + I_OUT + I_G;
    for (int it = gw; it < I_L; it += NGW) {
        int r = it;
        if (r >= I_IN + I_OUT) { r -= I_IN + I_OUT; const int hg = r >> 2, kb = (r >> 1) & 1, nb = r & 1, h = hg >> 1, gsel = hg & 1;
            transpose_item((gsel ? F.wx : F.wa) + (size_t)(l * NHEAD + h) * HD * HD, HD, HD, F.WgT + (size_t)((l * NHEAD + h) * 2 + gsel) * HD * HD, 64 * nb, 64 * nb, nullptr, scr, 64 * kb, F.lane);
        } else if (r < I_IN) { const int kb = r / (DIN / 64), nb = r % (DIN / 64);
            transpose_item(F.w_in + (size_t)l * D * DIN, D, DIN, F.WinT + (size_t)l * DIN * D, 64 * nb, src_col(64 * nb), F.norm_g + l * D, scr, 64 * kb, F.lane);
        } else { r -= I_IN; const int kb = r / (D / 64), nb = r % (D / 64);
            transpose_item(F.w_out + (size_t)l * D * D, D, D, F.WoutT + (size_t)l * D * D, 64 * nb, 64 * nb, nullptr, scr, 64 * kb, F.lane); }
    }
}
__device__ __forceinline__ void p_prologue(Frame& F) {
    PHASE_TID(F);
    const int gw = F.bid * NWAVES + F.wave, NGW = F.G * NWAVES;
    convert_layer(F, 0, gw, NGW);
    if (!(F.G == 256)) { for (int l = 1; l < DEPTH; ++l) convert_layer(F, l, gw, NGW); }
    for (int m = gw; m < S; m += NGW) {
        const f32x4* xr = (const f32x4*)(F.x + (size_t)m * D) + F.lane; u32x2* ob = (u32x2*)(F.XB + (size_t)m * D) + F.lane; float s = 0.f;
#pragma unroll
        for (int j = 0; j < 8; ++j) { const f32x4 v = xr[64 * j]; s += (v.x * v.x + v.y * v.y) + (v.z * v.z + v.w * v.w); u32x2 w; w.x = pk2(v.x, v.y); w.y = pk2(v.z, v.w); ob[64 * j] = w; }
        s = wave_sum(s);
        if (F.lane < 32) F.SSQ[F.lane * S + m] = F.lane == 0 ? s : 0.f;
    }
}

#define DPP_MOV(x, ctrl) __builtin_bit_cast(float, __builtin_amdgcn_update_dpp(0, __builtin_bit_cast(int, (float)(x)), (ctrl), 0xf, 0xf, true))
template <int NV> __device__ __forceinline__ void block_sum(float (&v)[NV], LAS float* red  , int wave, int lane) {
#pragma unroll
    for (int i = 0; i < NV; ++i) v[i] += DPP_MOV(v[i], 0x128);
#pragma unroll
    for (int i = 0; i < NV; ++i) v[i] += DPP_MOV(v[i], 0x124);
#pragma unroll
    for (int i = 0; i < NV; ++i) v[i] += DPP_MOV(v[i], 0x4E);
#pragma unroll
    for (int i = 0; i < NV; ++i) v[i] += DPP_MOV(v[i], 0xB1);
    __builtin_amdgcn_sched_barrier(0);
    float t[NV];
#pragma unroll
    for (int i = 0; i < NV; ++i) t[i] = __shfl_xor(v[i], 16);
#pragma unroll
    for (int i = 0; i < NV; ++i) v[i] += t[i];
    __builtin_amdgcn_sched_barrier(0);
#pragma unroll
    for (int i = 0; i < NV; ++i) t[i] = __shfl_xor(v[i], 32);
#pragma unroll
    for (int i = 0; i < NV; ++i) v[i] += t[i];
    __builtin_amdgcn_sched_barrier(0);
    if (lane == 0) {
#pragma unroll
        for (int i = 0; i < NV; ++i) red[i * 8 + wave] = v[i]; }
    __syncthreads();
#pragma unroll
    for (int i = 0; i < NV; ++i) { const LAS f32x4* p = (const LAS f32x4*)(red + i * 8); const f32x4 a = p[0], b = p[1]; v[i] = ((a.x + a.y) + (a.z + a.w)) + ((b.x + b.y) + (b.z + b.w)); }
    __syncthreads();
}
constexpr int CT = 16;
__device__ __forceinline__ void conv_item(Frame& F, int l, int item) {
    LAS unsigned char* cs = F.lds;
    LAS float* red = (LAS float*)(F.lds + 62 * 2048);
    const int t0 = item * 32, c0 = 2 * F.tid;
    const auto rus = MAKE_RSRC(F.U, (size_t)S * UW * 2); const int c16 = F.tid & 127, rb = F.tid >> 7; u32x4 v[16];
#pragma unroll
    for (int i = 0; i < 16; ++i) { const int row = rb + 4 * i, sidx = t0 - 30 + row; v[i] = (u32x4){0u, 0u, 0u, 0u};
        if (row < 62 && sidx >= 0) v[i] = __builtin_bit_cast(u32x4, __builtin_amdgcn_raw_buffer_load_b128(rus, c16 * 16, sidx * (UW * 2), 0)); }
    f32x2 wv[31];
    const auto rw = MAKE_RSRC(F.cdw_w + (size_t)l * CW * DC, CW * DC * 4);
#pragma unroll
    for (int j = 0; j < 31; ++j) wv[j] = __builtin_bit_cast(f32x2, __builtin_amdgcn_raw_buffer_load_b64(rw, c0 * 4, (30 - j) * DC * 4, 0));
    const f32x2 bias = *(const f32x2*)(F.cdw_b + l * DC + c0);
    const f32x2 lg = *(const f32x2*)(F.cln_g + l * DC + c0), lb = *(const f32x2*)(F.cln_b + l * DC + c0);
    const auto ru = MAKE_RSRC(F.U, (size_t)S * UW * 2); const auto ry = MAKE_RSRC(F.Y, (size_t)S * D * 2);
    unsigned zwq[32];
#pragma unroll
    for (int i = 0; i < 32; ++i) zwq[i] = __builtin_amdgcn_raw_buffer_load_b32(ru, (1024 + c0) * 2, (t0 + i) * (UW * 2), 0);
#pragma unroll
    for (int i = 0; i < 16; ++i) { const int row = rb + 4 * i; if (row < 62) *(LAS u32x4*)(cs + row * 2048 + c16 * 16) = v[i]; }
    __syncthreads();
#pragma unroll 1
    for (int hb_ = 0; hb_ < ((PROBE_DUP & 64) ? 2 : 1) * (32 / CT); ++hb_) { const int hb = hb_ % (32 / CT);
        f32x2 acc[CT];
#pragma unroll
        for (int i = 0; i < CT; ++i) acc[i] = bias;
        const LAS unsigned char* cp = cs + (hb * CT) * 2048 + F.tid * 4;
        unsigned cwq[CT + 30];
#pragma unroll
        for (int si = 0; si < CT + 30; ++si) cwq[si] = *(const LAS unsigned*)(cp + si * 2048);
        static_assert(CT + 30 == 46, "operand lists below");
        asm volatile("" : "+v"(cwq[0]), "+v"(cwq[1]), "+v"(cwq[2]), "+v"(cwq[3]), "+v"(cwq[4]), "+v"(cwq[5]), "+v"(cwq[6]), "+v"(cwq[7]), "+v"(cwq[8]), "+v"(cwq[9]), "+v"(cwq[10]), "+v"(cwq[11]), "+v"(cwq[12]), "+v"(cwq[13]), "+v"(cwq[14]), "+v"(cwq[15]));
        asm volatile("" : "+v"(cwq[16]), "+v"(cwq[17]), "+v"(cwq[18]), "+v"(cwq[19]), "+v"(cwq[20]), "+v"(cwq[21]), "+v"(cwq[22]), "+v"(cwq[23]), "+v"(cwq[24]), "+v"(cwq[25]), "+v"(cwq[26]), "+v"(cwq[27]), "+v"(cwq[28]), "+v"(cwq[29]), "+v"(cwq[30]), "+v"(cwq[31]));
        asm volatile("" : "+v"(cwq[32]), "+v"(cwq[33]), "+v"(cwq[34]), "+v"(cwq[35]), "+v"(cwq[36]), "+v"(cwq[37]), "+v"(cwq[38]), "+v"(cwq[39]), "+v"(cwq[40]), "+v"(cwq[41]), "+v"(cwq[42]), "+v"(cwq[43]), "+v"(cwq[44]), "+v"(cwq[45]));
#pragma unroll
        for (int si = 0; si < CT + 30; ++si) {
            const unsigned cw = cwq[si];
            const f32x2 xv = (f32x2){bflo(cw), bfhi(cw)};
#pragma unroll
            for (int i = 0; i < CT; ++i) { const int j = i + 30 - si; if (j >= 0 && j <= 30) acc[i] = wv[j] * xv + acc[i]; }
            static_assert(CT == 16, "operand list below");
            asm volatile("" : "+v"(acc[0]), "+v"(acc[1]), "+v"(acc[2]), "+v"(acc[3]), "+v"(acc[4]), "+v"(acc[5]), "+v"(acc[6]), "+v"(acc[7]),
                              "+v"(acc[8]), "+v"(acc[9]), "+v"(acc[10]), "+v"(acc[11]), "+v"(acc[12]), "+v"(acc[13]), "+v"(acc[14]), "+v"(acc[15]));
        }
        float a0[CT], a1[CT];
#pragma unroll
        for (int i = 0; i < CT; ++i) { a0[i] = acc[i].x; a1[i] = acc[i].y; }
        float sv[CT];
#pragma unroll
        for (int i = 0; i < CT; ++i) sv[i] = a0[i] + a1[i];
        block_sum<CT>(sv, red, F.wave, F.lane);
#pragma unroll
        for (int i = 0; i < CT; ++i) { const float mean = sv[i] * (1.f / DC); a0[i] -= mean; a1[i] -= mean; sv[i] = a0[i] * a0[i] + a1[i] * a1[i]; }
        block_sum<CT>(sv, red, F.wave, F.lane);
#pragma unroll
        for (int i = 0; i < CT; ++i) {
            const int t = t0 + hb * CT + i;
            const float rstd = __builtin_amdgcn_rsqf(sv[i] * (1.f / DC) + LN_EPS);
            const unsigned zw = hb ? zwq[CT + i] : zwq[i];
            const float n0 = a0[i] * rstd * lg.x + lb.x, n1 = a1[i] * rstd * lg.y + lb.y;
            const float y0 = n0 * pg8::fsigm(n0) * bflo(zw), y1 = n1 * pg8::fsigm(n1) * bfhi(zw);
            __builtin_amdgcn_raw_buffer_store_b32(pk2(y0, y1), ry, c0 * 2, t * (D * 2), 0);
        }
    }
    __syncthreads();
}
#define DPP_ROW_SHR(x, oldv, d) __builtin_bit_cast(float, __builtin_amdgcn_update_dpp(__builtin_bit_cast(int, (float)(oldv)), __builtin_bit_cast(int, (float)(x)), 0x110 + (d), 0xf, 0xf, false))
#define DPP_ROW_BCAST15(x) __builtin_bit_cast(float, __builtin_amdgcn_update_dpp(0, __builtin_bit_cast(int, (float)(x)), 0x15F, 0xf, 0xf, true))
__device__ __forceinline__ unsigned* lru_flag(Frame& F, int l, int c, int h) { return F.ctl + CW_LRU + 64 * ((l * NLCH + c) * NHEAD + h); }
__device__ __forceinline__ void lru_item(Frame& F, int l, int item) {
    const int c = item >> 3, h = item & 7, t0 = c * LCH, ch0 = h * HD;
    LAS unsigned char* xhi = F.lds; LAS unsigned char* xlo = F.lds + LCH * XROW;
    const int tid = F.tid, lane = F.lane, w = F.wave, fr = lane & 15, fq = lane >> 4;
    const auto ru = MAKE_RSRC(F.U, (size_t)S * UW * 2); const auto ry = MAKE_RSRC(F.Y, (size_t)S * D * 2);
    const int chl = ch0 + 16 * w + 4 * fq;
    const f32x4 vba = *(const f32x4*)(F.ba + l * DL + chl), vbx = *(const f32x4*)(F.bx + l * DL + chl), vlam = *(const f32x4*)(F.lam + l * DL + chl);
    float c8l[4], c8x[4], nba[4], nbx[4], keep[4];
#pragma unroll
    for (int j = 0; j < 4; ++j) { const float c8 = 8.f * log_sigmoid(vlam[j]); c8l[j] = c8 * 1.44269504089f; c8x[j] = 2.f * c8; nba[j] = vba[j] * -1.44269504089f; nbx[j] = vbx[j] * -1.44269504089f; }
    keep[0] = fr < 1 ? 1.f : 0.f; keep[1] = fr < 2 ? 1.f : 0.f; keep[2] = fr < 4 ? 1.f : 0.f; keep[3] = fr < 8 ? 1.f : 0.f;
    bf16x8 br[4], bi[4];
    { const bf16_t* wg = F.WgT + (size_t)((l * NHEAD + h) * 2) * HD * HD + (size_t)(16 * w + fr) * HD + 8 * fq;
#pragma unroll
      for (int kk = 0; kk < 4; ++kk) { br[kk] = *(const bf16x8*)(wg + 32 * kk); bi[kk] = *(const bf16x8*)(wg + HD * HD + 32 * kk); } }
    {
        const int tg = tid >> 4, cg = tid & 15, tb = 8 * tg;
        const float* cw = F.lcw + (size_t)l * LW * DL + ch0 + 8 * cg;
        f32x4 wk[4][2];
#pragma unroll
        for (int k = 0; k < 4; ++k) { wk[k][0] = *(const f32x4*)(cw + (size_t)k * DL); wk[k][1] = *(const f32x4*)(cw + (size_t)k * DL + 4); }
        const f32x4 bb0 = *(const f32x4*)(F.lcb + l * DL + ch0 + 8 * cg), bb1 = *(const f32x4*)(F.lcb + l * DL + ch0 + 8 * cg + 4);
        u32x4 rows[11];
#pragma unroll
        for (int r = 0; r < 11; ++r) { const int sidx = t0 + tb - 3 + r; rows[r] = (u32x4){0u, 0u, 0u, 0u};
            if (sidx >= 0) rows[r] = __builtin_bit_cast(u32x4, __builtin_amdgcn_raw_buffer_load_b128(ru, (2048 + ch0 + 8 * cg) * 2, sidx * (UW * 2), 0)); }
#pragma unroll
        for (int i = 0; i < 8; ++i) {
            f32x4 a0 = bb0, a1 = bb1;
#pragma unroll
            for (int k = 0; k < 4; ++k) { const u32x4 q = rows[i + k];
                a0[0] += wk[k][0][0] * bflo(q.x); a0[1] += wk[k][0][1] * bfhi(q.x); a0[2] += wk[k][0][2] * bflo(q.y); a0[3] += wk[k][0][3] * bfhi(q.y);
                a1[0] += wk[k][1][0] * bflo(q.z); a1[1] += wk[k][1][1] * bfhi(q.z); a1[2] += wk[k][1][2] * bflo(q.w); a1[3] += wk[k][1][3] * bfhi(q.w); }
            u32x4 hi; hi.x = pk2(a0[0], a0[1]); hi.y = pk2(a0[2], a0[3]); hi.z = pk2(a1[0], a1[1]); hi.w = pk2(a1[2], a1[3]);
            u32x4 lo; lo.x = pk2(a0[0] - bflo(hi.x), a0[1] - bfhi(hi.x)); lo.y = pk2(a0[2] - bflo(hi.y), a0[3] - bfhi(hi.y)); lo.z = pk2(a1[0] - bflo(hi.z), a1[1] - bfhi(hi.z)); lo.w = pk2(a1[2] - bflo(hi.w), a1[3] - bfhi(hi.w));
            *(LAS u32x4*)(xhi + (tb + i) * XROW + cg * 16) = hi; *(LAS u32x4*)(xlo + (tb + i) * XROW + cg * 16) = lo; }
    }
    __syncthreads();
    float hl[16][4], pc[16][4], HC[4], PC[4];
#pragma unroll
    for (int j = 0; j < 4; ++j) { HC[j] = 0.f; PC[j] = 1.f; }
#pragma unroll
    for (int m = 0; m < 16; ++m) {
        f32x4 ar = (f32x4){0.f, 0.f, 0.f, 0.f}, ai = (f32x4){0.f, 0.f, 0.f, 0.f};
        const LAS unsigned char* rowp = xhi + (16 * m + fr) * XROW;
#pragma unroll
        for (int kk = 0; kk < 4; ++kk) { const bf16x8 a = *(const LAS bf16x8*)(rowp + (32 * kk + 8 * fq) * 2);
            ar = __builtin_amdgcn_mfma_f32_16x16x32_bf16(br[kk], a, ar, 0, 0, 0); ai = __builtin_amdgcn_mfma_f32_16x16x32_bf16(bi[kk], a, ai, 0, 0, 0); }
        const u32x2 qh = *(const LAS u32x2*)(rowp + (16 * w + 4 * fq) * 2), ql = *(const LAS u32x2*)(rowp + LCH * XROW + (16 * w + 4 * fq) * 2);
        const float xcv[4] = {bflo(qh.x) + bflo(ql.x), bfhi(qh.x) + bfhi(ql.x), bflo(qh.y) + bflo(ql.y), bfhi(qh.y) + bfhi(ql.y)};
        float Aj[4], Bj[4], xq[4];
#pragma unroll
        for (int j = 0; j < 4; ++j) {
            const float r = __builtin_amdgcn_rcpf(1.f + __builtin_amdgcn_exp2f(ar[j] * -1.44269504089f + nba[j])), ig = __builtin_amdgcn_rcpf(1.f + __builtin_amdgcn_exp2f(ai[j] * -1.44269504089f + nbx[j]));
            const float x = c8x[j] * r; xq[j] = x;
            float p = x * (1.f / 5040.f) + (1.f / 720.f); p = p * x + (1.f / 120.f); p = p * x + (1.f / 24.f); p = p * x + (1.f / 6.f); p = p * x + 0.5f; p = p * x + 1.f;
            Aj[j] = __builtin_amdgcn_exp2f(c8l[j] * r); Bj[j] = __builtin_amdgcn_sqrtf(-x * p) * (ig * xcv[j]); }
        if (__builtin_expect(__any(fminf(fminf(xq[0], xq[1]), fminf(xq[2], xq[3])) <= -0.35f), 0)) {
#pragma unroll
            for (int j = 0; j < 4; ++j) if (xq[j] <= -0.35f) { const float r = __builtin_amdgcn_rcpf(1.f + __builtin_amdgcn_exp2f(ar[j] * -1.44269504089f + nba[j])), ig = __builtin_amdgcn_rcpf(1.f + __builtin_amdgcn_exp2f(ai[j] * -1.44269504089f + nbx[j]));
                (void)r; Bj[j] = __builtin_amdgcn_sqrtf(1.f - __builtin_amdgcn_exp2f(xq[j] * 1.44269504089f)) * (ig * xcv[j]); } }
#define LRU_PIN asm volatile("" : "+v"(Aj[0]), "+v"(Aj[1]), "+v"(Aj[2]), "+v"(Aj[3]), "+v"(Bj[0]), "+v"(Bj[1]), "+v"(Bj[2]), "+v"(Bj[3]))
#define DPP_SHR0(x, d) __builtin_bit_cast(float, __builtin_amdgcn_update_dpp(0, __builtin_bit_cast(int, (float)(x)), 0x110 + (d), 0xf, 0xf, true))
#define LRU_SCAN_STEP(d, kd) { \
            _Pragma("unroll") for (int j = 0; j < 4; ++j) { Bj[j] = DPP_SHR0(Bj[j], d) * Aj[j] + Bj[j]; } \
            _Pragma("unroll") for (int j = 0; j < 4; ++j) { const float t = DPP_SHR0(Aj[j], d) + keep[kd]; Aj[j] = Aj[j] * t; } LRU_PIN; }
        LRU_PIN; LRU_SCAN_STEP(1, 0) LRU_SCAN_STEP(2, 1) LRU_SCAN_STEP(4, 2) LRU_SCAN_STEP(8, 3)
#undef LRU_SCAN_STEP
#undef LRU_PIN
#pragma unroll
        for (int j = 0; j < 4; ++j) { hl[m][j] = Bj[j] + Aj[j] * HC[j]; pc[m][j] = Aj[j] * PC[j]; }
#pragma unroll
        for (int j = 0; j < 4; ++j) { HC[j] = DPP_ROW_BCAST15(hl[m][j]); PC[j] = DPP_ROW_BCAST15(pc[m][j]); }
    }
    const int vo_u = (fr * UW + 3072 + chl) * 2, vo_y = (fr * D + DC + chl) * 2;
    u32x2 zq[16];
#pragma unroll
    for (int m = 0; m < 16; ++m) zq[m] = __builtin_bit_cast(u32x2, __builtin_amdgcn_raw_buffer_load_b64(ru, vo_u, (t0 + 16 * m) * (UW * 2), 0));
    if (fr == 15) { unsigned long long* sp = F.SUM + (size_t)(l * NLCH + c) * DL + chl;
#pragma unroll
        for (int j = 0; j < 4; ++j) __hip_atomic_store(sp + j, ((unsigned long long)__builtin_bit_cast(unsigned, HC[j]) << 32) | __builtin_bit_cast(unsigned, PC[j]), __ATOMIC_RELAXED, __HIP_MEMORY_SCOPE_AGENT); }
    asm volatile("s_waitcnt vmcnt(0)" ::: "memory");
    __syncthreads();
    if (tid == 0) __hip_atomic_store(lru_flag(F, l, c, h), 1u, __ATOMIC_RELAXED, __HIP_MEMORY_SCOPE_AGENT);
    float Hin[4] = {0.f, 0.f, 0.f, 0.f};
    if (c > 0) {
        if (w == 0) {
            unsigned* fp = lru_flag(F, l, lane < c ? lane : 0, h); unsigned spins = 0;
            for (;;) { const unsigned v = __hip_atomic_load(fp, __ATOMIC_RELAXED, __HIP_MEMORY_SCOPE_AGENT); if (__all(v != 0u)) break; __builtin_amdgcn_s_sleep(2); if (++spins > (1u << 20)) break; }
            __builtin_amdgcn_fence(__ATOMIC_ACQUIRE, "agent");
            asm volatile("s_waitcnt vmcnt(0)" ::: "memory");
        }
        __syncthreads();
        const unsigned long long* sp = F.SUM + (size_t)(l * NLCH) * DL + chl;
        u32x4 q[2][2];
#pragma unroll
        for (int g = 0; g < 2; ++g) { const int cc = fr + 16 * g; q[g][0] = (u32x4){0x3f800000u, 0u, 0x3f800000u, 0u}; q[g][1] = q[g][0];
            if (cc < c) { q[g][0] = *(const u32x4*)(sp + (size_t)cc * DL); q[g][1] = *(const u32x4*)(sp + (size_t)cc * DL + 2); } }
#pragma unroll
        for (int j = 0; j < 4; ++j) { float Hq[2];
#pragma unroll
            for (int g = 0; g < 2; ++g) { const u32x4 qq = q[g][j >> 1]; float A = (j & 1) ? u2f(qq.z) : u2f(qq.x), B = (j & 1) ? u2f(qq.w) : u2f(qq.y);
#define LRU_SCAN_STEP(d) { const float ap = DPP_ROW_SHR(A, 1.0f, d), bp = DPP_ROW_SHR(B, 0.0f, d); B = A * bp + B; A = ap * A; }
                LRU_SCAN_STEP(1) LRU_SCAN_STEP(2) LRU_SCAN_STEP(4) LRU_SCAN_STEP(8)
#undef LRU_SCAN_STEP
                const float At = DPP_ROW_BCAST15(A), Bt = DPP_ROW_BCAST15(B);
                Hq[g] = g == 0 ? Bt : At * Hq[0] + Bt; }
            Hin[j] = Hq[1]; }
    }
#pragma unroll
    for (int m = 0; m < 16; ++m) { const int trow = t0 + 16 * m; const unsigned zx = zq[m].x, zy = zq[m].y;
        const float y0 = (hl[m][0] + pc[m][0] * Hin[0]) * bflo(zx), y1 = (hl[m][1] + pc[m][1] * Hin[1]) * bfhi(zx), y2 = (hl[m][2] + pc[m][2] * Hin[2]) * bflo(zy), y3 = (hl[m][3] + pc[m][3] * Hin[3]) * bfhi(zy);
        u32x2 o; o.x = pk2(y0, y1); o.y = pk2(y2, y3);
        __builtin_amdgcn_raw_buffer_store_b64(o, ry, vo_y, trow * (D * 2), 0); }
    __syncthreads();
}
__device__ __forceinline__ void p_mix(Frame& F, int l) {
    PHASE_TID(F);
    constexpr int NCONV = S / 32, NLRU = NLCH * NHEAD;
    for (int rep = 0; rep < ((PROBE_DUP & 8) ? 2 : 1); ++rep)
    for (int it = F.bid; it < NLRU; it += F.G) { PHASE_TID(F); lru_item(F, l, it); }
    for (int rep = 0; rep < ((PROBE_DUP & 16) ? 2 : 1); ++rep)
    for (int it = F.bid; it < NCONV; it += F.G) { PHASE_TID(F); conv_item(F, l, it); }
}
__device__ __forceinline__ void p_final(Frame& F) {
    PHASE_TID(F);
    const int gw = F.bid * NWAVES + F.wave, NGW = F.G * NWAVES;
    for (int m = gw; m < S; m += NGW) {
        float ss = 0.f;
#pragma unroll
        for (int p = 0; p < 32; ++p) ss += F.SSQ[p * S + m];
        const float rstd = 1.f / sqrtf(ss * (1.f / D) + RMS_EPS);
        f32x4* orow = (f32x4*)(F.out + (size_t)m * D) + F.lane; const f32x4* gr = (const f32x4*)F.final_g + F.lane;
#pragma unroll
        for (int j = 0; j < 8; ++j) orow[64 * j] = orow[64 * j] * rstd * gr[64 * j];
    }
}

constexpr int PH_PER_LAYER = 3, NPH = 1 + DEPTH * PH_PER_LAYER + 1;
struct Args { const float* in[16]; float* out; unsigned char* ws; int ph_lo, ph_hi; };
__global__ void __launch_bounds__(NTHREADS, 2) mk_fwd(Args a) {
    extern __shared__ __attribute__((aligned(16))) unsigned char lds_raw[];
    Frame F;
    F.lds = (LAS unsigned char*)lds_raw;
    F.wave = __builtin_amdgcn_readfirstlane(threadIdx.x >> 6); F.tid = threadIdx.x; F.lane = F.tid & 63; F.bid = blockIdx.x; F.G = gridDim.x;
    F.x = a.in[0]; F.norm_g = a.in[1]; F.w_in = a.in[2]; F.cdw_w = a.in[3]; F.cdw_b = a.in[4]; F.cln_g = a.in[5]; F.cln_b = a.in[6]; F.lcw = a.in[7]; F.lcb = a.in[8];
    F.wa = a.in[9]; F.ba = a.in[10]; F.wx = a.in[11]; F.bx = a.in[12]; F.lam = a.in[13]; F.w_out = a.in[14]; F.final_g = a.in[15]; F.out = a.out;
    unsigned char* ws = a.ws;
    F.WinT = (bf16_t*)(ws + WS_WINT); F.WoutT = (bf16_t*)(ws + WS_WOUTT); F.XB = (bf16_t*)(ws + WS_XB); F.U = (bf16_t*)(ws + WS_U); F.Y = (bf16_t*)(ws + WS_Y);
    F.SSQ = (float*)(ws + WS_SSQ); F.SUM = (unsigned long long*)(ws + WS_SUM); F.WgT = (bf16_t*)(ws + WS_WG); F.ctl = (unsigned*)(ws + WS_CTL);
    volatile LAS unsigned* bst = (volatile LAS unsigned*)(F.lds + LDS_BYTES - 64);
    if (F.tid < 16) bst[F.tid] = 0u;
    __syncthreads();
    XcdBarrier bar; bar.bar = (unsigned*)(ws + WS_CTL) + CW_BAR; bar.x = 0; bar.st = bst;
    if (MK_ONE_LAUNCH) bar = xcd_barrier_post((unsigned*)(ws + WS_CTL) + CW_BAR, bst);
    bar.wave = F.wave;
    for (int ph = a.ph_lo; ph < a.ph_hi; ++ph) {
      const int jj = (ph == 0 || ph == NPH - 1) ? -1 : (ph - 1) % PH_PER_LAYER;
      const int reps = ((PROBE_DUP & 1) && ph == 0) || ((PROBE_DUP & 2) && jj == 0) || ((PROBE_DUP & 4) && jj == 1) ? 2 : 1;
      for (int rep = 0; rep < reps; ++rep) {
        if (rep) xcd_barrier(bar);
        if (ph == 0) p_prologue(F);
        else if (ph == NPH - 1) p_final(F);
        else { const int l = (ph - 1) / PH_PER_LAYER, j = (ph - 1) % PH_PER_LAYER;
            if (j == 0) { pg8::Gemm g{F.XB, F.WinT + (size_t)l * DIN * D, S, DIN, D}; pg8::OrderRstd Sd; Sd.init(S, DIN, F.G, F.bid); Sd.ssq = F.SSQ; Sd.rtab = (LAS float*)(F.lds + pg8::RTAB_OFF); Sd.wave = F.wave;
                pg8::EpiIn E{F.U, (const LAS float*)(F.lds + pg8::RTAB_OFF)};
                pg8::gemm_phase<pg8::EpiIn, pg8::OrderRstd, true, true>(F.lds, g, Sd, E, F.wave);
                if (F.G == 256 && l + 1 < DEPTH && F.bid >= 128) { PHASE_TID(F); convert_layer(F, l + 1, (F.bid - 128) * NWAVES + F.wave, 128 * NWAVES); } }
            else if (j == 1) p_mix(F, l);
            else { pg8::Gemm g{F.Y, F.WoutT + (size_t)l * D * D, S, D, D}; pg8::StaticOrder Sd; Sd.init(S, D, F.G, F.bid);
                pg8::EpiOut E{l == DEPTH - 1 ? F.out : nullptr, F.XB, F.SSQ};
                pg8::gemm_phase<pg8::EpiOut, pg8::StaticOrder, true, true>(F.lds, g, Sd, E, F.wave); }
        }
      }
        if (ph + 1 < a.ph_hi) xcd_barrier(bar);
    }
}

extern "C" void kernel_launch(void* const* d_in, const int* in_sizes, int n_in, void* d_out, int out_size, void* d_ws, size_t ws_size, hipStream_t stream) {
    static int grid = 0;
    if (grid == 0) {
        if (n_in != 16 || in_sizes[0] != S * D || out_size != S * D || ws_size < WS_END) { fprintf(stderr, "kernel_launch: unexpected shapes (n_in %d, in0 %d, out %d, ws %zu)\n", n_in, n_in > 0 ? in_sizes[0] : -1, out_size, ws_size); grid = -1; return; }
        int dev = 0, cus = 0, per_cu = 0;
        if (hipGetDevice(&dev) != hipSuccess || hipDeviceGetAttribute(&cus, hipDeviceAttributeMultiprocessorCount, dev) != hipSuccess) { grid = -1; return; }
        if (hipFuncSetAttribute((const void*)mk_fwd, hipFuncAttributeMaxDynamicSharedMemorySize, LDS_BYTES) != hipSuccess) { fprintf(stderr, "kernel_launch: hipFuncSetAttribute failed\n"); grid = -1; return; }
        if (hipOccupancyMaxActiveBlocksPerMultiprocessor(&per_cu, (const void*)mk_fwd, NTHREADS, LDS_BYTES) != hipSuccess || per_cu < 1) fprintf(stderr, "kernel_launch: occupancy query says %d per CU\n", per_cu);
        (void)hipGetLastError();
        grid = cus;
    }
    if (grid < 0) return;
    (void)hipMemsetAsync((char*)d_ws + WS_CTL, 0, CTL_ZERO_BYTES, stream);
    Args a{};
    for (int i = 0; i < 16; ++i) a.in[i] = (const float*)d_in[i];
    a.out = (float*)d_out; a.ws = (unsigned char*)d_ws;
#if MK_ONE_LAUNCH
    a.ph_lo = 0; a.ph_hi = NPH;
    hipLaunchKernelGGL(mk_fwd, dim3(grid), dim3(NTHREADS), LDS_BYTES, stream, a);
#else
    for (int ph = 0; ph < NPH; ++ph) { a.ph_lo = ph; a.ph_hi = ph + 1; hipLaunchKernelGGL(mk_fwd, dim3(grid), dim3(NTHREADS), LDS_BYTES, stream, a); }
#endif
}
```

```cpp
#include <hip/hip_runtime.h>
#include <cstdio>
#include <cstdint>

#ifndef MK_ONE_LAUNCH
#define MK_ONE_LAUNCH 1
#endif

#ifndef PROBE_DUP
#define PROBE_DUP 0
#endif
#define LAS __attribute__((address_space(3)))
#define GAS __attribute__((address_space(1)))
typedef unsigned short bf16_t;
typedef short bf16x8 __attribute__((ext_vector_type(8)));
typedef float f32x4 __attribute__((ext_vector_type(4)));
typedef float f32x2 __attribute__((ext_vector_type(2)));
typedef unsigned u32x4 __attribute__((ext_vector_type(4)));
typedef unsigned u32x2 __attribute__((ext_vector_type(2)));

constexpr int S = 8192, D = 2048, DEPTH = 4, DC = 1024, DL = 1024, DIN = 5120, NHEAD = 8, HD = 128, CW = 31, LW = 4;
constexpr int UW = 4096;
constexpr float RMS_EPS = 1e-6f, LN_EPS = 1e-5f;
constexpr int NTHREADS = 512, NWAVES = 8;
constexpr int LDS_BYTES = 147456;
constexpr int LCH = 256, NLCH = S / LCH;
constexpr int XROW = 272;
constexpr int CW_BAR = 4096, CW_LRU = 16384;

constexpr size_t MiB = 1u << 20;
constexpr size_t WS_CTL = 0, CTL_ZERO_BYTES = 1 * MiB;
constexpr size_t WS_WINT = 2 * MiB;
constexpr size_t WS_WOUTT = 82 * MiB;
constexpr size_t WS_XB = 114 * MiB;
constexpr size_t WS_U = 146 * MiB;
constexpr size_t WS_Y = 210 * MiB;
constexpr size_t WS_SSQ = 242 * MiB;
constexpr size_t WS_SUM = 243 * MiB;
constexpr size_t WS_WG = 244 * MiB;
constexpr size_t WS_END = 246 * MiB;

__device__ __forceinline__ int opaque_tid(int wave);
#define MAKE_RSRC(p, bytes) __builtin_amdgcn_make_buffer_rsrc((void*)(p), 0, (int)(bytes), 0x00020000)
__device__ __forceinline__ unsigned f2bf(float f) { unsigned u = __builtin_bit_cast(unsigned, f); return (u + 0x7fffu + ((u >> 16) & 1u)) >> 16; }
__device__ __forceinline__ unsigned pk2(float lo, float hi) { return f2bf(lo) | (f2bf(hi) << 16); }
__device__ __forceinline__ float bflo(unsigned w) { return __builtin_bit_cast(float, w << 16); }
__device__ __forceinline__ float bfhi(unsigned w) { return __builtin_bit_cast(float, w & 0xffff0000u); }
__device__ __forceinline__ float u2f(unsigned u) { return __builtin_bit_cast(float, u); }
__device__ __forceinline__ float bf2f(bf16_t b) { return __builtin_bit_cast(float, (unsigned)b << 16); }
__device__ __forceinline__ float sigm(float x) { return 1.f / (1.f + __expf(-x)); }
__device__ __forceinline__ float siluf(float x) { return x * sigm(x); }
__device__ __forceinline__ float wave_sum(float v) {
#pragma unroll
    for (int o = 1; o < 64; o <<= 1) v += __shfl_xor(v, o);
    return v;
}
__device__ __forceinline__ float neg_expm1(float x) {
    float p = 1.f + x * (1.f / 8.f); p = 1.f + x * (1.f / 7.f) * p; p = 1.f + x * (1.f / 6.f) * p; p = 1.f + x * (1.f / 5.f) * p; p = 1.f + x * 0.25f * p; p = 1.f + x * (1.f / 3.f) * p; p = 1.f + x * 0.5f * p;
    const float big = 1.f - __builtin_amdgcn_exp2f(x * 1.44269504089f);
    return x > -0.35f ? -x * p : big;
}
__device__ __forceinline__ float log_sigmoid(float x) { return fminf(x, 0.f) - log1pf(expf(-fabsf(x))); }
__host__ __device__ __forceinline__ int src_col(int np) { if (np < 2048) { const int p = np >> 8, j = np & 255; return j < 128 ? 128 * p + j : 1024 + 128 * p + (j - 128); } return np; }

#define XB_TMO      128
#define XB_XCNT(j)  (256  + 64 * (j))
#define XB_XSUB(j)  (1280 + 64 * (j))
#define XB_XGEN(j)  (2304 + 64 * (j))
#define XB_TOP      3328
#define XB_TOPGEN   3392
#define XCD_BAR_WORDS 3456
#define XB_SPIN_CAP (1u << 18)
__device__ __forceinline__ unsigned xb_ld(unsigned* p)              { return __hip_atomic_load(p, __ATOMIC_RELAXED, __HIP_MEMORY_SCOPE_AGENT); }
__device__ __forceinline__ unsigned xb_add(unsigned* p, unsigned v) { return __hip_atomic_fetch_add(p, v, __ATOMIC_RELAXED, __HIP_MEMORY_SCOPE_AGENT); }
__device__ __forceinline__ unsigned xb_xcc_id() { return (unsigned)__builtin_amdgcn_s_getreg((3 << 11) | 20) & 0xFu; }
#define XB_SPIN(cond, bar) do { unsigned _sp = 0; while (cond) { __builtin_amdgcn_s_sleep(1); \
    if ((++_sp & 255u) == 0u) { if (xb_ld(&(bar)[XB_TMO])) break; if (_sp > XB_SPIN_CAP) { atomicAdd(&(bar)[XB_TMO], 1u); break; } } } } while (0)
struct XcdBarrier { unsigned* bar; unsigned x; volatile LAS unsigned* st; int wave; };
__device__ __forceinline__ XcdBarrier xcd_barrier_post(unsigned* bar, volatile LAS unsigned* st, int wave) {
    XcdBarrier b; b.bar = bar; b.x = xb_xcc_id(); b.st = st; b.wave = wave;
    if (opaque_tid(wave) == 0) st[2] = xb_add(&bar[XB_XCNT(b.x)], 1u);
    return b;
}
__device__ __forceinline__ void xcd_barrier_complete(unsigned* bar, unsigned x, unsigned& nloc, unsigned& nx) {
    const unsigned G = gridDim.x * gridDim.y * gridDim.z;
    unsigned sum, cnt, mine, sp = 0u;
    for (;;) {
        sum = 0u; cnt = 0u; mine = 0u;
#pragma unroll
        for (unsigned j = 0; j < 16; ++j) { const unsigned c = xb_ld(&bar[XB_XCNT(j)]); sum += c; cnt += (c > 0u) ? 1u : 0u; mine = (j == x) ? c : mine; }
        if (sum == G) break;
        __builtin_amdgcn_s_sleep(1);
        if ((++sp & 255u) == 0u) { if (xb_ld(&bar[XB_TMO])) break; if (sp > XB_SPIN_CAP) { atomicAdd(&bar[XB_TMO], 1u); break; } }
    }
    nloc = mine > 0u ? mine : 1u; nx = cnt > 0u ? cnt : 1u;
}
__device__ __forceinline__ void xcd_barrier(const XcdBarrier& b) {
    asm volatile("s_waitcnt vmcnt(0)" ::: "memory");
    __syncthreads();
    if (opaque_tid(b.wave) == 0) {
        unsigned* bar = b.bar;
        __builtin_amdgcn_s_waitcnt(0);
        unsigned nloc = b.st[0], nx = b.st[1];
        if (nloc == 0u) { xcd_barrier_complete(bar, b.x, nloc, nx); b.st[0] = nloc; b.st[1] = nx; }
        const unsigned old = xb_add(&bar[XB_XSUB(b.x)], 1u);
        const unsigned gen = old / nloc;
        if (old + 1u == (gen + 1u) * nloc) {
            __builtin_amdgcn_fence(__ATOMIC_RELEASE, "agent");
            asm volatile("s_waitcnt vmcnt(0)" ::: "memory");
            const unsigned og = xb_add(&bar[XB_TOP], 1u);
            const unsigned tg = og / nx;
            if (og + 1u == (tg + 1u) * nx) xb_add(&bar[XB_TOPGEN], 1u);
            else XB_SPIN(xb_ld(&bar[XB_TOPGEN]) == tg, bar);
            __builtin_amdgcn_fence(__ATOMIC_ACQUIRE, "agent");
            xb_add(&bar[XB_XGEN(b.x)], 1u);
            asm volatile("s_waitcnt vmcnt(0)" ::: "memory");
        } else {
            XB_SPIN(xb_ld(&bar[XB_XGEN(b.x)]) == gen, bar);
            __builtin_amdgcn_fence(__ATOMIC_ACQUIRE, "agent");
            asm volatile("s_waitcnt vmcnt(0)" ::: "memory");
        }
    }
    __syncthreads();
}

struct Frame {
    LAS unsigned char* lds;
    int tid, lane, wave, bid, G, vc;
    const float *x, *norm_g, *w_in, *cdw_w, *cdw_b, *cln_g, *cln_b, *lcw, *lcb, *wa, *ba, *wx, *bx, *lam, *w_out, *final_g;
    float* out;
    bf16_t *WinT, *WoutT, *XB, *U, *Y;
    float *SSQ; unsigned long long* SUM; bf16_t* WgT; unsigned* ctl;
};

namespace pg8 {
#define PG8_LAS __attribute__((address_space(3)))
typedef unsigned short bf16_t;
typedef short bf16x8 __attribute__((ext_vector_type(8)));
typedef float f32x4 __attribute__((ext_vector_type(4)));
typedef unsigned u32x4 __attribute__((ext_vector_type(4)));
constexpr int BM = 256, BK = 64, HALF = 128, HTB = HALF * BK * 2  , STAGE_BYTES = 8 * HTB, NXCD = 8, WGM = 8;

__host__ __device__ __forceinline__ int lds_byte(int r, int c) { const int st = (r >> 4) * 2 + (c >> 5), rr = r & 15, cc = c & 31, ob = rr * 64 + cc * 2; return st * 1024 + (ob ^ (((ob >> 9) & 1) << 5)); }
__host__ __device__ __forceinline__ void stage_rc(int b, int& R, int& C) { const int st = b / 1024, sb = b % 1024, swz = sb ^ (((sb >> 9) & 1) << 5); R = (st >> 1) * 16 + swz / 64; C = (st & 1) * 32 + (swz % 64) / 2; }
__host__ __device__ __forceinline__ int perm32(int rho) { const int n = rho >> 4, i = rho & 15; return 8 * (i >> 2) + 4 * n + (i & 3); }

struct Unit { int pm, pn; };
struct Gemm { const bf16_t* A; const bf16_t* Bt; int M, N, K; };

struct StaticOrder {
    int nM, nN, nwg, G, c;
    __host__ __device__ void init(int M, int N, int G_, int c_) { nM = M / BM; nN = N / BM; nwg = nM * nN; G = G_; c = c_; }
    __host__ __device__ bool next(int i, Unit& u) const {
        const long L = (long)i * G + c; if (L >= nwg) return false;
        int wgid = (int)L; { const int q = nwg / NXCD, r = nwg % NXCD, xcd = wgid % NXCD, off = wgid / NXCD; wgid = (xcd < r ? xcd * (q + 1) : r * (q + 1) + (xcd - r) * q) + off; }
        const int nig = WGM * nN, gid = wgid / nig, fm = gid * WGM, gsz = (nM - fm) < WGM ? (nM - fm) : WGM;
        u.pm = fm + ((wgid % nig) % gsz); u.pn = (wgid % nig) / gsz; return true;
    }
    __device__ __forceinline__ void a_ready(const Unit&, int) const {}
    __device__ __forceinline__ void done(const Unit&) const {}
};


__device__ __forceinline__ unsigned cvt_pk_bf16(float lo, float hi) { unsigned r; asm volatile("v_cvt_pk_bf16_f32 %0, %1, %2" : "=v"(r) : "v"(lo), "v"(hi)); return r; }
__device__ __forceinline__ float fsigm(float x) { return __builtin_amdgcn_rcpf(1.f + __builtin_amdgcn_exp2f(x * -1.44269504089f)); }
constexpr int RTAB_OFF = STAGE_BYTES;

struct OrderRstd : StaticOrder {
    const float* ssq; PG8_LAS float* rtab; int wave;
    __device__ __forceinline__ void a_ready(const Unit& u, int ui) const {
        const int t_ = opaque_tid(wave), wid = wave, lane = t_ & 63, rl = wid * 32 + (lane & 31), half = lane >> 5;
        const float* p = ssq + (size_t)(half * 16) * 8192 + u.pm * BM + rl; float s = 0.f;
#pragma unroll
        for (int q = 0; q < 16; ++q) s += p[(size_t)q * 8192];
        s += __shfl_xor(s, 32);
        if (lane < 32) rtab[(ui & 1) * 256 + rl] = 1.0f / sqrtf(s * (1.0f / 2048.0f) + 1e-6f);
    }
};
struct EpiIn {
    static constexpr bool PERM = true, AFTER_DRAIN = false;
    bf16_t* U; const PG8_LAS float* rtab;
    __device__ __forceinline__ void operator()(const f32x4 (&acc)[2][2][4][2], const Unit& u, int wr, int wc, int fr, int fq, int ui) const {
        const PG8_LAS float* rt = rtab + (ui & 1) * 256 + wr * 64 + fr;
        if (u.pn < 8) {
            bf16_t* base = U + (size_t)(u.pm * BM + wr * 64 + fr) * 4096 + 128 * u.pn + wc * 32 + 8 * fq;
#pragma unroll
            for (int ai = 0; ai < 2; ++ai)
#pragma unroll
                for (int m = 0; m < 4; ++m) { const float rs = rt[ai * HALF + m * 16];
                    const f32x4 v0 = acc[ai][0][m][0] * rs, v1 = acc[ai][0][m][1] * rs, g0 = acc[ai][1][m][0] * rs, g1 = acc[ai][1][m][1] * rs;
                    u32x4 w; w.x = cvt_pk_bf16(v0[0] * fsigm(g0[0]), v0[1] * fsigm(g0[1])); w.y = cvt_pk_bf16(v0[2] * fsigm(g0[2]), v0[3] * fsigm(g0[3]));
                    w.z = cvt_pk_bf16(v1[0] * fsigm(g1[0]), v1[1] * fsigm(g1[1])); w.w = cvt_pk_bf16(v1[2] * fsigm(g1[2]), v1[3] * fsigm(g1[3]));
                    *(u32x4*)(base + (size_t)(ai * HALF + m * 16) * 4096) = w; }
        } else {
            const bool act = (u.pn < 12) || (u.pn >= 16);
            bf16_t* base = U + (size_t)(u.pm * BM + wr * 64 + fr) * 4096 + (256 * u.pn - 1024) + wc * 32 + 8 * fq;
#pragma unroll
            for (int ai = 0; ai < 2; ++ai)
#pragma unroll
                for (int m = 0; m < 4; ++m) { const float rs = rt[ai * HALF + m * 16];
#pragma unroll
                    for (int bj = 0; bj < 2; ++bj) { f32x4 v0 = acc[ai][bj][m][0] * rs, v1 = acc[ai][bj][m][1] * rs;
                        if (act) {
#pragma unroll
                            for (int e = 0; e < 4; ++e) { v0[e] = v0[e] * fsigm(v0[e]); v1[e] = v1[e] * fsigm(v1[e]); } }
                        u32x4 w; w.x = cvt_pk_bf16(v0[0], v0[1]); w.y = cvt_pk_bf16(v0[2], v0[3]); w.z = cvt_pk_bf16(v1[0], v1[1]); w.w = cvt_pk_bf16(v1[2], v1[3]);
                        *(u32x4*)(base + (size_t)(ai * HALF + m * 16) * 4096 + bj * HALF) = w; } }
        }
    }
};
struct EpiOut {
    static constexpr bool PERM = true, AFTER_DRAIN = false;
    float* out; bf16_t* XB; float* ssq;
    __device__ __forceinline__ void operator()(const f32x4 (&acc)[2][2][4][2], const Unit& u, int wr, int wc, int fr, int fq, int) const {
#pragma unroll
        for (int ai = 0; ai < 2; ++ai) {
            u32x4 xo[4][2];
#pragma unroll
            for (int m = 0; m < 4; ++m)
#pragma unroll
                for (int bj = 0; bj < 2; ++bj) xo[m][bj] = *(const u32x4*)(XB + (size_t)(u.pm * BM + ai * HALF + wr * 64 + m * 16 + fr) * 2048 + u.pn * BM + wc * 32 + 8 * fq + bj * HALF);
#pragma unroll
            for (int m = 0; m < 4; ++m) { const int row = u.pm * BM + ai * HALF + wr * 64 + m * 16 + fr; const size_t off = (size_t)row * 2048 + u.pn * BM + wc * 32 + 8 * fq; float s = 0.f;
#pragma unroll
                for (int bj = 0; bj < 2; ++bj) { const u32x4 q = xo[m][bj];
                    const f32x4 x0 = (f32x4){__builtin_bit_cast(float, q.x << 16), __builtin_bit_cast(float, q.x & 0xffff0000u), __builtin_bit_cast(float, q.y << 16), __builtin_bit_cast(float, q.y & 0xffff0000u)};
                    const f32x4 x1 = (f32x4){__builtin_bit_cast(float, q.z << 16), __builtin_bit_cast(float, q.z & 0xffff0000u), __builtin_bit_cast(float, q.w << 16), __builtin_bit_cast(float, q.w & 0xffff0000u)};
                    const f32x4 v0 = x0 + acc[ai][bj][m][0], v1 = x1 + acc[ai][bj][m][1];
                    if (out) { *(f32x4*)(out + off + bj * HALF) = v0; *(f32x4*)(out + off + bj * HALF + 4) = v1; }
                    else { u32x4 w; w.x = cvt_pk_bf16(v0[0], v0[1]); w.y = cvt_pk_bf16(v0[2], v0[3]); w.z = cvt_pk_bf16(v1[0], v1[1]); w.w = cvt_pk_bf16(v1[2], v1[3]);
                        *(u32x4*)(XB + off + bj * HALF) = w; }
                    s += (v0[0] * v0[0] + v0[1] * v0[1]) + (v0[2] * v0[2] + v0[3] * v0[3]) + (v1[0] * v1[0] + v1[1] * v1[1]) + (v1[2] * v1[2] + v1[3] * v1[3]); }
                s += __shfl_xor(s, 16); s += __shfl_xor(s, 32);
                if (fq == 0) ssq[(size_t)(u.pn * 4 + wc) * 8192 + row] = s; }
            asm volatile("" ::: "memory"); }
    }
};

template <class Epi, class Sched, bool ALIGN_EPI = false, bool SP2 = false>
__device__ __forceinline__ void gemm_phase(PG8_LAS unsigned char* lds, const Gemm g, const Sched& S, const Epi& E, const int wave_in) {
    const int tid = opaque_tid(wave_in), wid = wave_in,
        lane = tid & 63, wr = wid >> 2, wc = wid & 3, fr = lane & 15, fq = lane >> 4;
    const int K = g.K, nt = K / BK;
    unsigned voffA[2], voffB[2];
#pragma unroll
    for (int i = 0; i < 2; ++i) { int R, C; stage_rc(tid * 16 + i * 8192, R, C); const int Rb = Epi::PERM ? ((R & ~31) + perm32(R & 31)) : R;
        voffA[i] = (unsigned)(R * K + C) * 2u; voffB[i] = (unsigned)(Rb * K + C) * 2u; }
    const size_t kstep = (size_t)(BK * 2);
    const size_t hstep = (size_t)HALF * K * 2;
    const size_t tstep = 2 * hstep;
    const unsigned ldsw = (unsigned)wid * 1024u;
    const int aoff = lds_byte(wr * 64 + fr, fq * 8), boff = lds_byte(wc * 32 + fr, fq * 8);
#define PG8_SA(b, h) (((b) * 2 + (h)) * HTB)
#define PG8_SB(b, h) ((4 + (b) * 2 + (h)) * HTB)
#define PG8_STAGE(bufoff, gbase, voff) do { _Pragma("unroll") for (int _i = 0; _i < 2; ++_i) \
        __builtin_amdgcn_global_load_lds((const unsigned*)((const char*)(gbase) + (voff)[_i]), (PG8_LAS unsigned*)(lds + (bufoff) + ldsw + _i * 8192), 16, 0, 0); } while (0)
#define PG8_LDA(dst, b, h) do { _Pragma("unroll") for (int m = 0; m < 4; ++m) _Pragma("unroll") for (int k = 0; k < 2; ++k) dst[m][k] = *(const PG8_LAS bf16x8*)(lds + PG8_SA(b, h) + aoff + m * 2048 + k * 1024); } while (0)
#define PG8_LDB(dst, b, h) do { _Pragma("unroll") for (int n = 0; n < 2; ++n) _Pragma("unroll") for (int k = 0; k < 2; ++k) dst[n][k] = *(const PG8_LAS bf16x8*)(lds + PG8_SB(b, h) + boff + n * 2048 + k * 1024); } while (0)
#define PG8_MMA(ai, bj, At, Bt) do { __builtin_amdgcn_s_setprio(1); _Pragma("unroll") for (int m = 0; m < 4; ++m) _Pragma("unroll") for (int n = 0; n < 2; ++n) _Pragma("unroll") for (int k = 0; k < 2; ++k) \
        acc[ai][bj][m][n] = __builtin_amdgcn_mfma_f32_16x16x32_bf16(Bt[n][k], At[m][k], acc[ai][bj][m][n], 0, 0, 0); __builtin_amdgcn_s_setprio(0); } while (0)
#define PG8_WAIT_V(n) asm volatile("s_waitcnt vmcnt(" #n ")" ::: "memory")
#define PG8_WAIT_L(n) asm volatile("s_waitcnt lgkmcnt(" #n ")" ::: "memory")
#define PG8_BAR __builtin_amdgcn_s_barrier()
#define PG8_SCHED __builtin_amdgcn_sched_barrier(0)
    Unit cur, nxt; int ui = 0;
    if (!S.next(0, cur)) return;
    f32x4 acc[2][2][4][2];
#pragma unroll
    for (int a = 0; a < 2; ++a)
#pragma unroll
        for (int b = 0; b < 2; ++b)
#pragma unroll
            for (int m = 0; m < 4; ++m)
#pragma unroll
                for (int n = 0; n < 2; ++n) acc[a][b][m][n] = (f32x4){0.f, 0.f, 0.f, 0.f};
    bf16x8 At[4][2], B0[2][2], B1[2][2];
    const char* cA = (const char*)g.A + (size_t)cur.pm * tstep; const char* cB = (const char*)g.Bt + (size_t)cur.pn * tstep;
    S.a_ready(cur, 0);
    if constexpr (SP2) {
        PG8_STAGE(PG8_SB(0, 0), cB, voffB); PG8_STAGE(PG8_SB(0, 1), cB + hstep, voffB); PG8_STAGE(PG8_SA(0, 0), cA, voffA); PG8_STAGE(PG8_SA(0, 1), cA + hstep, voffA);
        if (wr == 1) PG8_BAR;
        PG8_WAIT_V(2); PG8_BAR;
        PG8_STAGE(PG8_SB(1, 0), cB + kstep, voffB); PG8_STAGE(PG8_SA(1, 0), cA + kstep, voffA); PG8_STAGE(PG8_SB(1, 1), cB + hstep + kstep, voffB);
        PG8_WAIT_V(6); PG8_BAR;
    } else {
        PG8_STAGE(PG8_SB(0, 0), cB, voffB); PG8_STAGE(PG8_SA(0, 0), cA, voffA); PG8_STAGE(PG8_SB(0, 1), cB + hstep, voffB); PG8_STAGE(PG8_SA(0, 1), cA + hstep, voffA);
        if (wr == 1) PG8_BAR;
        PG8_WAIT_V(4); PG8_BAR;
        PG8_STAGE(PG8_SB(1, 0), cB + kstep, voffB); PG8_STAGE(PG8_SA(1, 0), cA + kstep, voffA); PG8_STAGE(PG8_SB(1, 1), cB + hstep + kstep, voffB);
        PG8_WAIT_V(6); PG8_BAR;
    }
    for (;;) {
        const bool has_next = S.next(ui + 1, nxt);
        const char* nA = has_next ? (const char*)g.A + (size_t)nxt.pm * tstep : cA; const char* nB = has_next ? (const char*)g.Bt + (size_t)nxt.pn * tstep : cB;
        for (int t = 0; t < nt; t += 2) {
            const bool last = (t == nt - 2);
            const char* a1 = cA + (size_t)(t + 1) * kstep;
            const char* a2 = last ? nA : cA + (size_t)(t + 2) * kstep; const char* b2 = last ? nB : cB + (size_t)(t + 2) * kstep;
            const char* a3 = a2 + kstep; const char* b3 = b2 + kstep;
            if (last && has_next) S.a_ready(nxt, ui + 1);
            if constexpr (SP2) {
            PG8_LDB(B0, 0, 0); PG8_LDB(B1, 0, 1); PG8_SCHED; PG8_LDA(At, 0, 0); PG8_STAGE(PG8_SA(1, 1), a1 + hstep, voffA);
            PG8_WAIT_V(8); PG8_WAIT_L(0); PG8_BAR; PG8_MMA(0, 0, At, B0); PG8_MMA(0, 1, At, B1); PG8_BAR; PG8_SCHED;
            PG8_LDA(At, 0, 1); PG8_STAGE(PG8_SB(0, 0), b2, voffB); PG8_STAGE(PG8_SB(0, 1), b2 + hstep, voffB); PG8_STAGE(PG8_SA(0, 0), a2, voffA);
            PG8_WAIT_V(8); PG8_WAIT_L(0); PG8_BAR; PG8_MMA(1, 0, At, B0); PG8_MMA(1, 1, At, B1); PG8_BAR; PG8_SCHED;
            PG8_LDB(B0, 1, 0); PG8_LDB(B1, 1, 1); PG8_SCHED; PG8_LDA(At, 1, 0); PG8_STAGE(PG8_SA(0, 1), a2 + hstep, voffA);
            PG8_WAIT_V(8); PG8_WAIT_L(0); PG8_BAR; PG8_MMA(0, 0, At, B0); PG8_MMA(0, 1, At, B1); PG8_BAR; PG8_SCHED;
            PG8_LDA(At, 1, 1); PG8_STAGE(PG8_SB(1, 0), b3, voffB); PG8_STAGE(PG8_SB(1, 1), b3 + hstep, voffB); PG8_STAGE(PG8_SA(1, 0), a3, voffA);
            PG8_WAIT_V(8); PG8_WAIT_L(0); PG8_BAR; PG8_MMA(1, 0, At, B0); PG8_MMA(1, 1, At, B1); PG8_BAR; PG8_SCHED;
            } else {
            PG8_LDB(B0, 0, 0); PG8_SCHED; PG8_LDA(At, 0, 0); PG8_STAGE(PG8_SA(1, 1), a1 + hstep, voffA);
            PG8_WAIT_L(8); PG8_BAR; PG8_WAIT_L(0); PG8_MMA(0, 0, At, B0); PG8_BAR; PG8_SCHED;
            PG8_LDB(B1, 0, 1); PG8_STAGE(PG8_SB(0, 0), b2, voffB);
            PG8_BAR; PG8_WAIT_L(0); PG8_MMA(0, 1, At, B1); PG8_BAR;
            PG8_LDA(At, 0, 1); PG8_STAGE(PG8_SA(0, 0), a2, voffA);
            PG8_BAR; PG8_WAIT_L(0); PG8_MMA(1, 0, At, B0); PG8_BAR; PG8_SCHED;
            PG8_STAGE(PG8_SB(0, 1), b2 + hstep, voffB);
            PG8_WAIT_V(6); PG8_BAR; PG8_MMA(1, 1, At, B1); PG8_BAR;
            PG8_LDB(B0, 1, 0); PG8_SCHED; PG8_LDA(At, 1, 0); PG8_STAGE(PG8_SA(0, 1), a2 + hstep, voffA);
            PG8_WAIT_L(8); PG8_BAR; PG8_WAIT_L(0); PG8_MMA(0, 0, At, B0); PG8_BAR; PG8_SCHED;
            PG8_LDB(B1, 1, 1); PG8_STAGE(PG8_SB(1, 0), b3, voffB);
            PG8_BAR; PG8_WAIT_L(0); PG8_MMA(0, 1, At, B1); PG8_BAR;
            PG8_LDA(At, 1, 1); PG8_STAGE(PG8_SA(1, 0), a3, voffA);
            PG8_BAR; PG8_WAIT_L(0); PG8_MMA(1, 0, At, B0); PG8_BAR; PG8_SCHED;
            PG8_STAGE(PG8_SB(1, 1), b3 + hstep, voffB);
            PG8_WAIT_V(6); PG8_BAR; PG8_MMA(1, 1, At, B1); PG8_BAR;
            }
        }
        if constexpr (ALIGN_EPI) { if (wr == 0) PG8_BAR; }
        if constexpr (!Epi::AFTER_DRAIN) { E(acc, cur, wr, wc, fr, fq, ui); S.done(cur); }
        if (!has_next) break;
#pragma unroll
        for (int a = 0; a < 2; ++a)
#pragma unroll
            for (int b = 0; b < 2; ++b)
#pragma unroll
                for (int m = 0; m < 4; ++m)
#pragma unroll
                    for (int n = 0; n < 2; ++n) acc[a][b][m][n] = (f32x4){0.f, 0.f, 0.f, 0.f};
        cur = nxt; cA = nA; cB = nB; ++ui;
        if constexpr (ALIGN_EPI) { if (wr == 1) PG8_BAR; }
    }
    PG8_WAIT_V(0);
    if constexpr (!ALIGN_EPI) { if (wr == 0) PG8_BAR; }
    PG8_BAR;
    if constexpr (Epi::AFTER_DRAIN) { E.fused(acc, cur, wr, wc, fr, fq, lds, wid, lane); S.done(cur); }
#undef PG8_SA
#undef PG8_SB
#undef PG8_STAGE
#undef PG8_LDA
#undef PG8_LDB
#undef PG8_MMA
#undef PG8_WAIT_V
#undef PG8_WAIT_L
#undef PG8_BAR
#undef PG8_SCHED
}
}

__device__ __forceinline__ int opaque_tid(int wave) { int ln = __builtin_amdgcn_mbcnt_hi(~0u, __builtin_amdgcn_mbcnt_lo(~0u, 0u)); asm volatile("" : "+v"(ln)); return wave * 64 + ln; }
#define PHASE_TID(F) do { const int _t = opaque_tid((F).wave); (F).tid = _t; (F).lane = _t & 63; } while (0)
__device__ __forceinline__ void transpose_item(const float* W, int K, int N, bf16_t* WT, int dst_row0, int src_col0, const float* gk, LAS float* scr, int k0, int lane) {
    f32x4 v[16]; const int r0 = lane >> 4, c4 = (lane & 15) * 4;
    const float* wp = W + (size_t)(k0 + r0) * N + src_col0 + c4;
#pragma unroll
    for (int i = 0; i < 16; ++i) v[i] = *(const f32x4*)(wp + (size_t)(4 * i) * N);
    if (gk) {
#pragma unroll
        for (int i = 0; i < 16; ++i) v[i] = v[i] * gk[k0 + r0 + 4 * i]; }
#pragma unroll
    for (int i = 0; i < 16; ++i) { LAS float* d = scr + (r0 + 4 * i) * 65 + c4; d[0] = v[i][0]; d[1] = v[i][1]; d[2] = v[i][2]; d[3] = v[i][3]; }
    asm volatile("s_waitcnt lgkmcnt(0)" ::: "memory");
    const int c = lane & 7;
#pragma unroll
    for (int j = 0; j < 8; ++j) { const int n = (lane >> 3) + 8 * j; const LAS float* sp = scr + (8 * c) * 65 + n;
        u32x4 o; o.x = pk2(sp[0 * 65], sp[1 * 65]); o.y = pk2(sp[2 * 65], sp[3 * 65]); o.z = pk2(sp[4 * 65], sp[5 * 65]); o.w = pk2(sp[6 * 65], sp[7 * 65]);
        *(u32x4*)(WT + (size_t)(dst_row0 + n) * K + k0 + 8 * c) = o; }
    asm volatile("s_waitcnt lgkmcnt(0)" ::: "memory");
}
__device__ __forceinline__ void convert_layer(Frame& F, int l, int gw, int NGW) {
    LAS float* scr = (LAS float*)(F.lds + F.wave * 17408);
    constexpr int I_IN = (D / 64) * (DIN / 64), I_OUT = (D / 64) * (D / 64), I_G = NHEAD * 2 * (HD / 64) * (HD / 64), I_L = I_IN + I_OUT + I_G;
    for (int it = gw; it < I_L; it += NGW) {
        int r = it;
        if (r >= I_IN + I_OUT) { r -= I_IN + I_OUT; const int hg = r >> 2, kb = (r >> 1) & 1, nb = r & 1, h = hg >> 1, gsel = hg & 1;
            transpose_item((gsel ? F.wx : F.wa) + (size_t)(l * NHEAD + h) * HD * HD, HD, HD, F.WgT + (size_t)((l * NHEAD + h) * 2 + gsel) * HD * HD, 64 * nb, 64 * nb, nullptr, scr, 64 * kb, F.lane);
        } else if (r < I_IN) { const int kb = r / (DIN / 64), nb = r % (DIN / 64);
            transpose_item(F.w_in + (size_t)l * D * DIN, D, DIN, F.WinT + (size_t)l * DIN * D, 64 * nb, src_col(64 * nb), F.norm_g + l * D, scr, 64 * kb, F.lane);
        } else { r -= I_IN; const int kb = r / (D / 64), nb = r % (D / 64);
            transpose_item(F.w_out + (size_t)l * D * D, D, D, F.WoutT + (size_t)l * D * D, 64 * nb, 64 * nb, nullptr, scr, 64 * kb, F.lane); }
    }
}
__device__ __forceinline__ void p_prologue(Frame& F) {
    PHASE_TID(F);
    const int gw = F.bid * NWAVES + F.wave, NGW = F.G * NWAVES;
    convert_layer(F, 0, gw, NGW);
    if (!(F.G == 256)) { for (int l = 1; l < DEPTH; ++l) convert_layer(F, l, gw, NGW); }
    for (int m = gw; m < S; m += NGW) {
        const f32x4* xr = (const f32x4*)(F.x + (size_t)m * D) + F.lane; u32x2* ob = (u32x2*)(F.XB + (size_t)m * D) + F.lane; float s = 0.f;
#pragma unroll
        for (int j = 0; j < 8; ++j) { const f32x4 v = xr[64 * j]; s += (v.x * v.x + v.y * v.y) + (v.z * v.z + v.w * v.w); u32x2 w; w.x = pk2(v.x, v.y); w.y = pk2(v.z, v.w); ob[64 * j] = w; }
        s = wave_sum(s);
        if (F.lane < 32) F.SSQ[F.lane * S + m] = F.lane == 0 ? s : 0.f;
    }
}

#define DPP_MOV(x, ctrl) __builtin_bit_cast(float, __builtin_amdgcn_update_dpp(0, __builtin_bit_cast(int, (float)(x)), (ctrl), 0xf, 0xf, true))
template <int NV> __device__ __forceinline__ void block_sum(float (&v)[NV], LAS float* red  , int wave, int lane) {
#pragma unroll
    for (int i = 0; i < NV; ++i) v[i] += DPP_MOV(v[i], 0x128);
#pragma unroll
    for (int i = 0; i < NV; ++i) v[i] += DPP_MOV(v[i], 0x124);
#pragma unroll
    for (int i = 0; i < NV; ++i) v[i] += DPP_MOV(v[i], 0x4E);
#pragma unroll
    for (int i = 0; i < NV; ++i) v[i] += DPP_MOV(v[i], 0xB1);
    __builtin_amdgcn_sched_barrier(0);
    float t[NV];
#pragma unroll
    for (int i = 0; i < NV; ++i) t[i] = __shfl_xor(v[i], 16);
#pragma unroll
    for (int i = 0; i < NV; ++i) v[i] += t[i];
    __builtin_amdgcn_sched_barrier(0);
#pragma unroll
    for (int i = 0; i < NV; ++i) t[i] = __shfl_xor(v[i], 32);
#pragma unroll
    for (int i = 0; i < NV; ++i) v[i] += t[i];
    __builtin_amdgcn_sched_barrier(0);
    if (lane == 0) {
#pragma unroll
        for (int i = 0; i < NV; ++i) red[i * 8 + wave] = v[i]; }
    __syncthreads();
#pragma unroll
    for (int i = 0; i < NV; ++i) { const LAS f32x4* p = (const LAS f32x4*)(red + i * 8); const f32x4 a = p[0], b = p[1]; v[i] = ((a.x + a.y) + (a.z + a.w)) + ((b.x + b.y) + (b.z + b.w)); }
    __syncthreads();
}
constexpr int CT = 16;
__device__ __forceinline__ void conv_item(Frame& F, int l, int item) {
    LAS unsigned char* cs = F.lds;
    LAS float* red = (LAS float*)(F.lds + 62 * 2048);
    const int t0 = item * 32, c0 = 2 * F.tid;
    const auto rus = MAKE_RSRC(F.U, (size_t)S * UW * 2); const int c16 = F.tid & 127, rb = F.tid >> 7; u32x4 v[16];
#pragma unroll
    for (int i = 0; i < 16; ++i) { const int row = rb + 4 * i, sidx = t0 - 30 + row; v[i] = (u32x4){0u, 0u, 0u, 0u};
        if (row < 62 && sidx >= 0) v[i] = __builtin_bit_cast(u32x4, __builtin_amdgcn_raw_buffer_load_b128(rus, c16 * 16, sidx * (UW * 2), 0)); }
    f32x2 wv[31];
    const auto rw = MAKE_RSRC(F.cdw_w + (size_t)l * CW * DC, CW * DC * 4);
#pragma unroll
    for (int j = 0; j < 31; ++j) wv[j] = __builtin_bit_cast(f32x2, __builtin_amdgcn_raw_buffer_load_b64(rw, c0 * 4, (30 - j) * DC * 4, 0));
    const f32x2 bias = *(const f32x2*)(F.cdw_b + l * DC + c0);
    const f32x2 lg = *(const f32x2*)(F.cln_g + l * DC + c0), lb = *(const f32x2*)(F.cln_b + l * DC + c0);
    const auto ru = MAKE_RSRC(F.U, (size_t)S * UW * 2); const auto ry = MAKE_RSRC(F.Y, (size_t)S * D * 2);
    unsigned zwq[32];
#pragma unroll
    for (int i = 0; i < 32; ++i) zwq[i] = __builtin_amdgcn_raw_buffer_load_b32(ru, (1024 + c0) * 2, (t0 + i) * (UW * 2), 0);
#pragma unroll
    for (int i = 0; i < 16; ++i) { const int row = rb + 4 * i; if (row < 62) *(LAS u32x4*)(cs + row * 2048 + c16 * 16) = v[i]; }
    __syncthreads();
#pragma unroll 1
    for (int hb_ = 0; hb_ < ((PROBE_DUP & 64) ? 2 : 1) * (32 / CT); ++hb_) { const int hb = hb_ % (32 / CT);
        f32x2 acc[CT];
#pragma unroll
        for (int i = 0; i < CT; ++i) acc[i] = bias;
        const LAS unsigned char* cp = cs + (hb * CT) * 2048 + F.tid * 4;
        unsigned cwq[CT + 30];
#pragma unroll
        for (int si = 0; si < CT + 30; ++si) cwq[si] = *(const LAS unsigned*)(cp + si * 2048);
        static_assert(CT + 30 == 46, "operand lists below");
        asm volatile("" : "+v"(cwq[0]), "+v"(cwq[1]), "+v"(cwq[2]), "+v"(cwq[3]), "+v"(cwq[4]), "+v"(cwq[5]), "+v"(cwq[6]), "+v"(cwq[7]), "+v"(cwq[8]), "+v"(cwq[9]), "+v"(cwq[10]), "+v"(cwq[11]), "+v"(cwq[12]), "+v"(cwq[13]), "+v"(cwq[14]), "+v"(cwq[15]));
        asm volatile("" : "+v"(cwq[16]), "+v"(cwq[17]), "+v"(cwq[18]), "+v"(cwq[19]), "+v"(cwq[20]), "+v"(cwq[21]), "+v"(cwq[22]), "+v"(cwq[23]), "+v"(cwq[24]), "+v"(cwq[25]), "+v"(cwq[26]), "+v"(cwq[27]), "+v"(cwq[28]), "+v"(cwq[29]), "+v"(cwq[30]), "+v"(cwq[31]));
        asm volatile("" : "+v"(cwq[32]), "+v"(cwq[33]), "+v"(cwq[34]), "+v"(cwq[35]), "+v"(cwq[36]), "+v"(cwq[37]), "+v"(cwq[38]), "+v"(cwq[39]), "+v"(cwq[40]), "+v"(cwq[41]), "+v"(cwq[42]), "+v"(cwq[43]), "+v"(cwq[44]), "+v"(cwq[45]));
#pragma unroll
        for (int si = 0; si < CT + 30; ++si) {
            const unsigned cw = cwq[si];
            const f32x2 xv = (f32x2){bflo(cw), bfhi(cw)};
#pragma unroll
            for (int i = 0; i < CT; ++i) { const int j = i + 30 - si; if (j >= 0 && j <= 30) acc[i] = wv[j] * xv + acc[i]; }
            static_assert(CT == 16, "operand list below");
            asm volatile("" : "+v"(acc[0]), "+v"(acc[1]), "+v"(acc[2]), "+v"(acc[3]), "+v"(acc[4]), "+v"(acc[5]), "+v"(acc[6]), "+v"(acc[7]),
                              "+v"(acc[8]), "+v"(acc[9]), "+v"(acc[10]), "+v"(acc[11]), "+v"(acc[12]), "+v"(acc[13]), "+v"(acc[14]), "+v"(acc[15]));
        }
        float a0[CT], a1[CT];
#pragma unroll
        for (int i = 0; i < CT; ++i) { a0[i] = acc[i].x; a1[i] = acc[i].y; }
        float sv[CT];
#pragma unroll
        for (int i = 0; i < CT; ++i) sv[i] = a0[i] + a1[i];
        block_sum<CT>(sv, red, F.wave, F.lane);
#pragma unroll
        for (int i = 0; i < CT; ++i) { const float mean = sv[i] * (1.f / DC); a0[i] -= mean; a1[i] -= mean; sv[i] = a0[i] * a0[i] + a1[i] * a1[i]; }
        block_sum<CT>(sv, red, F.wave, F.lane);
#pragma unroll
        for (int i = 0; i < CT; ++i) {
            const int t = t0 + hb * CT + i;
            const float rstd = __builtin_amdgcn_rsqf(sv[i] * (1.f / DC) + LN_EPS);
            const unsigned zw = hb ? zwq[CT + i] : zwq[i];
            const float n0 = a0[i] * rstd * lg.x + lb.x, n1 = a1[i] * rstd * lg.y + lb.y;
            const float y0 = n0 * pg8::fsigm(n0) * bflo(zw), y1 = n1 * pg8::fsigm(n1) * bfhi(zw);
            __builtin_amdgcn_raw_buffer_store_b32(pk2(y0, y1), ry, c0 * 2, t * (D * 2), 0);
        }
    }
    __syncthreads();
}
#define DPP_ROW_SHR(x, oldv, d) __builtin_bit_cast(float, __builtin_amdgcn_update_dpp(__builtin_bit_cast(int, (float)(oldv)), __builtin_bit_cast(int, (float)(x)), 0x110 + (d), 0xf, 0xf, false))
#define DPP_ROW_BCAST15(x) __builtin_bit_cast(float, __builtin_amdgcn_update_dpp(0, __builtin_bit_cast(int, (float)(x)), 0x15F, 0xf, 0xf, true))
__device__ __forceinline__ unsigned* lru_flag(Frame& F, int l, int c, int h) { return F.ctl + CW_LRU + 64 * ((l * NLCH + c) * NHEAD + h); }
__device__ __forceinline__ void lru_item(Frame& F, int l, int item) {
    const int c = item >> 3, h = item & 7, t0 = c * LCH, ch0 = h * HD;
    LAS unsigned char* xhi = F.lds; LAS unsigned char* xlo = F.lds + LCH * XROW;
    const int tid = F.tid, lane = F.lane, w = F.wave, fr = lane & 15, fq = lane >> 4;
    const auto ru = MAKE_RSRC(F.U, (size_t)S * UW * 2); const auto ry = MAKE_RSRC(F.Y, (size_t)S * D * 2);
    const int chl = ch0 + 16 * w + 4 * fq;
    const f32x4 vba = *(const f32x4*)(F.ba + l * DL + chl), vbx = *(const f32x4*)(F.bx + l * DL + chl), vlam = *(const f32x4*)(F.lam + l * DL + chl);
    float c8l[4], c8x[4], nba[4], nbx[4], keep[4];
#pragma unroll
    for (int j = 0; j < 4; ++j) { const float c8 = 8.f * log_sigmoid(vlam[j]); c8l[j] = c8 * 1.44269504089f; c8x[j] = 2.f * c8; nba[j] = vba[j] * -1.44269504089f; nbx[j] = vbx[j] * -1.44269504089f; }
    keep[0] = fr < 1 ? 1.f : 0.f; keep[1] = fr < 2 ? 1.f : 0.f; keep[2] = fr < 4 ? 1.f : 0.f; keep[3] = fr < 8 ? 1.f : 0.f;
    bf16x8 br[4], bi[4];
    { const bf16_t* wg = F.WgT + (size_t)((l * NHEAD + h) * 2) * HD * HD + (size_t)(16 * w + fr) * HD + 8 * fq;
#pragma unroll
      for (int kk = 0; kk < 4; ++kk) { br[kk] = *(const bf16x8*)(wg + 32 * kk); bi[kk] = *(const bf16x8*)(wg + HD * HD + 32 * kk); } }
    {
        const int tg = tid >> 4, cg = tid & 15, tb = 8 * tg;
        const float* cw = F.lcw + (size_t)l * LW * DL + ch0 + 8 * cg;
        f32x4 wk[4][2];
#pragma unroll
        for (int k = 0; k < 4; ++k) { wk[k][0] = *(const f32x4*)(cw + (size_t)k * DL); wk[k][1] = *(const f32x4*)(cw + (size_t)k * DL + 4); }
        const f32x4 bb0 = *(const f32x4*)(F.lcb + l * DL + ch0 + 8 * cg), bb1 = *(const f32x4*)(F.lcb + l * DL + ch0 + 8 * cg + 4);
        u32x4 rows[11];
#pragma unroll
        for (int r = 0; r < 11; ++r) { const int sidx = t0 + tb - 3 + r; rows[r] = (u32x4){0u, 0u, 0u, 0u};
            if (sidx >= 0) rows[r] = __builtin_bit_cast(u32x4, __builtin_amdgcn_raw_buffer_load_b128(ru, (2048 + ch0 + 8 * cg) * 2, sidx * (UW * 2), 0)); }
#pragma unroll
        for (int i = 0; i < 8; ++i) {
            f32x4 a0 = bb0, a1 = bb1;
#pragma unroll
            for (int k = 0; k < 4; ++k) { const u32x4 q = rows[i + k];
                a0[0] += wk[k][0][0] * bflo(q.x); a0[1] += wk[k][0][1] * bfhi(q.x); a0[2] += wk[k][0][2] * bflo(q.y); a0[3] += wk[k][0][3] * bfhi(q.y);
                a1[0] += wk[k][1][0] * bflo(q.z); a1[1] += wk[k][1][1] * bfhi(q.z); a1[2] += wk[k][1][2] * bflo(q.w); a1[3] += wk[k][1][3] * bfhi(q.w); }
            u32x4 hi; hi.x = pk2(a0[0], a0[1]); hi.y = pk2(a0[2], a0[3]); hi.z = pk2(a1[0], a1[1]); hi.w = pk2(a1[2], a1[3]);
            u32x4 lo; lo.x = pk2(a0[0] - bflo(hi.x), a0[1] - bfhi(hi.x)); lo.y = pk2(a0[2] - bflo(hi.y), a0[3] - bfhi(hi.y)); lo.z = pk2(a1[0] - bflo(hi.z), a1[1] - bfhi(hi.z)); lo.w = pk2(a1[2] - bflo(hi.w), a1[3] - bfhi(hi.w));
            *(LAS u32x4*)(xhi + (tb + i) * XROW + cg * 16) = hi; *(LAS u32x4*)(xlo + (tb + i) * XROW + cg * 16) = lo; }
    }
    __syncthreads();
    float hl[16][4], pc[16][4], HC[4], PC[4];
#pragma unroll
    for (int j = 0; j < 4; ++j) { HC[j] = 0.f; PC[j] = 1.f; }
#pragma unroll
    for (int m = 0; m < 16; ++m) {
        f32x4 ar = (f32x4){0.f, 0.f, 0.f, 0.f}, ai = (f32x4){0.f, 0.f, 0.f, 0.f};
        const LAS unsigned char* rowp = xhi + (16 * m + fr) * XROW;
#pragma unroll
        for (int kk = 0; kk < 4; ++kk) { const bf16x8 a = *(const LAS bf16x8*)(rowp + (32 * kk + 8 * fq) * 2);
            ar = __builtin_amdgcn_mfma_f32_16x16x32_bf16(br[kk], a, ar, 0, 0, 0); ai = __builtin_amdgcn_mfma_f32_16x16x32_bf16(bi[kk], a, ai, 0, 0, 0); }
        const u32x2 qh = *(const LAS u32x2*)(rowp + (16 * w + 4 * fq) * 2), ql = *(const LAS u32x2*)(rowp + LCH * XROW + (16 * w + 4 * fq) * 2);
        const float xcv[4] = {bflo(qh.x) + bflo(ql.x), bfhi(qh.x) + bfhi(ql.x), bflo(qh.y) + bflo(ql.y), bfhi(qh.y) + bfhi(ql.y)};
        float Aj[4], Bj[4], xq[4];
#pragma unroll
        for (int j = 0; j < 4; ++j) {
            const float r = __builtin_amdgcn_rcpf(1.f + __builtin_amdgcn_exp2f(ar[j] * -1.44269504089f + nba[j])), ig = __builtin_amdgcn_rcpf(1.f + __builtin_amdgcn_exp2f(ai[j] * -1.44269504089f + nbx[j]));
            const float x = c8x[j] * r; xq[j] = x;
            float p = x * (1.f / 5040.f) + (1.f / 720.f); p = p * x + (1.f / 120.f); p = p * x + (1.f / 24.f); p = p * x + (1.f / 6.f); p = p * x + 0.5f; p = p * x + 1.f;
            Aj[j] = __builtin_amdgcn_exp2f(c8l[j] * r); Bj[j] = __builtin_amdgcn_sqrtf(-x * p) * (ig * xcv[j]); }
        if (__builtin_expect(__any(fminf(fminf(xq[0], xq[1]), fminf(xq[2], xq[3])) <= -0.35f), 0)) {
#pragma unroll
            for (int j = 0; j < 4; ++j) if (xq[j] <= -0.35f) { const float r = __builtin_amdgcn_rcpf(1.f + __builtin_amdgcn_exp2f(ar[j] * -1.44269504089f + nba[j])), ig = __builtin_amdgcn_rcpf(1.f + __builtin_amdgcn_exp2f(ai[j] * -1.44269504089f + nbx[j]));
                (void)r; Bj[j] = __builtin_amdgcn_sqrtf(1.f - __builtin_amdgcn_exp2f(xq[j] * 1.44269504089f)) * (ig * xcv[j]); } }
#define LRU_PIN asm volatile("" : "+v"(Aj[0]), "+v"(Aj[1]), "+v"(Aj[2]), "+v"(Aj[3]), "+v"(Bj[0]), "+v"(Bj[1]), "+v"(Bj[2]), "+v"(Bj[3]))
#define DPP_SHR0(x, d) __builtin_bit_cast(float, __builtin_amdgcn_update_dpp(0, __builtin_bit_cast(int, (float)(x)), 0x110 + (d), 0xf, 0xf, true))
#define LRU_SCAN_STEP(d, kd) { \
            _Pragma("unroll") for (int j = 0; j < 4; ++j) { Bj[j] = DPP_SHR0(Bj[j], d) * Aj[j] + Bj[j]; } \
            _Pragma("unroll") for (int j = 0; j < 4; ++j) { const float t = DPP_SHR0(Aj[j], d) + keep[kd]; Aj[j] = Aj[j] * t; } LRU_PIN; }
        LRU_PIN; LRU_SCAN_STEP(1, 0) LRU_SCAN_STEP(2, 1) LRU_SCAN_STEP(4, 2) LRU_SCAN_STEP(8, 3)
#undef LRU_SCAN_STEP
#undef LRU_PIN
#pragma unroll
        for (int j = 0; j < 4; ++j) { hl[m][j] = Bj[j] + Aj[j] * HC[j]; pc[m][j] = Aj[j] * PC[j]; }
#pragma unroll
        for (int j = 0; j < 4; ++j) { HC[j] = DPP_ROW_BCAST15(hl[m][j]); PC[j] = DPP_ROW_BCAST15(pc[m][j]); }
    }
    const int vo_u = (fr * UW + 3072 + chl) * 2, vo_y = (fr * D + DC + chl) * 2;
    u32x2 zq[16];
#pragma unroll
    for (int m = 0; m < 16; ++m) zq[m] = __builtin_bit_cast(u32x2, __builtin_amdgcn_raw_buffer_load_b64(ru, vo_u, (t0 + 16 * m) * (UW * 2), 0));
    if (fr == 15) { unsigned long long* sp = F.SUM + (size_t)(l * NLCH + c) * DL + chl;
#pragma unroll
        for (int j = 0; j < 4; ++j) __hip_atomic_store(sp + j, ((unsigned long long)__builtin_bit_cast(unsigned, HC[j]) << 32) | __builtin_bit_cast(unsigned, PC[j]), __ATOMIC_RELAXED, __HIP_MEMORY_SCOPE_AGENT); }
    asm volatile("s_waitcnt vmcnt(0)" ::: "memory");
    __syncthreads();
    if (tid == 0) __hip_atomic_store(lru_flag(F, l, c, h), 1u, __ATOMIC_RELAXED, __HIP_MEMORY_SCOPE_AGENT);
    float Hin[4] = {0.f, 0.f, 0.f, 0.f};
    if (c > 0) {
        if (w == 0) {
            unsigned* fp = lru_flag(F, l, lane < c ? lane : 0, h); unsigned spins = 0;
            for (;;) { const unsigned v = __hip_atomic_load(fp, __ATOMIC_RELAXED, __HIP_MEMORY_SCOPE_AGENT); if (__all(v != 0u)) break; __builtin_amdgcn_s_sleep(2); if (++spins > (1u << 20)) break; }
            __builtin_amdgcn_fence(__ATOMIC_ACQUIRE, "agent");
            asm volatile("s_waitcnt vmcnt(0)" ::: "memory");
        }
        __syncthreads();
        const unsigned long long* sp = F.SUM + (size_t)(l * NLCH) * DL + chl;
        u32x4 q[2][2];
#pragma unroll
        for (int g = 0; g < 2; ++g) { const int cc = fr + 16 * g; q[g][0] = (u32x4){0x3f800000u, 0u, 0x3f800000u, 0u}; q[g][1] = q[g][0];
            if (cc < c) { q[g][0] = *(const u32x4*)(sp + (size_t)cc * DL); q[g][1] = *(const u32x4*)(sp + (size_t)cc * DL + 2); } }
#pragma unroll
        for (int j = 0; j < 4; ++j) { float Hq[2];
#pragma unroll
            for (int g = 0; g < 2; ++g) { const u32x4 qq = q[g][j >> 1]; float A = (j & 1) ? u2f(qq.z) : u2f(qq.x), B = (j & 1) ? u2f(qq.w) : u2f(qq.y);
#define LRU_SCAN_STEP(d) { const float ap = DPP_ROW_SHR(A, 1.0f, d), bp = DPP_ROW_SHR(B, 0.0f, d); B = A * bp + B; A = ap * A; }
                LRU_SCAN_STEP(1) LRU_SCAN_STEP(2) LRU_SCAN_STEP(4) LRU_SCAN_STEP(8)
#undef LRU_SCAN_STEP
                const float At = DPP_ROW_BCAST15(A), Bt = DPP_ROW_BCAST15(B);
                Hq[g] = g == 0 ? Bt : At * Hq[0] + Bt; }
            Hin[j] = Hq[1]; }
    }
#pragma unroll
    for (int m = 0; m < 16; ++m) { const int trow = t0 + 16 * m; const unsigned zx = zq[m].x, zy = zq[m].y;
        const float y0 = (hl[m][0] + pc[m][0] * Hin[0]) * bflo(zx), y1 = (hl[m][1] + pc[m][1] * Hin[1]) * bfhi(zx), y2 = (hl[m][2] + pc[m][2] * Hin[2]) * bflo(zy), y3 = (hl[m][3] + pc[m][3] * Hin[3]) * bfhi(zy);
        u32x2 o; o.x = pk2(y0, y1); o.y = pk2(y2, y3);
        __builtin_amdgcn_raw_buffer_store_b64(o, ry, vo_y, trow * (D * 2), 0); }
    __syncthreads();
}
__device__ __forceinline__ void p_mix(Frame& F, int l) {
    PHASE_TID(F);
    constexpr int NCONV = S / 32, NLRU = NLCH * NHEAD;
    for (int rep = 0; rep < ((PROBE_DUP & 8) ? 2 : 1); ++rep)
    for (int it = F.bid; it < NLRU; it += F.G) { PHASE_TID(F); lru_item(F, l, it); }
    for (int rep = 0; rep < ((PROBE_DUP & 16) ? 2 : 1); ++rep)
    for (int it = F.bid; it < NCONV; it += F.G) { PHASE_TID(F); conv_item(F, l, it); }
}
__device__ __forceinline__ void p_final(Frame& F) {
    PHASE_TID(F);
    const int gw = F.bid * NWAVES + F.wave, NGW = F.G * NWAVES;
    for (int m = gw; m < S; m += NGW) {
        float ss = 0.f;
#pragma unroll
        for (int p = 0; p < 32; ++p) ss += F.SSQ[p * S + m];
        const float rstd = 1.f / sqrtf(ss * (1.f / D) + RMS_EPS);
        f32x4* orow = (f32x4*)(F.out + (size_t)m * D) + F.lane; const f32x4* gr = (const f32x4*)F.final_g + F.lane;
#pragma unroll
        for (int j = 0; j < 8; ++j) orow[64 * j] = orow[64 * j] * rstd * gr[64 * j];
    }
}

constexpr int PH_PER_LAYER = 3, NPH = 1 + DEPTH * PH_PER_LAYER + 1;
struct Args { const float* in[16]; float* out; unsigned char* ws; int ph_lo, ph_hi; };
__global__ void __launch_bounds__(NTHREADS, 2) mk_fwd(Args a) {
    extern __shared__ __attribute__((aligned(16))) unsigned char lds_raw[];
    Frame F;
    F.lds = (LAS unsigned char*)lds_raw;
    F.wave = __builtin_amdgcn_readfirstlane(threadIdx.x >> 6); F.tid = opaque_tid(F.wave); F.lane = F.tid & 63; F.bid = blockIdx.x; F.G = gridDim.x; F.vc = blockIdx.x;
    F.x = a.in[0]; F.norm_g = a.in[1]; F.w_in = a.in[2]; F.cdw_w = a.in[3]; F.cdw_b = a.in[4]; F.cln_g = a.in[5]; F.cln_b = a.in[6]; F.lcw = a.in[7]; F.lcb = a.in[8];
    F.wa = a.in[9]; F.ba = a.in[10]; F.wx = a.in[11]; F.bx = a.in[12]; F.lam = a.in[13]; F.w_out = a.in[14]; F.final_g = a.in[15]; F.out = a.out;
    unsigned char* ws = a.ws;
    F.WinT = (bf16_t*)(ws + WS_WINT); F.WoutT = (bf16_t*)(ws + WS_WOUTT); F.XB = (bf16_t*)(ws + WS_XB); F.U = (bf16_t*)(ws + WS_U); F.Y = (bf16_t*)(ws + WS_Y);
    F.SSQ = (float*)(ws + WS_SSQ); F.SUM = (unsigned long long*)(ws + WS_SUM); F.WgT = (bf16_t*)(ws + WS_WG); F.ctl = (unsigned*)(ws + WS_CTL);
    volatile LAS unsigned* bst = (volatile LAS unsigned*)(F.lds + LDS_BYTES - 64);
    if (F.tid < 16) bst[F.tid] = 0u;
    __syncthreads();
    XcdBarrier bar; bar.bar = (unsigned*)(ws + WS_CTL) + CW_BAR; bar.x = 0; bar.st = bst;
    if (MK_ONE_LAUNCH) bar = xcd_barrier_post((unsigned*)(ws + WS_CTL) + CW_BAR, bst, F.wave);
    bar.wave = F.wave;
    for (int ph = a.ph_lo; ph < a.ph_hi; ++ph) {
      const int jj = (ph == 0 || ph == NPH - 1) ? -1 : (ph - 1) % PH_PER_LAYER;
      const int reps = ((PROBE_DUP & 1) && ph == 0) || ((PROBE_DUP & 2) && jj == 0) || ((PROBE_DUP & 4) && jj == 1) ? 2 : 1;
      for (int rep = 0; rep < reps; ++rep) {
        if (rep) xcd_barrier(bar);
        if (ph == 0) p_prologue(F);
        else if (ph == NPH - 1) p_final(F);
        else { const int l = (ph - 1) / PH_PER_LAYER, j = (ph - 1) % PH_PER_LAYER;
            if (j == 0) { pg8::Gemm g{F.XB, F.WinT + (size_t)l * DIN * D, S, DIN, D}; pg8::OrderRstd Sd; Sd.init(S, DIN, F.G, F.vc); Sd.ssq = F.SSQ; Sd.rtab = (LAS float*)(F.lds + pg8::RTAB_OFF); Sd.wave = F.wave;
                pg8::EpiIn E{F.U, (const LAS float*)(F.lds + pg8::RTAB_OFF)};
                pg8::gemm_phase<pg8::EpiIn, pg8::OrderRstd, true, true>(F.lds, g, Sd, E, F.wave);
                if (F.G == 256 && l + 1 < DEPTH && F.vc >= 128) { PHASE_TID(F); convert_layer(F, l + 1, (F.vc - 128) * NWAVES + F.wave, 128 * NWAVES); } }
            else if (j == 1) p_mix(F, l);
            else { pg8::Gemm g{F.Y, F.WoutT + (size_t)l * D * D, S, D, D}; pg8::StaticOrder Sd; Sd.init(S, D, F.G, F.vc);
                pg8::EpiOut E{l == DEPTH - 1 ? F.out : nullptr, F.XB, F.SSQ};
                pg8::gemm_phase<pg8::EpiOut, pg8::StaticOrder, true, true>(F.lds, g, Sd, E, F.wave); }
        }
      }
        if (ph + 1 < a.ph_hi) xcd_barrier(bar);
        if (MK_ONE_LAUNCH && ph == 0 && F.G == 256) {
            if (opaque_tid(F.wave) == 0) { bool ok = true;
                for (unsigned j = 0; j < 16; ++j) { const unsigned cnt = xb_ld(&bar.bar[XB_XCNT(j)]); ok = ok && (cnt == (j < 8 ? 32u : 0u)); }
                bst[4] = ok ? (bst[2] * 8u + bar.x) : (unsigned)F.bid; }
            __syncthreads();
            F.vc = __builtin_amdgcn_readfirstlane((int)bst[4]);
        }
    }
}

extern "C" void kernel_launch(void* const* d_in, const int* in_sizes, int n_in, void* d_out, int out_size, void* d_ws, size_t ws_size, hipStream_t stream) {
    static int grid = 0;
    if (grid == 0) {
        if (n_in != 16 || in_sizes[0] != S * D || out_size != S * D || ws_size < WS_END) { fprintf(stderr, "kernel_launch: unexpected shapes (n_in %d, in0 %d, out %d, ws %zu)\n", n_in, n_in > 0 ? in_sizes[0] : -1, out_size, ws_size); grid = -1; return; }
        int dev = 0, cus = 0, per_cu = 0;
        if (hipGetDevice(&dev) != hipSuccess || hipDeviceGetAttribute(&cus, hipDeviceAttributeMultiprocessorCount, dev) != hipSuccess) { grid = -1; return; }
        if (hipFuncSetAttribute((const void*)mk_fwd, hipFuncAttributeMaxDynamicSharedMemorySize, LDS_BYTES) != hipSuccess) { fprintf(stderr, "kernel_launch: hipFuncSetAttribute failed\n"); grid = -1; return; }
        if (hipOccupancyMaxActiveBlocksPerMultiprocessor(&per_cu, (const void*)mk_fwd, NTHREADS, LDS_BYTES) != hipSuccess || per_cu < 1) fprintf(stderr, "kernel_launch: occupancy query says %d per CU\n", per_cu);
        (void)hipGetLastError();
        grid = cus;
    }
    if (grid < 0) return;
    (void)hipMemsetAsync((char*)d_ws + WS_CTL, 0, CTL_ZERO_BYTES, stream);
    Args a{};
    for (int i = 0; i < 16; ++i) a.in[i] = (const float*)d_in[i];
    a.out = (float*)d_out; a.ws = (unsigned char*)d_ws;
#if MK_ONE_LAUNCH
    a.ph_lo = 0; a.ph_hi = NPH;
    hipLaunchKernelGGL(mk_fwd, dim3(grid), dim3(NTHREADS), LDS_BYTES, stream, a);
#else
    for (int ph = 0; ph < NPH; ++ph) { a.ph_lo = ph; a.ph_hi = ph + 1; hipLaunchKernelGGL(mk_fwd, dim3(grid), dim3(NTHREADS), LDS_BYTES, stream, a); }
#endif
}
```

```cpp
#include <hip/hip_runtime.h>
#include <cstdio>
#include <cstdint>

#ifndef MK_ONE_LAUNCH
#define MK_ONE_LAUNCH 1
#endif

#ifndef PROBE_DUP
#define PROBE_DUP 0
#endif
#define LAS __attribute__((address_space(3)))
#define GAS __attribute__((address_space(1)))
typedef unsigned short bf16_t;
typedef short bf16x8 __attribute__((ext_vector_type(8)));
typedef float f32x4 __attribute__((ext_vector_type(4)));
typedef float f32x2 __attribute__((ext_vector_type(2)));
typedef unsigned u32x4 __attribute__((ext_vector_type(4)));
typedef unsigned u32x2 __attribute__((ext_vector_type(2)));

constexpr int S = 8192, D = 2048, DEPTH = 4, DC = 1024, DL = 1024, DIN = 5120, NHEAD = 8, HD = 128, CW = 31, LW = 4;
constexpr int UW = 4096;
constexpr float RMS_EPS = 1e-6f, LN_EPS = 1e-5f;
constexpr int NTHREADS = 512, NWAVES = 8;
constexpr int LDS_BYTES = 147456;
constexpr int LCH = 256, NLCH = S / LCH;
constexpr int XROW = 272;
constexpr int CW_BAR = 4096, CW_LRU = 16384;

constexpr size_t MiB = 1u << 20;
constexpr size_t WS_CTL = 0, CTL_ZERO_BYTES = 1 * MiB;
constexpr size_t WS_WINT = 2 * MiB;
constexpr size_t WS_WOUTT = 82 * MiB;
constexpr size_t WS_XB = 114 * MiB;
constexpr size_t WS_U = 146 * MiB;
constexpr size_t WS_Y = 210 * MiB;
constexpr size_t WS_SSQ = 242 * MiB;
constexpr size_t WS_SUM = 243 * MiB;
constexpr size_t WS_WG = 244 * MiB;
constexpr size_t WS_END = 246 * MiB;

__device__ __forceinline__ int opaque_tid(int wave);
#define MAKE_RSRC(p, bytes) __builtin_amdgcn_make_buffer_rsrc((void*)(p), 0, (int)(bytes), 0x00020000)
__device__ __forceinline__ unsigned f2bf(float f) { unsigned u = __builtin_bit_cast(unsigned, f); return (u + 0x7fffu + ((u >> 16) & 1u)) >> 16; }
__device__ __forceinline__ unsigned pk2(float lo, float hi) { return f2bf(lo) | (f2bf(hi) << 16); }
__device__ __forceinline__ float bflo(unsigned w) { return __builtin_bit_cast(float, w << 16); }
__device__ __forceinline__ float bfhi(unsigned w) { return __builtin_bit_cast(float, w & 0xffff0000u); }
__device__ __forceinline__ float u2f(unsigned u) { return __builtin_bit_cast(float, u); }
__device__ __forceinline__ float bf2f(bf16_t b) { return __builtin_bit_cast(float, (unsigned)b << 16); }
__device__ __forceinline__ float sigm(float x) { return 1.f / (1.f + __expf(-x)); }
__device__ __forceinline__ float siluf(float x) { return x * sigm(x); }
__device__ __forceinline__ float wave_sum(float v) {
#pragma unroll
    for (int o = 1; o < 64; o <<= 1) v += __shfl_xor(v, o);
    return v;
}
__device__ __forceinline__ float neg_expm1(float x) {
    float p = 1.f + x * (1.f / 8.f); p = 1.f + x * (1.f / 7.f) * p; p = 1.f + x * (1.f / 6.f) * p; p = 1.f + x * (1.f / 5.f) * p; p = 1.f + x * 0.25f * p; p = 1.f + x * (1.f / 3.f) * p; p = 1.f + x * 0.5f * p;
    const float big = 1.f - __builtin_amdgcn_exp2f(x * 1.44269504089f);
    return x > -0.35f ? -x * p : big;
}
__device__ __forceinline__ float log_sigmoid(float x) { return fminf(x, 0.f) - log1pf(expf(-fabsf(x))); }
__host__ __device__ __forceinline__ int src_col(int np) { if (np < 2048) { const int p = np >> 8, j = np & 255; return j < 128 ? 128 * p + j : 1024 + 128 * p + (j - 128); } return np; }

#define XB_TMO      128
#define XB_XCNT(j)  (256  + 64 * (j))
#define XB_XSUB(j)  (1280 + 64 * (j))
#define XB_XGEN(j)  (2304 + 64 * (j))
#define XB_TOP      3328
#define XB_TOPGEN   3392
#define XCD_BAR_WORDS 3456
#define XB_SPIN_CAP (1u << 18)
__device__ __forceinline__ unsigned xb_ld(unsigned* p)              { return __hip_atomic_load(p, __ATOMIC_RELAXED, __HIP_MEMORY_SCOPE_AGENT); }
__device__ __forceinline__ unsigned xb_add(unsigned* p, unsigned v) { return __hip_atomic_fetch_add(p, v, __ATOMIC_RELAXED, __HIP_MEMORY_SCOPE_AGENT); }
__device__ __forceinline__ unsigned xb_xcc_id() { return (unsigned)__builtin_amdgcn_s_getreg((3 << 11) | 20) & 0xFu; }
#define XB_SPIN(cond, bar) do { unsigned _sp = 0; while (cond) { __builtin_amdgcn_s_sleep(1); \
    if ((++_sp & 255u) == 0u) { if (xb_ld(&(bar)[XB_TMO])) break; if (_sp > XB_SPIN_CAP) { atomicAdd(&(bar)[XB_TMO], 1u); break; } } } } while (0)
struct XcdBarrier { unsigned* bar; unsigned x; volatile LAS unsigned* st; int wave; };
__device__ __forceinline__ XcdBarrier xcd_barrier_post(unsigned* bar, volatile LAS unsigned* st, int wave) {
    XcdBarrier b; b.bar = bar; b.x = xb_xcc_id(); b.st = st; b.wave = wave;
    if (opaque_tid(wave) == 0) st[2] = xb_add(&bar[XB_XCNT(b.x)], 1u);
    return b;
}
__device__ __forceinline__ void xcd_barrier_complete(unsigned* bar, unsigned x, unsigned& nloc, unsigned& nx) {
    const unsigned G = gridDim.x * gridDim.y * gridDim.z;
    unsigned sum, cnt, mine, sp = 0u;
    for (;;) {
        sum = 0u; cnt = 0u; mine = 0u;
#pragma unroll
        for (unsigned j = 0; j < 16; ++j) { const unsigned c = xb_ld(&bar[XB_XCNT(j)]); sum += c; cnt += (c > 0u) ? 1u : 0u; mine = (j == x) ? c : mine; }
        if (sum == G) break;
        __builtin_amdgcn_s_sleep(1);
        if ((++sp & 255u) == 0u) { if (xb_ld(&bar[XB_TMO])) break; if (sp > XB_SPIN_CAP) { atomicAdd(&bar[XB_TMO], 1u); break; } }
    }
    nloc = mine > 0u ? mine : 1u; nx = cnt > 0u ? cnt : 1u;
}
__device__ __forceinline__ void xcd_barrier(const XcdBarrier& b) {
    asm volatile("s_waitcnt vmcnt(0)" ::: "memory");
    __syncthreads();
    if (opaque_tid(b.wave) == 0) {
        unsigned* bar = b.bar;
        __builtin_amdgcn_s_waitcnt(0);
        unsigned nloc = b.st[0], nx = b.st[1];
        if (nloc == 0u) { xcd_barrier_complete(bar, b.x, nloc, nx); b.st[0] = nloc; b.st[1] = nx; }
        const unsigned old = xb_add(&bar[XB_XSUB(b.x)], 1u);
        const unsigned gen = old / nloc;
        if (old + 1u == (gen + 1u) * nloc) {
            __builtin_amdgcn_fence(__ATOMIC_RELEASE, "agent");
            asm volatile("s_waitcnt vmcnt(0)" ::: "memory");
            const unsigned og = xb_add(&bar[XB_TOP], 1u);
            const unsigned tg = og / nx;
            if (og + 1u == (tg + 1u) * nx) xb_add(&bar[XB_TOPGEN], 1u);
            else XB_SPIN(xb_ld(&bar[XB_TOPGEN]) == tg, bar);
            __builtin_amdgcn_fence(__ATOMIC_ACQUIRE, "agent");
            xb_add(&bar[XB_XGEN(b.x)], 1u);
            asm volatile("s_waitcnt vmcnt(0)" ::: "memory");
        } else {
            XB_SPIN(xb_ld(&bar[XB_XGEN(b.x)]) == gen, bar);
            __builtin_amdgcn_fence(__ATOMIC_ACQUIRE, "agent");
            asm volatile("s_waitcnt vmcnt(0)" ::: "memory");
        }
    }
    __syncthreads();
}

struct Frame {
    LAS unsigned char* lds;
    int tid, lane, wave, bid, G, vc;
    const float *x, *norm_g, *w_in, *cdw_w, *cdw_b, *cln_g, *cln_b, *lcw, *lcb, *wa, *ba, *wx, *bx, *lam, *w_out, *final_g;
    float* out;
    bf16_t *WinT, *WoutT, *XB, *U, *Y;
    float *SSQ; unsigned long long* SUM; bf16_t* WgT; unsigned* ctl;
};

namespace pg8 {
#define PG8_LAS __attribute__((address_space(3)))
typedef unsigned short bf16_t;
typedef short bf16x8 __attribute__((ext_vector_type(8)));
typedef float f32x4 __attribute__((ext_vector_type(4)));
typedef unsigned u32x4 __attribute__((ext_vector_type(4)));
constexpr int BM = 256, BK = 64, HALF = 128, HTB = HALF * BK * 2  , STAGE_BYTES = 8 * HTB, NXCD = 8, WGM = 8;

__host__ __device__ __forceinline__ int lds_byte(int r, int c) { const int st = (r >> 4) * 2 + (c >> 5), rr = r & 15, cc = c & 31, ob = rr * 64 + cc * 2; return st * 1024 + (ob ^ (((ob >> 9) & 1) << 5)); }
__host__ __device__ __forceinline__ void stage_rc(int b, int& R, int& C) { const int st = b / 1024, sb = b % 1024, swz = sb ^ (((sb >> 9) & 1) << 5); R = (st >> 1) * 16 + swz / 64; C = (st & 1) * 32 + (swz % 64) / 2; }
__host__ __device__ __forceinline__ int perm32(int rho) { const int n = rho >> 4, i = rho & 15; return 8 * (i >> 2) + 4 * n + (i & 3); }

struct Unit { int pm, pn; };
struct Gemm { const bf16_t* A; const bf16_t* Bt; int M, N, K; };

struct StaticOrder {
    int nM, nN, nwg, G, c;
    __host__ __device__ void init(int M, int N, int G_, int c_) { nM = M / BM; nN = N / BM; nwg = nM * nN; G = G_; c = c_; }
    __host__ __device__ bool next(int i, Unit& u) const {
        const long L = (long)i * G + c; if (L >= nwg) return false;
        int wgid = (int)L; { const int q = nwg / NXCD, r = nwg % NXCD, xcd = wgid % NXCD, off = wgid / NXCD; wgid = (xcd < r ? xcd * (q + 1) : r * (q + 1) + (xcd - r) * q) + off; }
        const int nig = WGM * nN, gid = wgid / nig, fm = gid * WGM, gsz = (nM - fm) < WGM ? (nM - fm) : WGM;
        u.pm = fm + ((wgid % nig) % gsz); u.pn = (wgid % nig) / gsz; return true;
    }
    __device__ __forceinline__ void a_ready(const Unit&, int) const {}
    __device__ __forceinline__ void done(const Unit&) const {}
};


__device__ __forceinline__ unsigned cvt_pk_bf16(float lo, float hi) { unsigned r; asm volatile("v_cvt_pk_bf16_f32 %0, %1, %2" : "=v"(r) : "v"(lo), "v"(hi)); return r; }
__device__ __forceinline__ void st16_wt(void* p, u32x4 v) { asm volatile("global_store_dwordx4 %0, %1, off sc1\n\ts_nop 1" :: "v"(p), "v"(v) : "memory"); }
__device__ __forceinline__ float fsigm(float x) { return __builtin_amdgcn_rcpf(1.f + __builtin_amdgcn_exp2f(x * -1.44269504089f)); }
constexpr int RTAB_OFF = STAGE_BYTES;

struct OrderRstd : StaticOrder {
    const float* ssq; PG8_LAS float* rtab; int wave;
    __device__ __forceinline__ void a_ready(const Unit& u, int ui) const {
        const int t_ = opaque_tid(wave), wid = wave, lane = t_ & 63, rl = wid * 32 + (lane & 31), half = lane >> 5;
        const float* p = ssq + (size_t)(half * 16) * 8192 + u.pm * BM + rl; float s = 0.f;
#pragma unroll
        for (int q = 0; q < 16; ++q) s += p[(size_t)q * 8192];
        s += __shfl_xor(s, 32);
        if (lane < 32) rtab[(ui & 1) * 256 + rl] = 1.0f / sqrtf(s * (1.0f / 2048.0f) + 1e-6f);
    }
};
struct EpiIn {
    static constexpr bool PERM = true, AFTER_DRAIN = false;
    bf16_t* U; const PG8_LAS float* rtab;
    __device__ __forceinline__ void operator()(const f32x4 (&acc)[2][2][4][2], const Unit& u, int wr, int wc, int fr, int fq, int ui) const {
        const PG8_LAS float* rt = rtab + (ui & 1) * 256 + wr * 64 + fr;
        if (u.pn < 8) {
            bf16_t* base = U + (size_t)(u.pm * BM + wr * 64 + fr) * 4096 + 128 * u.pn + wc * 32 + 8 * fq;
#pragma unroll
            for (int ai = 0; ai < 2; ++ai)
#pragma unroll
                for (int m = 0; m < 4; ++m) { const float rs = rt[ai * HALF + m * 16];
                    const f32x4 v0 = acc[ai][0][m][0] * rs, v1 = acc[ai][0][m][1] * rs, g0 = acc[ai][1][m][0] * rs, g1 = acc[ai][1][m][1] * rs;
                    u32x4 w; w.x = cvt_pk_bf16(v0[0] * fsigm(g0[0]), v0[1] * fsigm(g0[1])); w.y = cvt_pk_bf16(v0[2] * fsigm(g0[2]), v0[3] * fsigm(g0[3]));
                    w.z = cvt_pk_bf16(v1[0] * fsigm(g1[0]), v1[1] * fsigm(g1[1])); w.w = cvt_pk_bf16(v1[2] * fsigm(g1[2]), v1[3] * fsigm(g1[3]));
                    st16_wt(base + (size_t)(ai * HALF + m * 16) * 4096, w); }
        } else {
            const bool act = (u.pn < 12) || (u.pn >= 16);
            bf16_t* base = U + (size_t)(u.pm * BM + wr * 64 + fr) * 4096 + (256 * u.pn - 1024) + wc * 32 + 8 * fq;
#pragma unroll
            for (int ai = 0; ai < 2; ++ai)
#pragma unroll
                for (int m = 0; m < 4; ++m) { const float rs = rt[ai * HALF + m * 16];
#pragma unroll
                    for (int bj = 0; bj < 2; ++bj) { f32x4 v0 = acc[ai][bj][m][0] * rs, v1 = acc[ai][bj][m][1] * rs;
                        if (act) {
#pragma unroll
                            for (int e = 0; e < 4; ++e) { v0[e] = v0[e] * fsigm(v0[e]); v1[e] = v1[e] * fsigm(v1[e]); } }
                        u32x4 w; w.x = cvt_pk_bf16(v0[0], v0[1]); w.y = cvt_pk_bf16(v0[2], v0[3]); w.z = cvt_pk_bf16(v1[0], v1[1]); w.w = cvt_pk_bf16(v1[2], v1[3]);
                        st16_wt(base + (size_t)(ai * HALF + m * 16) * 4096 + bj * HALF, w); } }
        }
    }
};
struct EpiOut {
    static constexpr bool PERM = true, AFTER_DRAIN = false;
    float* out; bf16_t* XB; float* ssq;
    __device__ __forceinline__ void operator()(const f32x4 (&acc)[2][2][4][2], const Unit& u, int wr, int wc, int fr, int fq, int) const {
#pragma unroll
        for (int ai = 0; ai < 2; ++ai) {
            u32x4 xo[4][2];
#pragma unroll
            for (int m = 0; m < 4; ++m)
#pragma unroll
                for (int bj = 0; bj < 2; ++bj) xo[m][bj] = *(const u32x4*)(XB + (size_t)(u.pm * BM + ai * HALF + wr * 64 + m * 16 + fr) * 2048 + u.pn * BM + wc * 32 + 8 * fq + bj * HALF);
#pragma unroll
            for (int m = 0; m < 4; ++m) { const int row = u.pm * BM + ai * HALF + wr * 64 + m * 16 + fr; const size_t off = (size_t)row * 2048 + u.pn * BM + wc * 32 + 8 * fq; float s = 0.f;
#pragma unroll
                for (int bj = 0; bj < 2; ++bj) { const u32x4 q = xo[m][bj];
                    const f32x4 x0 = (f32x4){__builtin_bit_cast(float, q.x << 16), __builtin_bit_cast(float, q.x & 0xffff0000u), __builtin_bit_cast(float, q.y << 16), __builtin_bit_cast(float, q.y & 0xffff0000u)};
                    const f32x4 x1 = (f32x4){__builtin_bit_cast(float, q.z << 16), __builtin_bit_cast(float, q.z & 0xffff0000u), __builtin_bit_cast(float, q.w << 16), __builtin_bit_cast(float, q.w & 0xffff0000u)};
                    const f32x4 v0 = x0 + acc[ai][bj][m][0], v1 = x1 + acc[ai][bj][m][1];
                    if (out) { *(f32x4*)(out + off + bj * HALF) = v0; *(f32x4*)(out + off + bj * HALF + 4) = v1; }
                    else { u32x4 w; w.x = cvt_pk_bf16(v0[0], v0[1]); w.y = cvt_pk_bf16(v0[2], v0[3]); w.z = cvt_pk_bf16(v1[0], v1[1]); w.w = cvt_pk_bf16(v1[2], v1[3]);
                        st16_wt(XB + off + bj * HALF, w); }
                    s += (v0[0] * v0[0] + v0[1] * v0[1]) + (v0[2] * v0[2] + v0[3] * v0[3]) + (v1[0] * v1[0] + v1[1] * v1[1]) + (v1[2] * v1[2] + v1[3] * v1[3]); }
                s += __shfl_xor(s, 16); s += __shfl_xor(s, 32);
                if (fq == 0) ssq[(size_t)(u.pn * 4 + wc) * 8192 + row] = s; }
            asm volatile("" ::: "memory"); }
    }
};

template <class Epi, class Sched, bool ALIGN_EPI = false, bool SP2 = false>
__device__ __forceinline__ void gemm_phase(PG8_LAS unsigned char* lds, const Gemm g, const Sched& S, const Epi& E, const int wave_in) {
    const int tid = opaque_tid(wave_in), wid = wave_in,
        lane = tid & 63, wr = wid >> 2, wc = wid & 3, fr = lane & 15, fq = lane >> 4;
    const int K = g.K, nt = K / BK;
    unsigned voffA[2], voffB[2];
#pragma unroll
    for (int i = 0; i < 2; ++i) { int R, C; stage_rc(tid * 16 + i * 8192, R, C); const int Rb = Epi::PERM ? ((R & ~31) + perm32(R & 31)) : R;
        voffA[i] = (unsigned)(R * K + C) * 2u; voffB[i] = (unsigned)(Rb * K + C) * 2u; }
    const size_t kstep = (size_t)(BK * 2);
    const size_t hstep = (size_t)HALF * K * 2;
    const size_t tstep = 2 * hstep;
    const unsigned ldsw = (unsigned)wid * 1024u;
    const int aoff = lds_byte(wr * 64 + fr, fq * 8), boff = lds_byte(wc * 32 + fr, fq * 8);
#define PG8_SA(b, h) (((b) * 2 + (h)) * HTB)
#define PG8_SB(b, h) ((4 + (b) * 2 + (h)) * HTB)
#define PG8_STAGE(bufoff, gbase, voff) do { _Pragma("unroll") for (int _i = 0; _i < 2; ++_i) \
        __builtin_amdgcn_global_load_lds((const unsigned*)((const char*)(gbase) + (voff)[_i]), (PG8_LAS unsigned*)(lds + (bufoff) + ldsw + _i * 8192), 16, 0, 0); } while (0)
#define PG8_LDA(dst, b, h) do { _Pragma("unroll") for (int m = 0; m < 4; ++m) _Pragma("unroll") for (int k = 0; k < 2; ++k) dst[m][k] = *(const PG8_LAS bf16x8*)(lds + PG8_SA(b, h) + aoff + m * 2048 + k * 1024); } while (0)
#define PG8_LDB(dst, b, h) do { _Pragma("unroll") for (int n = 0; n < 2; ++n) _Pragma("unroll") for (int k = 0; k < 2; ++k) dst[n][k] = *(const PG8_LAS bf16x8*)(lds + PG8_SB(b, h) + boff + n * 2048 + k * 1024); } while (0)
#define PG8_MMA(ai, bj, At, Bt) do { __builtin_amdgcn_s_setprio(1); _Pragma("unroll") for (int m = 0; m < 4; ++m) _Pragma("unroll") for (int n = 0; n < 2; ++n) _Pragma("unroll") for (int k = 0; k < 2; ++k) \
        acc[ai][bj][m][n] = __builtin_amdgcn_mfma_f32_16x16x32_bf16(Bt[n][k], At[m][k], acc[ai][bj][m][n], 0, 0, 0); __builtin_amdgcn_s_setprio(0); } while (0)
#define PG8_WAIT_V(n) asm volatile("s_waitcnt vmcnt(" #n ")" ::: "memory")
#define PG8_WAIT_L(n) asm volatile("s_waitcnt lgkmcnt(" #n ")" ::: "memory")
#define PG8_BAR __builtin_amdgcn_s_barrier()
#define PG8_SCHED __builtin_amdgcn_sched_barrier(0)
    Unit cur, nxt; int ui = 0;
    if (!S.next(0, cur)) return;
    f32x4 acc[2][2][4][2];
#pragma unroll
    for (int a = 0; a < 2; ++a)
#pragma unroll
        for (int b = 0; b < 2; ++b)
#pragma unroll
            for (int m = 0; m < 4; ++m)
#pragma unroll
                for (int n = 0; n < 2; ++n) acc[a][b][m][n] = (f32x4){0.f, 0.f, 0.f, 0.f};
    bf16x8 At[4][2], B0[2][2], B1[2][2];
    const char* cA = (const char*)g.A + (size_t)cur.pm * tstep; const char* cB = (const char*)g.Bt + (size_t)cur.pn * tstep;
    S.a_ready(cur, 0);
    if constexpr (SP2) {
        PG8_STAGE(PG8_SB(0, 0), cB, voffB); PG8_STAGE(PG8_SB(0, 1), cB + hstep, voffB); PG8_STAGE(PG8_SA(0, 0), cA, voffA); PG8_STAGE(PG8_SA(0, 1), cA + hstep, voffA);
        if (wr == 1) PG8_BAR;
        PG8_WAIT_V(2); PG8_BAR;
        PG8_STAGE(PG8_SB(1, 0), cB + kstep, voffB); PG8_STAGE(PG8_SA(1, 0), cA + kstep, voffA); PG8_STAGE(PG8_SB(1, 1), cB + hstep + kstep, voffB);
        PG8_WAIT_V(6); PG8_BAR;
    } else {
        PG8_STAGE(PG8_SB(0, 0), cB, voffB); PG8_STAGE(PG8_SA(0, 0), cA, voffA); PG8_STAGE(PG8_SB(0, 1), cB + hstep, voffB); PG8_STAGE(PG8_SA(0, 1), cA + hstep, voffA);
        if (wr == 1) PG8_BAR;
        PG8_WAIT_V(4); PG8_BAR;
        PG8_STAGE(PG8_SB(1, 0), cB + kstep, voffB); PG8_STAGE(PG8_SA(1, 0), cA + kstep, voffA); PG8_STAGE(PG8_SB(1, 1), cB + hstep + kstep, voffB);
        PG8_WAIT_V(6); PG8_BAR;
    }
    for (;;) {
        const bool has_next = S.next(ui + 1, nxt);
        const char* nA = has_next ? (const char*)g.A + (size_t)nxt.pm * tstep : cA; const char* nB = has_next ? (const char*)g.Bt + (size_t)nxt.pn * tstep : cB;
        for (int t = 0; t < nt; t += 2) {
            const bool last = (t == nt - 2);
            const char* a1 = cA + (size_t)(t + 1) * kstep;
            const char* a2 = last ? nA : cA + (size_t)(t + 2) * kstep; const char* b2 = last ? nB : cB + (size_t)(t + 2) * kstep;
            const char* a3 = a2 + kstep; const char* b3 = b2 + kstep;
            if (last && has_next) S.a_ready(nxt, ui + 1);
            if constexpr (SP2) {
            PG8_LDB(B0, 0, 0); PG8_LDB(B1, 0, 1); PG8_SCHED; PG8_LDA(At, 0, 0); PG8_STAGE(PG8_SA(1, 1), a1 + hstep, voffA);
            PG8_WAIT_V(8); PG8_WAIT_L(0); PG8_BAR; PG8_MMA(0, 0, At, B0); PG8_MMA(0, 1, At, B1); PG8_BAR; PG8_SCHED;
            PG8_LDA(At, 0, 1); PG8_STAGE(PG8_SB(0, 0), b2, voffB); PG8_STAGE(PG8_SB(0, 1), b2 + hstep, voffB); PG8_STAGE(PG8_SA(0, 0), a2, voffA);
            PG8_WAIT_V(8); PG8_WAIT_L(0); PG8_BAR; PG8_MMA(1, 0, At, B0); PG8_MMA(1, 1, At, B1); PG8_BAR; PG8_SCHED;
            PG8_LDB(B0, 1, 0); PG8_LDB(B1, 1, 1); PG8_SCHED; PG8_LDA(At, 1, 0); PG8_STAGE(PG8_SA(0, 1), a2 + hstep, voffA);
            PG8_WAIT_V(8); PG8_WAIT_L(0); PG8_BAR; PG8_MMA(0, 0, At, B0); PG8_MMA(0, 1, At, B1); PG8_BAR; PG8_SCHED;
            PG8_LDA(At, 1, 1); PG8_STAGE(PG8_SB(1, 0), b3, voffB); PG8_STAGE(PG8_SB(1, 1), b3 + hstep, voffB); PG8_STAGE(PG8_SA(1, 0), a3, voffA);
            PG8_WAIT_V(8); PG8_WAIT_L(0); PG8_BAR; PG8_MMA(1, 0, At, B0); PG8_MMA(1, 1, At, B1); PG8_BAR; PG8_SCHED;
            } else {
            PG8_LDB(B0, 0, 0); PG8_SCHED; PG8_LDA(At, 0, 0); PG8_STAGE(PG8_SA(1, 1), a1 + hstep, voffA);
            PG8_WAIT_L(8); PG8_BAR; PG8_WAIT_L(0); PG8_MMA(0, 0, At, B0); PG8_BAR; PG8_SCHED;
            PG8_LDB(B1, 0, 1); PG8_STAGE(PG8_SB(0, 0), b2, voffB);
            PG8_BAR; PG8_WAIT_L(0); PG8_MMA(0, 1, At, B1); PG8_BAR;
            PG8_LDA(At, 0, 1); PG8_STAGE(PG8_SA(0, 0), a2, voffA);
            PG8_BAR; PG8_WAIT_L(0); PG8_MMA(1, 0, At, B0); PG8_BAR; PG8_SCHED;
            PG8_STAGE(PG8_SB(0, 1), b2 + hstep, voffB);
            PG8_WAIT_V(6); PG8_BAR; PG8_MMA(1, 1, At, B1); PG8_BAR;
            PG8_LDB(B0, 1, 0); PG8_SCHED; PG8_LDA(At, 1, 0); PG8_STAGE(PG8_SA(0, 1), a2 + hstep, voffA);
            PG8_WAIT_L(8); PG8_BAR; PG8_WAIT_L(0); PG8_MMA(0, 0, At, B0); PG8_BAR; PG8_SCHED;
            PG8_LDB(B1, 1, 1); PG8_STAGE(PG8_SB(1, 0), b3, voffB);
            PG8_BAR; PG8_WAIT_L(0); PG8_MMA(0, 1, At, B1); PG8_BAR;
            PG8_LDA(At, 1, 1); PG8_STAGE(PG8_SA(1, 0), a3, voffA);
            PG8_BAR; PG8_WAIT_L(0); PG8_MMA(1, 0, At, B0); PG8_BAR; PG8_SCHED;
            PG8_STAGE(PG8_SB(1, 1), b3 + hstep, voffB);
            PG8_WAIT_V(6); PG8_BAR; PG8_MMA(1, 1, At, B1); PG8_BAR;
            }
        }
        if constexpr (ALIGN_EPI) { if (wr == 0) PG8_BAR; }
        if constexpr (!Epi::AFTER_DRAIN) { E(acc, cur, wr, wc, fr, fq, ui); S.done(cur); }
        if (!has_next) break;
#pragma unroll
        for (int a = 0; a < 2; ++a)
#pragma unroll
            for (int b = 0; b < 2; ++b)
#pragma unroll
                for (int m = 0; m < 4; ++m)
#pragma unroll
                    for (int n = 0; n < 2; ++n) acc[a][b][m][n] = (f32x4){0.f, 0.f, 0.f, 0.f};
        cur = nxt; cA = nA; cB = nB; ++ui;
        if constexpr (ALIGN_EPI) { if (wr == 1) PG8_BAR; }
    }
    PG8_WAIT_V(0);
    if constexpr (!ALIGN_EPI) { if (wr == 0) PG8_BAR; }
    PG8_BAR;
    if constexpr (Epi::AFTER_DRAIN) { E.fused(acc, cur, wr, wc, fr, fq, lds, wid, lane); S.done(cur); }
#undef PG8_SA
#undef PG8_SB
#undef PG8_STAGE
#undef PG8_LDA
#undef PG8_LDB
#undef PG8_MMA
#undef PG8_WAIT_V
#undef PG8_WAIT_L
#undef PG8_BAR
#undef PG8_SCHED
}
}

__device__ __forceinline__ int opaque_tid(int wave) { int ln = __builtin_amdgcn_mbcnt_hi(~0u, __builtin_amdgcn_mbcnt_lo(~0u, 0u)); asm volatile("" : "+v"(ln)); return wave * 64 + ln; }
#define PHASE_TID(F) do { const int _t = opaque_tid((F).wave); (F).tid = _t; (F).lane = _t & 63; } while (0)
__device__ __forceinline__ void transpose_item(const float* W, int K, int N, bf16_t* WT, int dst_row0, int src_col0, const float* gk, LAS float* scr, int k0, int lane) {
    f32x4 v[16]; const int r0 = lane >> 4, c4 = (lane & 15) * 4;
    const float* wp = W + (size_t)(k0 + r0) * N + src_col0 + c4;
#pragma unroll
    for (int i = 0; i < 16; ++i) v[i] = *(const f32x4*)(wp + (size_t)(4 * i) * N);
    if (gk) {
#pragma unroll
        for (int i = 0; i < 16; ++i) v[i] = v[i] * gk[k0 + r0 + 4 * i]; }
#pragma unroll
    for (int i = 0; i < 16; ++i) { LAS float* d = scr + (r0 + 4 * i) * 65 + c4; d[0] = v[i][0]; d[1] = v[i][1]; d[2] = v[i][2]; d[3] = v[i][3]; }
    asm volatile("s_waitcnt lgkmcnt(0)" ::: "memory");
    const int c = lane & 7;
#pragma unroll
    for (int j = 0; j < 8; ++j) { const int n = (lane >> 3) + 8 * j; const LAS float* sp = scr + (8 * c) * 65 + n;
        u32x4 o; o.x = pk2(sp[0 * 65], sp[1 * 65]); o.y = pk2(sp[2 * 65], sp[3 * 65]); o.z = pk2(sp[4 * 65], sp[5 * 65]); o.w = pk2(sp[6 * 65], sp[7 * 65]);
        *(u32x4*)(WT + (size_t)(dst_row0 + n) * K + k0 + 8 * c) = o; }
    asm volatile("s_waitcnt lgkmcnt(0)" ::: "memory");
}
__device__ __forceinline__ void convert_layer(Frame& F, int l, int gw, int NGW) {
    LAS float* scr = (LAS float*)(F.lds + F.wave * 17408);
    constexpr int I_IN = (D / 64) * (DIN / 64), I_OUT = (D / 64) * (D / 64), I_G = NHEAD * 2 * (HD / 64) * (HD / 64), I_L = I_IN + I_OUT + I_G;
    for (int it = gw; it < I_L; it += NGW) {
        int r = it;
        if (r >= I_IN + I_OUT) { r -= I_IN + I_OUT; const int hg = r >> 2, kb = (r >> 1) & 1, nb = r & 1, h = hg >> 1, gsel = hg & 1;
            transpose_item((gsel ? F.wx : F.wa) + (size_t)(l * NHEAD + h) * HD * HD, HD, HD, F.WgT + (size_t)((l * NHEAD + h) * 2 + gsel) * HD * HD, 64 * nb, 64 * nb, nullptr, scr, 64 * kb, F.lane);
        } else if (r < I_IN) { const int kb = r / (DIN / 64), nb = r % (DIN / 64);
            transpose_item(F.w_in + (size_t)l * D * DIN, D, DIN, F.WinT + (size_t)l * DIN * D, 64 * nb, src_col(64 * nb), F.norm_g + l * D, scr, 64 * kb, F.lane);
        } else { r -= I_IN; const int kb = r / (D / 64), nb = r % (D / 64);
            transpose_item(F.w_out + (size_t)l * D * D, D, D, F.WoutT + (size_t)l * D * D, 64 * nb, 64 * nb, nullptr, scr, 64 * kb, F.lane); }
    }
}
__device__ __forceinline__ void p_prologue(Frame& F) {
    PHASE_TID(F);
    const int gw = F.bid * NWAVES + F.wave, NGW = F.G * NWAVES;
    convert_layer(F, 0, gw, NGW);
    if (!(F.G == 256)) { for (int l = 1; l < DEPTH; ++l) convert_layer(F, l, gw, NGW); }
    for (int m = gw; m < S; m += NGW) {
        const f32x4* xr = (const f32x4*)(F.x + (size_t)m * D) + F.lane; u32x2* ob = (u32x2*)(F.XB + (size_t)m * D) + F.lane; float s = 0.f;
#pragma unroll
        for (int j = 0; j < 8; ++j) { const f32x4 v = xr[64 * j]; s += (v.x * v.x + v.y * v.y) + (v.z * v.z + v.w * v.w); u32x2 w; w.x = pk2(v.x, v.y); w.y = pk2(v.z, v.w); ob[64 * j] = w; }
        s = wave_sum(s);
        if (F.lane < 32) F.SSQ[F.lane * S + m] = F.lane == 0 ? s : 0.f;
    }
}

#define DPP_MOV(x, ctrl) __builtin_bit_cast(float, __builtin_amdgcn_update_dpp(0, __builtin_bit_cast(int, (float)(x)), (ctrl), 0xf, 0xf, true))
template <int NV> __device__ __forceinline__ void block_sum(float (&v)[NV], LAS float* red  , int wave, int lane) {
#pragma unroll
    for (int i = 0; i < NV; ++i) v[i] += DPP_MOV(v[i], 0x128);
#pragma unroll
    for (int i = 0; i < NV; ++i) v[i] += DPP_MOV(v[i], 0x124);
#pragma unroll
    for (int i = 0; i < NV; ++i) v[i] += DPP_MOV(v[i], 0x4E);
#pragma unroll
    for (int i = 0; i < NV; ++i) v[i] += DPP_MOV(v[i], 0xB1);
    __builtin_amdgcn_sched_barrier(0);
    float t[NV];
#pragma unroll
    for (int i = 0; i < NV; ++i) t[i] = __shfl_xor(v[i], 16);
#pragma unroll
    for (int i = 0; i < NV; ++i) v[i] += t[i];
    __builtin_amdgcn_sched_barrier(0);
#pragma unroll
    for (int i = 0; i < NV; ++i) t[i] = __shfl_xor(v[i], 32);
#pragma unroll
    for (int i = 0; i < NV; ++i) v[i] += t[i];
    __builtin_amdgcn_sched_barrier(0);
    if (lane == 0) {
#pragma unroll
        for (int i = 0; i < NV; ++i) red[i * 8 + wave] = v[i]; }
    __syncthreads();
#pragma unroll
    for (int i = 0; i < NV; ++i) { const LAS f32x4* p = (const LAS f32x4*)(red + i * 8); const f32x4 a = p[0], b = p[1]; v[i] = ((a.x + a.y) + (a.z + a.w)) + ((b.x + b.y) + (b.z + b.w)); }
    __syncthreads();
}
constexpr int CT = 16;
__device__ __forceinline__ void conv_item(Frame& F, int l, int item) {
    LAS unsigned char* cs = F.lds;
    LAS float* red = (LAS float*)(F.lds + 62 * 2048);
    const int t0 = item * 32, c0 = 2 * F.tid;
    const auto rus = MAKE_RSRC(F.U, (size_t)S * UW * 2); const int c16 = F.tid & 127, rb = F.tid >> 7; u32x4 v[16];
#pragma unroll
    for (int i = 0; i < 16; ++i) { const int row = rb + 4 * i, sidx = t0 - 30 + row; v[i] = (u32x4){0u, 0u, 0u, 0u};
        if (row < 62 && sidx >= 0) v[i] = __builtin_bit_cast(u32x4, __builtin_amdgcn_raw_buffer_load_b128(rus, c16 * 16, sidx * (UW * 2), 0)); }
    f32x2 wv[31];
    const auto rw = MAKE_RSRC(F.cdw_w + (size_t)l * CW * DC, CW * DC * 4);
#pragma unroll
    for (int j = 0; j < 31; ++j) wv[j] = __builtin_bit_cast(f32x2, __builtin_amdgcn_raw_buffer_load_b64(rw, c0 * 4, (30 - j) * DC * 4, 0));
    const f32x2 bias = *(const f32x2*)(F.cdw_b + l * DC + c0);
    const f32x2 lg = *(const f32x2*)(F.cln_g + l * DC + c0), lb = *(const f32x2*)(F.cln_b + l * DC + c0);
    const auto ru = MAKE_RSRC(F.U, (size_t)S * UW * 2); const auto ry = MAKE_RSRC(F.Y, (size_t)S * D * 2);
    unsigned zwq[32];
#pragma unroll
    for (int i = 0; i < 32; ++i) zwq[i] = __builtin_amdgcn_raw_buffer_load_b32(ru, (1024 + c0) * 2, (t0 + i) * (UW * 2), 0);
#pragma unroll
    for (int i = 0; i < 16; ++i) { const int row = rb + 4 * i; if (row < 62) *(LAS u32x4*)(cs + row * 2048 + c16 * 16) = v[i]; }
    __syncthreads();
#pragma unroll 1
    for (int hb_ = 0; hb_ < ((PROBE_DUP & 64) ? 2 : 1) * (32 / CT); ++hb_) { const int hb = hb_ % (32 / CT);
        f32x2 acc[CT];
#pragma unroll
        for (int i = 0; i < CT; ++i) acc[i] = bias;
        const LAS unsigned char* cp = cs + (hb * CT) * 2048 + F.tid * 4;
        unsigned cwq[CT + 30];
#pragma unroll
        for (int si = 0; si < CT + 30; ++si) cwq[si] = *(const LAS unsigned*)(cp + si * 2048);
        static_assert(CT + 30 == 46, "operand lists below");
        asm volatile("" : "+v"(cwq[0]), "+v"(cwq[1]), "+v"(cwq[2]), "+v"(cwq[3]), "+v"(cwq[4]), "+v"(cwq[5]), "+v"(cwq[6]), "+v"(cwq[7]), "+v"(cwq[8]), "+v"(cwq[9]), "+v"(cwq[10]), "+v"(cwq[11]), "+v"(cwq[12]), "+v"(cwq[13]), "+v"(cwq[14]), "+v"(cwq[15]));
        asm volatile("" : "+v"(cwq[16]), "+v"(cwq[17]), "+v"(cwq[18]), "+v"(cwq[19]), "+v"(cwq[20]), "+v"(cwq[21]), "+v"(cwq[22]), "+v"(cwq[23]), "+v"(cwq[24]), "+v"(cwq[25]), "+v"(cwq[26]), "+v"(cwq[27]), "+v"(cwq[28]), "+v"(cwq[29]), "+v"(cwq[30]), "+v"(cwq[31]));
        asm volatile("" : "+v"(cwq[32]), "+v"(cwq[33]), "+v"(cwq[34]), "+v"(cwq[35]), "+v"(cwq[36]), "+v"(cwq[37]), "+v"(cwq[38]), "+v"(cwq[39]), "+v"(cwq[40]), "+v"(cwq[41]), "+v"(cwq[42]), "+v"(cwq[43]), "+v"(cwq[44]), "+v"(cwq[45]));
#pragma unroll
        for (int si = 0; si < CT + 30; ++si) {
            const unsigned cw = cwq[si];
            const f32x2 xv = (f32x2){bflo(cw), bfhi(cw)};
#pragma unroll
            for (int i = 0; i < CT; ++i) { const int j = i + 30 - si; if (j >= 0 && j <= 30) acc[i] = wv[j] * xv + acc[i]; }
            static_assert(CT == 16, "operand list below");
            asm volatile("" : "+v"(acc[0]), "+v"(acc[1]), "+v"(acc[2]), "+v"(acc[3]), "+v"(acc[4]), "+v"(acc[5]), "+v"(acc[6]), "+v"(acc[7]),
                              "+v"(acc[8]), "+v"(acc[9]), "+v"(acc[10]), "+v"(acc[11]), "+v"(acc[12]), "+v"(acc[13]), "+v"(acc[14]), "+v"(acc[15]));
        }
        float a0[CT], a1[CT];
#pragma unroll
        for (int i = 0; i < CT; ++i) { a0[i] = acc[i].x; a1[i] = acc[i].y; }
        float sv[CT];
#pragma unroll
        for (int i = 0; i < CT; ++i) sv[i] = a0[i] + a1[i];
        block_sum<CT>(sv, red, F.wave, F.lane);
#pragma unroll
        for (int i = 0; i < CT; ++i) { const float mean = sv[i] * (1.f / DC); a0[i] -= mean; a1[i] -= mean; sv[i] = a0[i] * a0[i] + a1[i] * a1[i]; }
        block_sum<CT>(sv, red, F.wave, F.lane);
#pragma unroll
        for (int i = 0; i < CT; ++i) {
            const int t = t0 + hb * CT + i;
            const float rstd = __builtin_amdgcn_rsqf(sv[i] * (1.f / DC) + LN_EPS);
            const unsigned zw = hb ? zwq[CT + i] : zwq[i];
            const float n0 = a0[i] * rstd * lg.x + lb.x, n1 = a1[i] * rstd * lg.y + lb.y;
            const float y0 = n0 * pg8::fsigm(n0) * bflo(zw), y1 = n1 * pg8::fsigm(n1) * bfhi(zw);
            __builtin_amdgcn_raw_buffer_store_b32(pk2(y0, y1), ry, c0 * 2, t * (D * 2), 0);
        }
    }
    __syncthreads();
}
#define DPP_ROW_SHR(x, oldv, d) __builtin_bit_cast(float, __builtin_amdgcn_update_dpp(__builtin_bit_cast(int, (float)(oldv)), __builtin_bit_cast(int, (float)(x)), 0x110 + (d), 0xf, 0xf, false))
#define DPP_ROW_BCAST15(x) __builtin_bit_cast(float, __builtin_amdgcn_update_dpp(0, __builtin_bit_cast(int, (float)(x)), 0x15F, 0xf, 0xf, true))
__device__ __forceinline__ unsigned* lru_flag(Frame& F, int l, int c, int h) { return F.ctl + CW_LRU + 64 * ((l * NLCH + c) * NHEAD + h); }
__device__ __forceinline__ void lru_item(Frame& F, int l, int item) {
    const int c = item >> 3, h = item & 7, t0 = c * LCH, ch0 = h * HD;
    LAS unsigned char* xhi = F.lds; LAS unsigned char* xlo = F.lds + LCH * XROW;
    const int tid = F.tid, lane = F.lane, w = F.wave, fr = lane & 15, fq = lane >> 4;
    const auto ru = MAKE_RSRC(F.U, (size_t)S * UW * 2); const auto ry = MAKE_RSRC(F.Y, (size_t)S * D * 2);
    const int chl = ch0 + 16 * w + 4 * fq;
    const f32x4 vba = *(const f32x4*)(F.ba + l * DL + chl), vbx = *(const f32x4*)(F.bx + l * DL + chl), vlam = *(const f32x4*)(F.lam + l * DL + chl);
    float c8l[4], c8x[4], nba[4], nbx[4], keep[4];
#pragma unroll
    for (int j = 0; j < 4; ++j) { const float c8 = 8.f * log_sigmoid(vlam[j]); c8l[j] = c8 * 1.44269504089f; c8x[j] = 2.f * c8; nba[j] = vba[j] * -1.44269504089f; nbx[j] = vbx[j] * -1.44269504089f; }
    keep[0] = fr < 1 ? 1.f : 0.f; keep[1] = fr < 2 ? 1.f : 0.f; keep[2] = fr < 4 ? 1.f : 0.f; keep[3] = fr < 8 ? 1.f : 0.f;
    bf16x8 br[4], bi[4];
    { const bf16_t* wg = F.WgT + (size_t)((l * NHEAD + h) * 2) * HD * HD + (size_t)(16 * w + fr) * HD + 8 * fq;
#pragma unroll
      for (int kk = 0; kk < 4; ++kk) { br[kk] = *(const bf16x8*)(wg + 32 * kk); bi[kk] = *(const bf16x8*)(wg + HD * HD + 32 * kk); } }
    {
        const int tg = tid >> 4, cg = tid & 15, tb = 8 * tg;
        const float* cw = F.lcw + (size_t)l * LW * DL + ch0 + 8 * cg;
        f32x4 wk[4][2];
#pragma unroll
        for (int k = 0; k < 4; ++k) { wk[k][0] = *(const f32x4*)(cw + (size_t)k * DL); wk[k][1] = *(const f32x4*)(cw + (size_t)k * DL + 4); }
        const f32x4 bb0 = *(const f32x4*)(F.lcb + l * DL + ch0 + 8 * cg), bb1 = *(const f32x4*)(F.lcb + l * DL + ch0 + 8 * cg + 4);
        u32x4 rows[11];
#pragma unroll
        for (int r = 0; r < 11; ++r) { const int sidx = t0 + tb - 3 + r; rows[r] = (u32x4){0u, 0u, 0u, 0u};
            if (sidx >= 0) rows[r] = __builtin_bit_cast(u32x4, __builtin_amdgcn_raw_buffer_load_b128(ru, (2048 + ch0 + 8 * cg) * 2, sidx * (UW * 2), 0)); }
#pragma unroll
        for (int i = 0; i < 8; ++i) {
            f32x4 a0 = bb0, a1 = bb1;
#pragma unroll
            for (int k = 0; k < 4; ++k) { const u32x4 q = rows[i + k];
                a0[0] += wk[k][0][0] * bflo(q.x); a0[1] += wk[k][0][1] * bfhi(q.x); a0[2] += wk[k][0][2] * bflo(q.y); a0[3] += wk[k][0][3] * bfhi(q.y);
                a1[0] += wk[k][1][0] * bflo(q.z); a1[1] += wk[k][1][1] * bfhi(q.z); a1[2] += wk[k][1][2] * bflo(q.w); a1[3] += wk[k][1][3] * bfhi(q.w); }
            u32x4 hi; hi.x = pk2(a0[0], a0[1]); hi.y = pk2(a0[2], a0[3]); hi.z = pk2(a1[0], a1[1]); hi.w = pk2(a1[2], a1[3]);
            u32x4 lo; lo.x = pk2(a0[0] - bflo(hi.x), a0[1] - bfhi(hi.x)); lo.y = pk2(a0[2] - bflo(hi.y), a0[3] - bfhi(hi.y)); lo.z = pk2(a1[0] - bflo(hi.z), a1[1] - bfhi(hi.z)); lo.w = pk2(a1[2] - bflo(hi.w), a1[3] - bfhi(hi.w));
            *(LAS u32x4*)(xhi + (tb + i) * XROW + cg * 16) = hi; *(LAS u32x4*)(xlo + (tb + i) * XROW + cg * 16) = lo; }
    }
    __syncthreads();
    float hl[16][4], pc[16][4], HC[4], PC[4];
#pragma unroll
    for (int j = 0; j < 4; ++j) { HC[j] = 0.f; PC[j] = 1.f; }
#pragma unroll
    for (int m = 0; m < 16; ++m) {
        f32x4 ar = (f32x4){0.f, 0.f, 0.f, 0.f}, ai = (f32x4){0.f, 0.f, 0.f, 0.f};
        const LAS unsigned char* rowp = xhi + (16 * m + fr) * XROW;
#pragma unroll
        for (int kk = 0; kk < 4; ++kk) { const bf16x8 a = *(const LAS bf16x8*)(rowp + (32 * kk + 8 * fq) * 2);
            ar = __builtin_amdgcn_mfma_f32_16x16x32_bf16(br[kk], a, ar, 0, 0, 0); ai = __builtin_amdgcn_mfma_f32_16x16x32_bf16(bi[kk], a, ai, 0, 0, 0); }
        const u32x2 qh = *(const LAS u32x2*)(rowp + (16 * w + 4 * fq) * 2), ql = *(const LAS u32x2*)(rowp + LCH * XROW + (16 * w + 4 * fq) * 2);
        const float xcv[4] = {bflo(qh.x) + bflo(ql.x), bfhi(qh.x) + bfhi(ql.x), bflo(qh.y) + bflo(ql.y), bfhi(qh.y) + bfhi(ql.y)};
        float Aj[4], Bj[4], xq[4];
#pragma unroll
        for (int j = 0; j < 4; ++j) {
            const float r = __builtin_amdgcn_rcpf(1.f + __builtin_amdgcn_exp2f(ar[j] * -1.44269504089f + nba[j])), ig = __builtin_amdgcn_rcpf(1.f + __builtin_amdgcn_exp2f(ai[j] * -1.44269504089f + nbx[j]));
            const float x = c8x[j] * r; xq[j] = x;
            float p = x * (1.f / 5040.f) + (1.f / 720.f); p = p * x + (1.f / 120.f); p = p * x + (1.f / 24.f); p = p * x + (1.f / 6.f); p = p * x + 0.5f; p = p * x + 1.f;
            Aj[j] = __builtin_amdgcn_exp2f(c8l[j] * r); Bj[j] = __builtin_amdgcn_sqrtf(-x * p) * (ig * xcv[j]); }
        if (__builtin_expect(__any(fminf(fminf(xq[0], xq[1]), fminf(xq[2], xq[3])) <= -0.35f), 0)) {
#pragma unroll
            for (int j = 0; j < 4; ++j) if (xq[j] <= -0.35f) { const float r = __builtin_amdgcn_rcpf(1.f + __builtin_amdgcn_exp2f(ar[j] * -1.44269504089f + nba[j])), ig = __builtin_amdgcn_rcpf(1.f + __builtin_amdgcn_exp2f(ai[j] * -1.44269504089f + nbx[j]));
                (void)r; Bj[j] = __builtin_amdgcn_sqrtf(1.f - __builtin_amdgcn_exp2f(xq[j] * 1.44269504089f)) * (ig * xcv[j]); } }
#define LRU_PIN asm volatile("" : "+v"(Aj[0]), "+v"(Aj[1]), "+v"(Aj[2]), "+v"(Aj[3]), "+v"(Bj[0]), "+v"(Bj[1]), "+v"(Bj[2]), "+v"(Bj[3]))
#define DPP_SHR0(x, d) __builtin_bit_cast(float, __builtin_amdgcn_update_dpp(0, __builtin_bit_cast(int, (float)(x)), 0x110 + (d), 0xf, 0xf, true))
#define LRU_SCAN_STEP(d, kd) { \
            _Pragma("unroll") for (int j = 0; j < 4; ++j) { Bj[j] = DPP_SHR0(Bj[j], d) * Aj[j] + Bj[j]; } \
            _Pragma("unroll") for (int j = 0; j < 4; ++j) { const float t = DPP_SHR0(Aj[j], d) + keep[kd]; Aj[j] = Aj[j] * t; } LRU_PIN; }
        LRU_PIN; LRU_SCAN_STEP(1, 0) LRU_SCAN_STEP(2, 1) LRU_SCAN_STEP(4, 2) LRU_SCAN_STEP(8, 3)
#undef LRU_SCAN_STEP
#undef LRU_PIN
#pragma unroll
        for (int j = 0; j < 4; ++j) { hl[m][j] = Bj[j] + Aj[j] * HC[j]; pc[m][j] = Aj[j] * PC[j]; }
#pragma unroll
        for (int j = 0; j < 4; ++j) { HC[j] = DPP_ROW_BCAST15(hl[m][j]); PC[j] = DPP_ROW_BCAST15(pc[m][j]); }
    }
    const int vo_u = (fr * UW + 3072 + chl) * 2, vo_y = (fr * D + DC + chl) * 2;
    u32x2 zq[16];
#pragma unroll
    for (int m = 0; m < 16; ++m) zq[m] = __builtin_bit_cast(u32x2, __builtin_amdgcn_raw_buffer_load_b64(ru, vo_u, (t0 + 16 * m) * (UW * 2), 0));
    if (fr == 15) { unsigned long long* sp = F.SUM + (size_t)(l * NLCH + c) * DL + chl;
#pragma unroll
        for (int j = 0; j < 4; ++j) __hip_atomic_store(sp + j, ((unsigned long long)__builtin_bit_cast(unsigned, HC[j]) << 32) | __builtin_bit_cast(unsigned, PC[j]), __ATOMIC_RELAXED, __HIP_MEMORY_SCOPE_AGENT); }
    asm volatile("s_waitcnt vmcnt(0)" ::: "memory");
    __syncthreads();
    if (tid == 0) __hip_atomic_store(lru_flag(F, l, c, h), 1u, __ATOMIC_RELAXED, __HIP_MEMORY_SCOPE_AGENT);
    float Hin[4] = {0.f, 0.f, 0.f, 0.f};
    if (c > 0) {
        if (w == 0) {
            unsigned* fp = lru_flag(F, l, lane < c ? lane : 0, h); unsigned spins = 0;
            for (;;) { const unsigned v = __hip_atomic_load(fp, __ATOMIC_RELAXED, __HIP_MEMORY_SCOPE_AGENT); if (__all(v != 0u)) break; __builtin_amdgcn_s_sleep(2); if (++spins > (1u << 20)) break; }
            __builtin_amdgcn_fence(__ATOMIC_ACQUIRE, "agent");
            asm volatile("s_waitcnt vmcnt(0)" ::: "memory");
        }
        __syncthreads();
        const unsigned long long* sp = F.SUM + (size_t)(l * NLCH) * DL + chl;
        u32x4 q[2][2];
#pragma unroll
        for (int g = 0; g < 2; ++g) { const int cc = fr + 16 * g; q[g][0] = (u32x4){0x3f800000u, 0u, 0x3f800000u, 0u}; q[g][1] = q[g][0];
            if (cc < c) { q[g][0] = *(const u32x4*)(sp + (size_t)cc * DL); q[g][1] = *(const u32x4*)(sp + (size_t)cc * DL + 2); } }
#pragma unroll
        for (int j = 0; j < 4; ++j) { float Hq[2];
#pragma unroll
            for (int g = 0; g < 2; ++g) { const u32x4 qq = q[g][j >> 1]; float A = (j & 1) ? u2f(qq.z) : u2f(qq.x), B = (j & 1) ? u2f(qq.w) : u2f(qq.y);
#define LRU_SCAN_STEP(d) { const float ap = DPP_ROW_SHR(A, 1.0f, d), bp = DPP_ROW_SHR(B, 0.0f, d); B = A * bp + B; A = ap * A; }
                LRU_SCAN_STEP(1) LRU_SCAN_STEP(2) LRU_SCAN_STEP(4) LRU_SCAN_STEP(8)
#undef LRU_SCAN_STEP
                const float At = DPP_ROW_BCAST15(A), Bt = DPP_ROW_BCAST15(B);
                Hq[g] = g == 0 ? Bt : At * Hq[0] + Bt; }
            Hin[j] = Hq[1]; }
    }
#pragma unroll
    for (int m = 0; m < 16; ++m) { const int trow = t0 + 16 * m; const unsigned zx = zq[m].x, zy = zq[m].y;
        const float y0 = (hl[m][0] + pc[m][0] * Hin[0]) * bflo(zx), y1 = (hl[m][1] + pc[m][1] * Hin[1]) * bfhi(zx), y2 = (hl[m][2] + pc[m][2] * Hin[2]) * bflo(zy), y3 = (hl[m][3] + pc[m][3] * Hin[3]) * bfhi(zy);
        u32x2 o; o.x = pk2(y0, y1); o.y = pk2(y2, y3);
        __builtin_amdgcn_raw_buffer_store_b64(o, ry, vo_y, trow * (D * 2), 0); }
    __syncthreads();
}
__device__ __forceinline__ void p_mix(Frame& F, int l) {
    PHASE_TID(F);
    constexpr int NCONV = S / 32, NLRU = NLCH * NHEAD;
    for (int rep = 0; rep < ((PROBE_DUP & 8) ? 2 : 1); ++rep)
    for (int it = F.bid; it < NLRU; it += F.G) { PHASE_TID(F); lru_item(F, l, it); }
    for (int rep = 0; rep < ((PROBE_DUP & 16) ? 2 : 1); ++rep)
    for (int it = F.bid; it < NCONV; it += F.G) { PHASE_TID(F); conv_item(F, l, it); }
}
__device__ __forceinline__ void p_final(Frame& F) {
    PHASE_TID(F);
    const int gw = F.bid * NWAVES + F.wave, NGW = F.G * NWAVES;
    for (int m = gw; m < S; m += NGW) {
        float ss = 0.f;
#pragma unroll
        for (int p = 0; p < 32; ++p) ss += F.SSQ[p * S + m];
        const float rstd = 1.f / sqrtf(ss * (1.f / D) + RMS_EPS);
        f32x4* orow = (f32x4*)(F.out + (size_t)m * D) + F.lane; const f32x4* gr = (const f32x4*)F.final_g + F.lane;
#pragma unroll
        for (int j = 0; j < 8; ++j) orow[64 * j] = orow[64 * j] * rstd * gr[64 * j];
    }
}

constexpr int PH_PER_LAYER = 3, NPH = 1 + DEPTH * PH_PER_LAYER + 1;
struct Args { const float* in[16]; float* out; unsigned char* ws; int ph_lo, ph_hi; };
__global__ void __launch_bounds__(NTHREADS, 2) mk_fwd(Args a) {
    extern __shared__ __attribute__((aligned(16))) unsigned char lds_raw[];
    Frame F;
    F.lds = (LAS unsigned char*)lds_raw;
    F.wave = __builtin_amdgcn_readfirstlane(threadIdx.x >> 6); F.tid = opaque_tid(F.wave); F.lane = F.tid & 63; F.bid = blockIdx.x; F.G = gridDim.x; F.vc = blockIdx.x;
    F.x = a.in[0]; F.norm_g = a.in[1]; F.w_in = a.in[2]; F.cdw_w = a.in[3]; F.cdw_b = a.in[4]; F.cln_g = a.in[5]; F.cln_b = a.in[6]; F.lcw = a.in[7]; F.lcb = a.in[8];
    F.wa = a.in[9]; F.ba = a.in[10]; F.wx = a.in[11]; F.bx = a.in[12]; F.lam = a.in[13]; F.w_out = a.in[14]; F.final_g = a.in[15]; F.out = a.out;
    unsigned char* ws = a.ws;
    F.WinT = (bf16_t*)(ws + WS_WINT); F.WoutT = (bf16_t*)(ws + WS_WOUTT); F.XB = (bf16_t*)(ws + WS_XB); F.U = (bf16_t*)(ws + WS_U); F.Y = (bf16_t*)(ws + WS_Y);
    F.SSQ = (float*)(ws + WS_SSQ); F.SUM = (unsigned long long*)(ws + WS_SUM); F.WgT = (bf16_t*)(ws + WS_WG); F.ctl = (unsigned*)(ws + WS_CTL);
    volatile LAS unsigned* bst = (volatile LAS unsigned*)(F.lds + LDS_BYTES - 64);
    if (F.tid < 16) bst[F.tid] = 0u;
    __syncthreads();
    XcdBarrier bar; bar.bar = (unsigned*)(ws + WS_CTL) + CW_BAR; bar.x = 0; bar.st = bst;
    if (MK_ONE_LAUNCH) bar = xcd_barrier_post((unsigned*)(ws + WS_CTL) + CW_BAR, bst, F.wave);
    bar.wave = F.wave;
    for (int ph = a.ph_lo; ph < a.ph_hi; ++ph) {
      const int jj = (ph == 0 || ph == NPH - 1) ? -1 : (ph - 1) % PH_PER_LAYER;
      const int reps = ((PROBE_DUP & 1) && ph == 0) || ((PROBE_DUP & 2) && jj == 0) || ((PROBE_DUP & 4) && jj == 1) ? 2 : 1;
      for (int rep = 0; rep < reps; ++rep) {
        if (rep) xcd_barrier(bar);
        if (ph == 0) p_prologue(F);
        else if (ph == NPH - 1) p_final(F);
        else { const int l = (ph - 1) / PH_PER_LAYER, j = (ph - 1) % PH_PER_LAYER;
            if (j == 0) { pg8::Gemm g{F.XB, F.WinT + (size_t)l * DIN * D, S, DIN, D}; pg8::OrderRstd Sd; Sd.init(S, DIN, F.G, F.vc); Sd.ssq = F.SSQ; Sd.rtab = (LAS float*)(F.lds + pg8::RTAB_OFF); Sd.wave = F.wave;
                pg8::EpiIn E{F.U, (const LAS float*)(F.lds + pg8::RTAB_OFF)};
                pg8::gemm_phase<pg8::EpiIn, pg8::OrderRstd, true, true>(F.lds, g, Sd, E, F.wave);
                if (F.G == 256 && l + 1 < DEPTH && F.vc >= 128) { PHASE_TID(F); convert_layer(F, l + 1, (F.vc - 128) * NWAVES + F.wave, 128 * NWAVES); } }
            else if (j == 1) p_mix(F, l);
            else { pg8::Gemm g{F.Y, F.WoutT + (size_t)l * D * D, S, D, D}; pg8::StaticOrder Sd; Sd.init(S, D, F.G, F.vc);
                pg8::EpiOut E{l == DEPTH - 1 ? F.out : nullptr, F.XB, F.SSQ};
                pg8::gemm_phase<pg8::EpiOut, pg8::StaticOrder, true, true>(F.lds, g, Sd, E, F.wave); }
        }
      }
        if (ph + 1 < a.ph_hi) xcd_barrier(bar);
        if (MK_ONE_LAUNCH && ph == 0 && F.G == 256) {
            if (opaque_tid(F.wave) == 0) { bool ok = true;
                for (unsigned j = 0; j < 16; ++j) { const unsigned cnt = xb_ld(&bar.bar[XB_XCNT(j)]); ok = ok && (cnt == (j < 8 ? 32u : 0u)); }
                bst[4] = ok ? (bst[2] * 8u + bar.x) : (unsigned)F.bid; }
            __syncthreads();
            F.vc = __builtin_amdgcn_readfirstlane((int)bst[4]);
        }
    }
}

extern "C" void kernel_launch(void* const* d_in, const int* in_sizes, int n_in, void* d_out, int out_size, void* d_ws, size_t ws_size, hipStream_t stream) {
    static int grid = 0;
    if (grid == 0) {
        if (n_in != 16 || in_sizes[0] != S * D || out_size != S * D || ws_size < WS_END) { fprintf(stderr, "kernel_launch: unexpected shapes (n_in %d, in0 %d, out %d, ws %zu)\n", n_in, n_in > 0 ? in_sizes[0] : -1, out_size, ws_size); grid = -1; return; }
        int dev = 0, cus = 0, per_cu = 0;
        if (hipGetDevice(&dev) != hipSuccess || hipDeviceGetAttribute(&cus, hipDeviceAttributeMultiprocessorCount, dev) != hipSuccess) { grid = -1; return; }
        if (hipFuncSetAttribute((const void*)mk_fwd, hipFuncAttributeMaxDynamicSharedMemorySize, LDS_BYTES) != hipSuccess) { fprintf(stderr, "kernel_launch: hipFuncSetAttribute failed\n"); grid = -1; return; }
        if (hipOccupancyMaxActiveBlocksPerMultiprocessor(&per_cu, (const void*)mk_fwd, NTHREADS, LDS_BYTES) != hipSuccess || per_cu < 1) fprintf(stderr, "kernel_launch: occupancy query says %d per CU\n", per_cu);
        (void)hipGetLastError();
        grid = cus;
    }
    if (grid < 0) return;
    (void)hipMemsetAsync((char*)d_ws + WS_CTL, 0, CTL_ZERO_BYTES, stream);
    Args a{};
    for (int i = 0; i < 16; ++i) a.in[i] = (const float*)d_in[i];
    a.out = (float*)d_out; a.ws = (unsigned char*)d_ws;
#if MK_ONE_LAUNCH
    a.ph_lo = 0; a.ph_hi = NPH;
    hipLaunchKernelGGL(mk_fwd, dim3(grid), dim3(NTHREADS), LDS_BYTES, stream, a);
#else
    for (int ph = 0; ph < NPH; ++ph) { a.ph_lo = ph; a.ph_hi = ph + 1; hipLaunchKernelGGL(mk_fwd, dim3(grid), dim3(NTHREADS), LDS_BYTES, stream, a); }
#endif
}
```

```cpp
#include <hip/hip_runtime.h>
#include <cstdio>
#include <cstdint>

#ifndef MK_ONE_LAUNCH
#define MK_ONE_LAUNCH 1
#endif

#ifndef PROBE_DUP
#define PROBE_DUP 0
#endif
#define LAS __attribute__((address_space(3)))
#define GAS __attribute__((address_space(1)))
typedef unsigned short bf16_t;
typedef short bf16x8 __attribute__((ext_vector_type(8)));
typedef float f32x4 __attribute__((ext_vector_type(4)));
typedef float f32x2 __attribute__((ext_vector_type(2)));
typedef unsigned u32x4 __attribute__((ext_vector_type(4)));
typedef unsigned u32x2 __attribute__((ext_vector_type(2)));

constexpr int S = 8192, D = 2048, DEPTH = 4, DC = 1024, DL = 1024, DIN = 5120, NHEAD = 8, HD = 128, CW = 31, LW = 4;
constexpr int UW = 4096;
constexpr float RMS_EPS = 1e-6f, LN_EPS = 1e-5f;
constexpr int NTHREADS = 512, NWAVES = 8;
constexpr int LDS_BYTES = 147456;
constexpr int LCH = 256, NLCH = S / LCH;
constexpr int XROW = 272;
constexpr int CW_BAR = 4096, CW_LRU = 16384;

constexpr size_t MiB = 1u << 20;
constexpr size_t WS_CTL = 0, CTL_ZERO_BYTES = 1 * MiB;
constexpr size_t WS_WINT = 2 * MiB;
constexpr size_t WS_WOUTT = 82 * MiB;
constexpr size_t WS_XB = 114 * MiB;
constexpr size_t WS_U = 146 * MiB;
constexpr size_t WS_Y = 210 * MiB;
constexpr size_t WS_SSQ = 242 * MiB;
constexpr size_t WS_SUM = 243 * MiB;
constexpr size_t WS_WG = 244 * MiB;
constexpr size_t WS_END = 246 * MiB;

__device__ __forceinline__ int opaque_tid(int wave);
#define MAKE_RSRC(p, bytes) __builtin_amdgcn_make_buffer_rsrc((void*)(p), 0, (int)(bytes), 0x00020000)
__device__ __forceinline__ unsigned f2bf(float f) { unsigned u = __builtin_bit_cast(unsigned, f); return (u + 0x7fffu + ((u >> 16) & 1u)) >> 16; }
__device__ __forceinline__ unsigned pk2(float lo, float hi) { return f2bf(lo) | (f2bf(hi) << 16); }
__device__ __forceinline__ float bflo(unsigned w) { return __builtin_bit_cast(float, w << 16); }
__device__ __forceinline__ float bfhi(unsigned w) { return __builtin_bit_cast(float, w & 0xffff0000u); }
__device__ __forceinline__ float u2f(unsigned u) { return __builtin_bit_cast(float, u); }
__device__ __forceinline__ float bf2f(bf16_t b) { return __builtin_bit_cast(float, (unsigned)b << 16); }
__device__ __forceinline__ float sigm(float x) { return 1.f / (1.f + __expf(-x)); }
__device__ __forceinline__ float siluf(float x) { return x * sigm(x); }
__device__ __forceinline__ float wave_sum(float v) {
#pragma unroll
    for (int o = 1; o < 64; o <<= 1) v += __shfl_xor(v, o);
    return v;
}
__device__ __forceinline__ float neg_expm1(float x) {
    float p = 1.f + x * (1.f / 8.f); p = 1.f + x * (1.f / 7.f) * p; p = 1.f + x * (1.f / 6.f) * p; p = 1.f + x * (1.f / 5.f) * p; p = 1.f + x * 0.25f * p; p = 1.f + x * (1.f / 3.f) * p; p = 1.f + x * 0.5f * p;
    const float big = 1.f - __builtin_amdgcn_exp2f(x * 1.44269504089f);
    return x > -0.35f ? -x * p : big;
}
__device__ __forceinline__ float log_sigmoid(float x) { return fminf(x, 0.f) - log1pf(expf(-fabsf(x))); }
__host__ __device__ __forceinline__ int src_col(int np) { if (np < 2048) { const int p = np >> 8, j = np & 255; return j < 128 ? 128 * p + j : 1024 + 128 * p + (j - 128); } return np; }

#define XB_TMO      128
#define XB_XCNT(j)  (256  + 64 * (j))
#define XB_XSUB(j)  (1280 + 64 * (j))
#define XB_XGEN(j)  (2304 + 64 * (j))
#define XB_TOP      3328
#define XB_TOPGEN   3392
#define XCD_BAR_WORDS 3456
#define XB_SPIN_CAP (1u << 18)
__device__ __forceinline__ unsigned xb_ld(unsigned* p)              { return __hip_atomic_load(p, __ATOMIC_RELAXED, __HIP_MEMORY_SCOPE_AGENT); }
__device__ __forceinline__ unsigned xb_add(unsigned* p, unsigned v) { return __hip_atomic_fetch_add(p, v, __ATOMIC_RELAXED, __HIP_MEMORY_SCOPE_AGENT); }
__device__ __forceinline__ unsigned xb_xcc_id() { return (unsigned)__builtin_amdgcn_s_getreg((3 << 11) | 20) & 0xFu; }
#define XB_SPIN(cond, bar) do { unsigned _sp = 0; while (cond) { __builtin_amdgcn_s_sleep(1); \
    if ((++_sp & 255u) == 0u) { if (xb_ld(&(bar)[XB_TMO])) break; if (_sp > XB_SPIN_CAP) { atomicAdd(&(bar)[XB_TMO], 1u); break; } } } } while (0)
struct XcdBarrier { unsigned* bar; unsigned x; volatile LAS unsigned* st; int wave; };
__device__ __forceinline__ XcdBarrier xcd_barrier_post(unsigned* bar, volatile LAS unsigned* st, int wave) {
    XcdBarrier b; b.bar = bar; b.x = xb_xcc_id(); b.st = st; b.wave = wave;
    if (opaque_tid(wave) == 0) st[2] = xb_add(&bar[XB_XCNT(b.x)], 1u);
    return b;
}
__device__ __forceinline__ void xcd_barrier_complete(unsigned* bar, unsigned x, unsigned& nloc, unsigned& nx) {
    const unsigned G = gridDim.x * gridDim.y * gridDim.z;
    unsigned sum, cnt, mine, sp = 0u;
    for (;;) {
        sum = 0u; cnt = 0u; mine = 0u;
#pragma unroll
        for (unsigned j = 0; j < 16; ++j) { const unsigned c = xb_ld(&bar[XB_XCNT(j)]); sum += c; cnt += (c > 0u) ? 1u : 0u; mine = (j == x) ? c : mine; }
        if (sum == G) break;
        __builtin_amdgcn_s_sleep(1);
        if ((++sp & 255u) == 0u) { if (xb_ld(&bar[XB_TMO])) break; if (sp > XB_SPIN_CAP) { atomicAdd(&bar[XB_TMO], 1u); break; } }
    }
    nloc = mine > 0u ? mine : 1u; nx = cnt > 0u ? cnt : 1u;
}
__device__ __forceinline__ void xcd_barrier(const XcdBarrier& b) {
    asm volatile("s_waitcnt vmcnt(0)" ::: "memory");
    __syncthreads();
    if (opaque_tid(b.wave) == 0) {
        unsigned* bar = b.bar;
        __builtin_amdgcn_s_waitcnt(0);
        unsigned nloc = b.st[0], nx = b.st[1];
        if (nloc == 0u) { xcd_barrier_complete(bar, b.x, nloc, nx); b.st[0] = nloc; b.st[1] = nx; }
        const unsigned old = xb_add(&bar[XB_XSUB(b.x)], 1u);
        const unsigned gen = old / nloc;
        if (old + 1u == (gen + 1u) * nloc) {
            __builtin_amdgcn_fence(__ATOMIC_RELEASE, "agent");
            asm volatile("s_waitcnt vmcnt(0)" ::: "memory");
            const unsigned og = xb_add(&bar[XB_TOP], 1u);
            const unsigned tg = og / nx;
            if (og + 1u == (tg + 1u) * nx) xb_add(&bar[XB_TOPGEN], 1u);
            else XB_SPIN(xb_ld(&bar[XB_TOPGEN]) == tg, bar);
            __builtin_amdgcn_fence(__ATOMIC_ACQUIRE, "agent");
            xb_add(&bar[XB_XGEN(b.x)], 1u);
            asm volatile("s_waitcnt vmcnt(0)" ::: "memory");
        } else {
            XB_SPIN(xb_ld(&bar[XB_XGEN(b.x)]) == gen, bar);
            __builtin_amdgcn_fence(__ATOMIC_ACQUIRE, "agent");
            asm volatile("s_waitcnt vmcnt(0)" ::: "memory");
        }
    }
    __syncthreads();
}

struct Frame {
    LAS unsigned char* lds;
    int tid, lane, wave, bid, G, vc;
    const float *x, *norm_g, *w_in, *cdw_w, *cdw_b, *cln_g, *cln_b, *lcw, *lcb, *wa, *ba, *wx, *bx, *lam, *w_out, *final_g;
    float* out;
    bf16_t *WinT, *WoutT, *XB, *U, *Y;
    float *SSQ; unsigned long long* SUM; bf16_t* WgT; unsigned* ctl;
};

namespace pg8 {
#define PG8_LAS __attribute__((address_space(3)))
typedef unsigned short bf16_t;
typedef short bf16x8 __attribute__((ext_vector_type(8)));
typedef float f32x4 __attribute__((ext_vector_type(4)));
typedef unsigned u32x4 __attribute__((ext_vector_type(4)));
constexpr int BM = 256, BK = 64, HALF = 128, HTB = HALF * BK * 2  , STAGE_BYTES = 8 * HTB, NXCD = 8, WGM = 8;

__host__ __device__ __forceinline__ int lds_byte(int r, int c) { const int st = (r >> 4) * 2 + (c >> 5), rr = r & 15, cc = c & 31, ob = rr * 64 + cc * 2; return st * 1024 + (ob ^ (((ob >> 9) & 1) << 5)); }
__host__ __device__ __forceinline__ void stage_rc(int b, int& R, int& C) { const int st = b / 1024, sb = b % 1024, swz = sb ^ (((sb >> 9) & 1) << 5); R = (st >> 1) * 16 + swz / 64; C = (st & 1) * 32 + (swz % 64) / 2; }
__host__ __device__ __forceinline__ int perm32(int rho) { const int n = rho >> 4, i = rho & 15; return 8 * (i >> 2) + 4 * n + (i & 3); }

struct Unit { int pm, pn; };
struct Gemm { const bf16_t* A; const bf16_t* Bt; int M, N, K; };

struct StaticOrder {
    int nM, nN, nwg, G, c;
    __host__ __device__ void init(int M, int N, int G_, int c_) { nM = M / BM; nN = N / BM; nwg = nM * nN; G = G_; c = c_; }
    __host__ __device__ bool next(int i, Unit& u) const {
        const long L = (long)i * G + c; if (L >= nwg) return false;
        int wgid = (int)L; { const int q = nwg / NXCD, r = nwg % NXCD, xcd = wgid % NXCD, off = wgid / NXCD; wgid = (xcd < r ? xcd * (q + 1) : r * (q + 1) + (xcd - r) * q) + off; }
        const int nig = WGM * nN, gid = wgid / nig, fm = gid * WGM, gsz = (nM - fm) < WGM ? (nM - fm) : WGM;
        u.pm = fm + ((wgid % nig) % gsz); u.pn = (wgid % nig) / gsz; return true;
    }
    __device__ __forceinline__ void a_ready(const Unit&, int) const {}
    __device__ __forceinline__ void done(const Unit&) const {}
};


__device__ __forceinline__ unsigned cvt_pk_bf16(float lo, float hi) { unsigned r; asm volatile("v_cvt_pk_bf16_f32 %0, %1, %2" : "=v"(r) : "v"(lo), "v"(hi)); return r; }
__device__ __forceinline__ void st16_wt(void* p, u32x4 v) { asm volatile("global_store_dwordx4 %0, %1, off sc1\n\ts_nop 1" :: "v"(p), "v"(v) : "memory"); }
__device__ __forceinline__ float fsigm(float x) { return __builtin_amdgcn_rcpf(1.f + __builtin_amdgcn_exp2f(x * -1.44269504089f)); }
constexpr int RTAB_OFF = STAGE_BYTES;

struct OrderRstd : StaticOrder {
    const float* ssq; PG8_LAS float* rtab; int wave;
    __device__ __forceinline__ void a_ready(const Unit& u, int ui) const {
        const int t_ = opaque_tid(wave), wid = wave, lane = t_ & 63, rl = wid * 32 + (lane & 31), half = lane >> 5;
        const float* p = ssq + (size_t)(half * 16) * 8192 + u.pm * BM + rl; float s = 0.f;
#pragma unroll
        for (int q = 0; q < 16; ++q) s += p[(size_t)q * 8192];
        s += __shfl_xor(s, 32);
        if (lane < 32) rtab[(ui & 1) * 256 + rl] = 1.0f / sqrtf(s * (1.0f / 2048.0f) + 1e-6f);
    }
};
struct EpiIn {
    static constexpr bool PERM = true, AFTER_DRAIN = false;
    bf16_t* U; const PG8_LAS float* rtab;
    __device__ __forceinline__ void operator()(const f32x4 (&acc)[2][2][4][2], const Unit& u, int wr, int wc, int fr, int fq, int ui) const {
        const PG8_LAS float* rt = rtab + (ui & 1) * 256 + wr * 64 + fr;
        if (u.pn < 8) {
            bf16_t* base = U + (size_t)(u.pm * BM + wr * 64 + fr) * 4096 + 128 * u.pn + wc * 32 + 8 * fq;
#pragma unroll
            for (int ai = 0; ai < 2; ++ai)
#pragma unroll
                for (int m = 0; m < 4; ++m) { const float rs = rt[ai * HALF + m * 16];
                    const f32x4 v0 = acc[ai][0][m][0] * rs, v1 = acc[ai][0][m][1] * rs, g0 = acc[ai][1][m][0] * rs, g1 = acc[ai][1][m][1] * rs;
                    u32x4 w; w.x = cvt_pk_bf16(v0[0] * fsigm(g0[0]), v0[1] * fsigm(g0[1])); w.y = cvt_pk_bf16(v0[2] * fsigm(g0[2]), v0[3] * fsigm(g0[3]));
                    w.z = cvt_pk_bf16(v1[0] * fsigm(g1[0]), v1[1] * fsigm(g1[1])); w.w = cvt_pk_bf16(v1[2] * fsigm(g1[2]), v1[3] * fsigm(g1[3]));
                    st16_wt(base + (size_t)(ai * HALF + m * 16) * 4096, w); }
        } else {
            const bool act = (u.pn < 12) || (u.pn >= 16);
            bf16_t* base = U + (size_t)(u.pm * BM + wr * 64 + fr) * 4096 + (256 * u.pn - 1024) + wc * 32 + 8 * fq;
#pragma unroll
            for (int ai = 0; ai < 2; ++ai)
#pragma unroll
                for (int m = 0; m < 4; ++m) { const float rs = rt[ai * HALF + m * 16];
#pragma unroll
                    for (int bj = 0; bj < 2; ++bj) { f32x4 v0 = acc[ai][bj][m][0] * rs, v1 = acc[ai][bj][m][1] * rs;
                        if (act) {
#pragma unroll
                            for (int e = 0; e < 4; ++e) { v0[e] = v0[e] * fsigm(v0[e]); v1[e] = v1[e] * fsigm(v1[e]); } }
                        u32x4 w; w.x = cvt_pk_bf16(v0[0], v0[1]); w.y = cvt_pk_bf16(v0[2], v0[3]); w.z = cvt_pk_bf16(v1[0], v1[1]); w.w = cvt_pk_bf16(v1[2], v1[3]);
                        st16_wt(base + (size_t)(ai * HALF + m * 16) * 4096 + bj * HALF, w); } }
        }
    }
};
struct EpiOut {
    static constexpr bool PERM = true, AFTER_DRAIN = false;
    float* out; bf16_t* XB; float* ssq; bf16_t* XBw;
    __device__ __forceinline__ void operator()(const f32x4 (&acc)[2][2][4][2], const Unit& u, int wr, int wc, int fr, int fq, int) const {
#pragma unroll
        for (int ai = 0; ai < 2; ++ai) {
            u32x4 xo[4][2];
#pragma unroll
            for (int m = 0; m < 4; ++m)
#pragma unroll
                for (int bj = 0; bj < 2; ++bj) xo[m][bj] = *(const u32x4*)(XB + (size_t)(u.pm * BM + ai * HALF + wr * 64 + m * 16 + fr) * 2048 + u.pn * BM + wc * 32 + 8 * fq + bj * HALF);
#pragma unroll
            for (int m = 0; m < 4; ++m) { const int row = u.pm * BM + ai * HALF + wr * 64 + m * 16 + fr; const size_t off = (size_t)row * 2048 + u.pn * BM + wc * 32 + 8 * fq; float s = 0.f;
#pragma unroll
                for (int bj = 0; bj < 2; ++bj) { const u32x4 q = xo[m][bj];
                    const f32x4 x0 = (f32x4){__builtin_bit_cast(float, q.x << 16), __builtin_bit_cast(float, q.x & 0xffff0000u), __builtin_bit_cast(float, q.y << 16), __builtin_bit_cast(float, q.y & 0xffff0000u)};
                    const f32x4 x1 = (f32x4){__builtin_bit_cast(float, q.z << 16), __builtin_bit_cast(float, q.z & 0xffff0000u), __builtin_bit_cast(float, q.w << 16), __builtin_bit_cast(float, q.w & 0xffff0000u)};
                    const f32x4 v0 = x0 + acc[ai][bj][m][0], v1 = x1 + acc[ai][bj][m][1];
                    if (out) { *(f32x4*)(out + off + bj * HALF) = v0; *(f32x4*)(out + off + bj * HALF + 4) = v1; }
                    else { u32x4 w; w.x = cvt_pk_bf16(v0[0], v0[1]); w.y = cvt_pk_bf16(v0[2], v0[3]); w.z = cvt_pk_bf16(v1[0], v1[1]); w.w = cvt_pk_bf16(v1[2], v1[3]);
                        st16_wt(XBw + off + bj * HALF, w); }
                    s += (v0[0] * v0[0] + v0[1] * v0[1]) + (v0[2] * v0[2] + v0[3] * v0[3]) + (v1[0] * v1[0] + v1[1] * v1[1]) + (v1[2] * v1[2] + v1[3] * v1[3]); }
                s += __shfl_xor(s, 16); s += __shfl_xor(s, 32);
                if (fq == 0) ssq[(size_t)(u.pn * 4 + wc) * 8192 + row] = s; }
            asm volatile("" ::: "memory"); }
    }
};

template <class Epi, class Sched, bool ALIGN_EPI = false, bool SP2 = false>
__device__ __forceinline__ void gemm_phase(PG8_LAS unsigned char* lds, const Gemm g, const Sched& S, const Epi& E, const int wave_in) {
    const int tid = opaque_tid(wave_in), wid = wave_in,
        lane = tid & 63, wr = wid >> 2, wc = wid & 3, fr = lane & 15, fq = lane >> 4;
    const int K = g.K, nt = K / BK;
    unsigned voffA[2], voffB[2];
#pragma unroll
    for (int i = 0; i < 2; ++i) { int R, C; stage_rc(tid * 16 + i * 8192, R, C); const int Rb = Epi::PERM ? ((R & ~31) + perm32(R & 31)) : R;
        voffA[i] = (unsigned)(R * K + C) * 2u; voffB[i] = (unsigned)(Rb * K + C) * 2u; }
    const size_t kstep = (size_t)(BK * 2);
    const size_t hstep = (size_t)HALF * K * 2;
    const size_t tstep = 2 * hstep;
    const unsigned ldsw = (unsigned)wid * 1024u;
    const int aoff = lds_byte(wr * 64 + fr, fq * 8), boff = lds_byte(wc * 32 + fr, fq * 8);
#define PG8_SA(b, h) (((b) * 2 + (h)) * HTB)
#define PG8_SB(b, h) ((4 + (b) * 2 + (h)) * HTB)
#define PG8_STAGE(bufoff, gbase, voff) do { _Pragma("unroll") for (int _i = 0; _i < 2; ++_i) \
        __builtin_amdgcn_global_load_lds((const unsigned*)((const char*)(gbase) + (voff)[_i]), (PG8_LAS unsigned*)(lds + (bufoff) + ldsw + _i * 8192), 16, 0, 0); } while (0)
#define PG8_LDA(dst, b, h) do { _Pragma("unroll") for (int m = 0; m < 4; ++m) _Pragma("unroll") for (int k = 0; k < 2; ++k) dst[m][k] = *(const PG8_LAS bf16x8*)(lds + PG8_SA(b, h) + aoff + m * 2048 + k * 1024); } while (0)
#define PG8_LDB(dst, b, h) do { _Pragma("unroll") for (int n = 0; n < 2; ++n) _Pragma("unroll") for (int k = 0; k < 2; ++k) dst[n][k] = *(const PG8_LAS bf16x8*)(lds + PG8_SB(b, h) + boff + n * 2048 + k * 1024); } while (0)
#define PG8_MMA(ai, bj, At, Bt) do { __builtin_amdgcn_s_setprio(1); _Pragma("unroll") for (int m = 0; m < 4; ++m) _Pragma("unroll") for (int n = 0; n < 2; ++n) _Pragma("unroll") for (int k = 0; k < 2; ++k) \
        acc[ai][bj][m][n] = __builtin_amdgcn_mfma_f32_16x16x32_bf16(Bt[n][k], At[m][k], acc[ai][bj][m][n], 0, 0, 0); __builtin_amdgcn_s_setprio(0); } while (0)
#define PG8_WAIT_V(n) asm volatile("s_waitcnt vmcnt(" #n ")" ::: "memory")
#define PG8_WAIT_L(n) asm volatile("s_waitcnt lgkmcnt(" #n ")" ::: "memory")
#define PG8_BAR __builtin_amdgcn_s_barrier()
#define PG8_SCHED __builtin_amdgcn_sched_barrier(0)
    Unit cur, nxt; int ui = 0;
    if (!S.next(0, cur)) return;
    f32x4 acc[2][2][4][2];
#pragma unroll
    for (int a = 0; a < 2; ++a)
#pragma unroll
        for (int b = 0; b < 2; ++b)
#pragma unroll
            for (int m = 0; m < 4; ++m)
#pragma unroll
                for (int n = 0; n < 2; ++n) acc[a][b][m][n] = (f32x4){0.f, 0.f, 0.f, 0.f};
    bf16x8 At[4][2], B0[2][2], B1[2][2];
    const char* cA = (const char*)g.A + (size_t)cur.pm * tstep; const char* cB = (const char*)g.Bt + (size_t)cur.pn * tstep;
    S.a_ready(cur, 0);
    if constexpr (SP2) {
        PG8_STAGE(PG8_SB(0, 0), cB, voffB); PG8_STAGE(PG8_SB(0, 1), cB + hstep, voffB); PG8_STAGE(PG8_SA(0, 0), cA, voffA); PG8_STAGE(PG8_SA(0, 1), cA + hstep, voffA);
        if (wr == 1) PG8_BAR;
        PG8_WAIT_V(2); PG8_BAR;
        PG8_STAGE(PG8_SB(1, 0), cB + kstep, voffB); PG8_STAGE(PG8_SA(1, 0), cA + kstep, voffA); PG8_STAGE(PG8_SB(1, 1), cB + hstep + kstep, voffB);
        PG8_WAIT_V(6); PG8_BAR;
    } else {
        PG8_STAGE(PG8_SB(0, 0), cB, voffB); PG8_STAGE(PG8_SA(0, 0), cA, voffA); PG8_STAGE(PG8_SB(0, 1), cB + hstep, voffB); PG8_STAGE(PG8_SA(0, 1), cA + hstep, voffA);
        if (wr == 1) PG8_BAR;
        PG8_WAIT_V(4); PG8_BAR;
        PG8_STAGE(PG8_SB(1, 0), cB + kstep, voffB); PG8_STAGE(PG8_SA(1, 0), cA + kstep, voffA); PG8_STAGE(PG8_SB(1, 1), cB + hstep + kstep, voffB);
        PG8_WAIT_V(6); PG8_BAR;
    }
    for (;;) {
        const bool has_next = S.next(ui + 1, nxt);
        const char* nA = has_next ? (const char*)g.A + (size_t)nxt.pm * tstep : cA; const char* nB = has_next ? (const char*)g.Bt + (size_t)nxt.pn * tstep : cB;
        for (int t = 0; t < nt; t += 2) {
            const bool last = (t == nt - 2);
            const char* a1 = cA + (size_t)(t + 1) * kstep;
            const char* a2 = last ? nA : cA + (size_t)(t + 2) * kstep; const char* b2 = last ? nB : cB + (size_t)(t + 2) * kstep;
            const char* a3 = a2 + kstep; const char* b3 = b2 + kstep;
            if (last && has_next) S.a_ready(nxt, ui + 1);
            if constexpr (SP2) {
            PG8_LDB(B0, 0, 0); PG8_LDB(B1, 0, 1); PG8_SCHED; PG8_LDA(At, 0, 0); PG8_STAGE(PG8_SA(1, 1), a1 + hstep, voffA);
            PG8_WAIT_V(8); PG8_WAIT_L(0); PG8_BAR; PG8_MMA(0, 0, At, B0); PG8_MMA(0, 1, At, B1); PG8_BAR; PG8_SCHED;
            PG8_LDA(At, 0, 1); PG8_STAGE(PG8_SB(0, 0), b2, voffB); PG8_STAGE(PG8_SB(0, 1), b2 + hstep, voffB); PG8_STAGE(PG8_SA(0, 0), a2, voffA);
            PG8_WAIT_V(8); PG8_WAIT_L(0); PG8_BAR; PG8_MMA(1, 0, At, B0); PG8_MMA(1, 1, At, B1); PG8_BAR; PG8_SCHED;
            PG8_LDB(B0, 1, 0); PG8_LDB(B1, 1, 1); PG8_SCHED; PG8_LDA(At, 1, 0); PG8_STAGE(PG8_SA(0, 1), a2 + hstep, voffA);
            PG8_WAIT_V(8); PG8_WAIT_L(0); PG8_BAR; PG8_MMA(0, 0, At, B0); PG8_MMA(0, 1, At, B1); PG8_BAR; PG8_SCHED;
            PG8_LDA(At, 1, 1); PG8_STAGE(PG8_SB(1, 0), b3, voffB); PG8_STAGE(PG8_SB(1, 1), b3 + hstep, voffB); PG8_STAGE(PG8_SA(1, 0), a3, voffA);
            PG8_WAIT_V(8); PG8_WAIT_L(0); PG8_BAR; PG8_MMA(1, 0, At, B0); PG8_MMA(1, 1, At, B1); PG8_BAR; PG8_SCHED;
            } else {
            PG8_LDB(B0, 0, 0); PG8_SCHED; PG8_LDA(At, 0, 0); PG8_STAGE(PG8_SA(1, 1), a1 + hstep, voffA);
            PG8_WAIT_L(8); PG8_BAR; PG8_WAIT_L(0); PG8_MMA(0, 0, At, B0); PG8_BAR; PG8_SCHED;
            PG8_LDB(B1, 0, 1); PG8_STAGE(PG8_SB(0, 0), b2, voffB);
            PG8_BAR; PG8_WAIT_L(0); PG8_MMA(0, 1, At, B1); PG8_BAR;
            PG8_LDA(At, 0, 1); PG8_STAGE(PG8_SA(0, 0), a2, voffA);
            PG8_BAR; PG8_WAIT_L(0); PG8_MMA(1, 0, At, B0); PG8_BAR; PG8_SCHED;
            PG8_STAGE(PG8_SB(0, 1), b2 + hstep, voffB);
            PG8_WAIT_V(6); PG8_BAR; PG8_MMA(1, 1, At, B1); PG8_BAR;
            PG8_LDB(B0, 1, 0); PG8_SCHED; PG8_LDA(At, 1, 0); PG8_STAGE(PG8_SA(0, 1), a2 + hstep, voffA);
            PG8_WAIT_L(8); PG8_BAR; PG8_WAIT_L(0); PG8_MMA(0, 0, At, B0); PG8_BAR; PG8_SCHED;
            PG8_LDB(B1, 1, 1); PG8_STAGE(PG8_SB(1, 0), b3, voffB);
            PG8_BAR; PG8_WAIT_L(0); PG8_MMA(0, 1, At, B1); PG8_BAR;
            PG8_LDA(At, 1, 1); PG8_STAGE(PG8_SA(1, 0), a3, voffA);
            PG8_BAR; PG8_WAIT_L(0); PG8_MMA(1, 0, At, B0); PG8_BAR; PG8_SCHED;
            PG8_STAGE(PG8_SB(1, 1), b3 + hstep, voffB);
            PG8_WAIT_V(6); PG8_BAR; PG8_MMA(1, 1, At, B1); PG8_BAR;
            }
        }
        if constexpr (ALIGN_EPI) { if (wr == 0) PG8_BAR; }
        if constexpr (!Epi::AFTER_DRAIN) { E(acc, cur, wr, wc, fr, fq, ui); S.done(cur); }
        if (!has_next) break;
#pragma unroll
        for (int a = 0; a < 2; ++a)
#pragma unroll
            for (int b = 0; b < 2; ++b)
#pragma unroll
                for (int m = 0; m < 4; ++m)
#pragma unroll
                    for (int n = 0; n < 2; ++n) acc[a][b][m][n] = (f32x4){0.f, 0.f, 0.f, 0.f};
        cur = nxt; cA = nA; cB = nB; ++ui;
        if constexpr (ALIGN_EPI) { if (wr == 1) PG8_BAR; }
    }
    PG8_WAIT_V(0);
    if constexpr (!ALIGN_EPI) { if (wr == 0) PG8_BAR; }
    PG8_BAR;
    if constexpr (Epi::AFTER_DRAIN) { E.fused(acc, cur, wr, wc, fr, fq, lds, wid, lane); S.done(cur); }
#undef PG8_SA
#undef PG8_SB
#undef PG8_STAGE
#undef PG8_LDA
#undef PG8_LDB
#undef PG8_MMA
#undef PG8_WAIT_V
#undef PG8_WAIT_L
#undef PG8_BAR
#undef PG8_SCHED
}
}

__device__ __forceinline__ int opaque_tid(int wave) { int ln = __builtin_amdgcn_mbcnt_hi(~0u, __builtin_amdgcn_mbcnt_lo(~0u, 0u)); asm volatile("" : "+v"(ln)); return wave * 64 + ln; }
#define PHASE_TID(F) do { const int _t = opaque_tid((F).wave); (F).tid = _t; (F).lane = _t & 63; } while (0)
__device__ __forceinline__ void transpose_item(const float* W, int K, int N, bf16_t* WT, int dst_row0, int src_col0, const float* gk, LAS float* scr, int k0, int lane) {
    f32x4 v[16]; const int r0 = lane >> 4, c4 = (lane & 15) * 4;
    const float* wp = W + (size_t)(k0 + r0) * N + src_col0 + c4;
#pragma unroll
    for (int i = 0; i < 16; ++i) v[i] = *(const f32x4*)(wp + (size_t)(4 * i) * N);
    if (gk) {
#pragma unroll
        for (int i = 0; i < 16; ++i) v[i] = v[i] * gk[k0 + r0 + 4 * i]; }
#pragma unroll
    for (int i = 0; i < 16; ++i) { LAS float* d = scr + (r0 + 4 * i) * 65 + c4; d[0] = v[i][0]; d[1] = v[i][1]; d[2] = v[i][2]; d[3] = v[i][3]; }
    asm volatile("s_waitcnt lgkmcnt(0)" ::: "memory");
    const int c = lane & 7;
#pragma unroll
    for (int j = 0; j < 8; ++j) { const int n = (lane >> 3) + 8 * j; const LAS float* sp = scr + (8 * c) * 65 + n;
        u32x4 o; o.x = pk2(sp[0 * 65], sp[1 * 65]); o.y = pk2(sp[2 * 65], sp[3 * 65]); o.z = pk2(sp[4 * 65], sp[5 * 65]); o.w = pk2(sp[6 * 65], sp[7 * 65]);
        *(u32x4*)(WT + (size_t)(dst_row0 + n) * K + k0 + 8 * c) = o; }
    asm volatile("s_waitcnt lgkmcnt(0)" ::: "memory");
}
__device__ __forceinline__ void convert_layer(Frame& F, int l, int gw, int NGW) {
    LAS float* scr = (LAS float*)(F.lds + F.wave * 17408);
    constexpr int I_IN = (D / 64) * (DIN / 64), I_OUT = (D / 64) * (D / 64), I_G = NHEAD * 2 * (HD / 64) * (HD / 64), I_L = I_IN + I_OUT + I_G;
    for (int it = gw; it < I_L; it += NGW) {
        int r = it;
        if (r >= I_IN + I_OUT) { r -= I_IN + I_OUT; const int hg = r >> 2, kb = (r >> 1) & 1, nb = r & 1, h = hg >> 1, gsel = hg & 1;
            transpose_item((gsel ? F.wx : F.wa) + (size_t)(l * NHEAD + h) * HD * HD, HD, HD, F.WgT + (size_t)((l * NHEAD + h) * 2 + gsel) * HD * HD, 64 * nb, 64 * nb, nullptr, scr, 64 * kb, F.lane);
        } else if (r < I_IN) { const int kb = r / (DIN / 64), nb = r % (DIN / 64);
            transpose_item(F.w_in + (size_t)l * D * DIN, D, DIN, F.WinT + (size_t)l * DIN * D, 64 * nb, src_col(64 * nb), F.norm_g + l * D, scr, 64 * kb, F.lane);
        } else { r -= I_IN; const int kb = r / (D / 64), nb = r % (D / 64);
            transpose_item(F.w_out + (size_t)l * D * D, D, D, F.WoutT + (size_t)l * D * D, 64 * nb, 64 * nb, nullptr, scr, 64 * kb, F.lane); }
    }
}
__device__ __forceinline__ void p_prologue(Frame& F) {
    PHASE_TID(F);
    const int gw = F.bid * NWAVES + F.wave, NGW = F.G * NWAVES;
    convert_layer(F, 0, gw, NGW);
    if (!(F.G == 256)) { for (int l = 1; l < DEPTH; ++l) convert_layer(F, l, gw, NGW); }
    for (int m = gw; m < S; m += NGW) {
        const f32x4* xr = (const f32x4*)(F.x + (size_t)m * D) + F.lane; u32x2* ob = (u32x2*)(F.XB + (size_t)m * D) + F.lane; float s = 0.f;
#pragma unroll
        for (int j = 0; j < 8; ++j) { const f32x4 v = xr[64 * j]; s += (v.x * v.x + v.y * v.y) + (v.z * v.z + v.w * v.w); u32x2 w; w.x = pk2(v.x, v.y); w.y = pk2(v.z, v.w); ob[64 * j] = w; }
        s = wave_sum(s);
        if (F.lane < 32) F.SSQ[F.lane * S + m] = F.lane == 0 ? s : 0.f;
    }
}

#define DPP_MOV(x, ctrl) __builtin_bit_cast(float, __builtin_amdgcn_update_dpp(0, __builtin_bit_cast(int, (float)(x)), (ctrl), 0xf, 0xf, true))
template <int NV> __device__ __forceinline__ void block_sum(float (&v)[NV], LAS float* red  , int wave, int lane) {
#pragma unroll
    for (int i = 0; i < NV; ++i) v[i] += DPP_MOV(v[i], 0x128);
#pragma unroll
    for (int i = 0; i < NV; ++i) v[i] += DPP_MOV(v[i], 0x124);
#pragma unroll
    for (int i = 0; i < NV; ++i) v[i] += DPP_MOV(v[i], 0x4E);
#pragma unroll
    for (int i = 0; i < NV; ++i) v[i] += DPP_MOV(v[i], 0xB1);
    __builtin_amdgcn_sched_barrier(0);
    float t[NV];
#pragma unroll
    for (int i = 0; i < NV; ++i) t[i] = __shfl_xor(v[i], 16);
#pragma unroll
    for (int i = 0; i < NV; ++i) v[i] += t[i];
    __builtin_amdgcn_sched_barrier(0);
#pragma unroll
    for (int i = 0; i < NV; ++i) t[i] = __shfl_xor(v[i], 32);
#pragma unroll
    for (int i = 0; i < NV; ++i) v[i] += t[i];
    __builtin_amdgcn_sched_barrier(0);
    if (lane == 0) {
#pragma unroll
        for (int i = 0; i < NV; ++i) red[i * 8 + wave] = v[i]; }
    __syncthreads();
#pragma unroll
    for (int i = 0; i < NV; ++i) { const LAS f32x4* p = (const LAS f32x4*)(red + i * 8); const f32x4 a = p[0], b = p[1]; v[i] = ((a.x + a.y) + (a.z + a.w)) + ((b.x + b.y) + (b.z + b.w)); }
    __syncthreads();
}
__device__ __forceinline__ float row_transpose_sum16(const float (&v)[16], int lane) {
    const bool sa = (lane & 8) != 0, sb = (lane & 4) != 0, sc = (lane & 2) != 0, sd = (lane & 1) != 0;
    float w8[8], w4[4], w2[2];
#pragma unroll
    for (int k = 0; k < 8; ++k) { const float keep = sa ? v[k + 8] : v[k], send = sa ? v[k] : v[k + 8]; w8[k] = keep + DPP_MOV(send, 0x140); }
#pragma unroll
    for (int k = 0; k < 4; ++k) { const float keep = sb ? w8[k + 4] : w8[k], send = sb ? w8[k] : w8[k + 4]; w4[k] = keep + DPP_MOV(send, 0x141); }
#pragma unroll
    for (int k = 0; k < 2; ++k) { const float keep = sc ? w4[k + 2] : w4[k], send = sc ? w4[k] : w4[k + 2]; w2[k] = keep + DPP_MOV(send, 0x4E); }
    const float keep = sd ? w2[1] : w2[0], send = sd ? w2[0] : w2[1];
    return keep + DPP_MOV(send, 0xB1);
}
constexpr int CT = 16;
__device__ __forceinline__ void conv_item(Frame& F, int l, int item) {
    LAS unsigned char* cs = F.lds;
    LAS float* red = (LAS float*)(F.lds + 62 * 2048);
    const int t0 = item * 32, c0 = 2 * F.tid;
    const auto rus = MAKE_RSRC(F.U, (size_t)S * UW * 2); const int c16 = F.tid & 127, rb = F.tid >> 7; u32x4 v[16];
#pragma unroll
    for (int i = 0; i < 16; ++i) { const int row = rb + 4 * i, sidx = t0 - 30 + row; v[i] = (u32x4){0u, 0u, 0u, 0u};
        if (row < 62 && sidx >= 0) v[i] = __builtin_bit_cast(u32x4, __builtin_amdgcn_raw_buffer_load_b128(rus, c16 * 16, sidx * (UW * 2), 0)); }
    f32x2 wv[31];
    const auto rw = MAKE_RSRC(F.cdw_w + (size_t)l * CW * DC, CW * DC * 4);
#pragma unroll
    for (int j = 0; j < 31; ++j) wv[j] = __builtin_bit_cast(f32x2, __builtin_amdgcn_raw_buffer_load_b64(rw, c0 * 4, (30 - j) * DC * 4, 0));
    const f32x2 bias = *(const f32x2*)(F.cdw_b + l * DC + c0);
    const f32x2 lg = *(const f32x2*)(F.cln_g + l * DC + c0), lb = *(const f32x2*)(F.cln_b + l * DC + c0);
    const auto ru = MAKE_RSRC(F.U, (size_t)S * UW * 2); const auto ry = MAKE_RSRC(F.Y, (size_t)S * D * 2);
    unsigned zwq[32];
#pragma unroll
    for (int i = 0; i < 32; ++i) zwq[i] = __builtin_amdgcn_raw_buffer_load_b32(ru, (1024 + c0) * 2, (t0 + i) * (UW * 2), 0);
#pragma unroll
    for (int i = 0; i < 16; ++i) { const int row = rb + 4 * i; if (row < 62) *(LAS u32x4*)(cs + row * 2048 + c16 * 16) = v[i]; }
    __syncthreads();
#pragma unroll 1
    for (int hb_ = 0; hb_ < ((PROBE_DUP & 64) ? 2 : 1) * (32 / CT); ++hb_) { const int hb = hb_ % (32 / CT);
        f32x2 acc[CT];
#pragma unroll
        for (int i = 0; i < CT; ++i) acc[i] = bias;
        const LAS unsigned char* cp = cs + (hb * CT) * 2048 + F.tid * 4;
        unsigned cwq[CT + 30];
#pragma unroll
        for (int si = 0; si < CT + 30; ++si) cwq[si] = *(const LAS unsigned*)(cp + si * 2048);
        static_assert(CT + 30 == 46, "operand lists below");
        asm volatile("" : "+v"(cwq[0]), "+v"(cwq[1]), "+v"(cwq[2]), "+v"(cwq[3]), "+v"(cwq[4]), "+v"(cwq[5]), "+v"(cwq[6]), "+v"(cwq[7]), "+v"(cwq[8]), "+v"(cwq[9]), "+v"(cwq[10]), "+v"(cwq[11]), "+v"(cwq[12]), "+v"(cwq[13]), "+v"(cwq[14]), "+v"(cwq[15]));
        asm volatile("" : "+v"(cwq[16]), "+v"(cwq[17]), "+v"(cwq[18]), "+v"(cwq[19]), "+v"(cwq[20]), "+v"(cwq[21]), "+v"(cwq[22]), "+v"(cwq[23]), "+v"(cwq[24]), "+v"(cwq[25]), "+v"(cwq[26]), "+v"(cwq[27]), "+v"(cwq[28]), "+v"(cwq[29]), "+v"(cwq[30]), "+v"(cwq[31]));
        asm volatile("" : "+v"(cwq[32]), "+v"(cwq[33]), "+v"(cwq[34]), "+v"(cwq[35]), "+v"(cwq[36]), "+v"(cwq[37]), "+v"(cwq[38]), "+v"(cwq[39]), "+v"(cwq[40]), "+v"(cwq[41]), "+v"(cwq[42]), "+v"(cwq[43]), "+v"(cwq[44]), "+v"(cwq[45]));
#pragma unroll
        for (int si = 0; si < CT + 30; ++si) {
            const unsigned cw = cwq[si];
            const f32x2 xv = (f32x2){bflo(cw), bfhi(cw)};
#pragma unroll
            for (int i = 0; i < CT; ++i) { const int j = i + 30 - si; if (j >= 0 && j <= 30) acc[i] = wv[j] * xv + acc[i]; }
            static_assert(CT == 16, "operand list below");
            asm volatile("" : "+v"(acc[0]), "+v"(acc[1]), "+v"(acc[2]), "+v"(acc[3]), "+v"(acc[4]), "+v"(acc[5]), "+v"(acc[6]), "+v"(acc[7]),
                              "+v"(acc[8]), "+v"(acc[9]), "+v"(acc[10]), "+v"(acc[11]), "+v"(acc[12]), "+v"(acc[13]), "+v"(acc[14]), "+v"(acc[15]));
        }
        float s1v[CT], s2v[CT];
#pragma unroll
        for (int i = 0; i < CT; ++i) { s1v[i] = acc[i].x + acc[i].y; s2v[i] = acc[i].x * acc[i].x + acc[i].y * acc[i].y; }
        const float rs1 = row_transpose_sum16(s1v, F.lane), rs2 = row_transpose_sum16(s2v, F.lane);
        LAS f32x2* part = (LAS f32x2*)red; LAS f32x2* tot = (LAS f32x2*)(red + 1024);
        part[(F.lane & 15) * 32 + F.wave * 4 + (F.lane >> 4)] = (f32x2){rs1, rs2};
        __syncthreads();
        { f32x2 pv = part[F.tid];
          float q1 = pv.x, q2 = pv.y;
          q1 += DPP_MOV(q1, 0x128); q2 += DPP_MOV(q2, 0x128); q1 += DPP_MOV(q1, 0x124); q2 += DPP_MOV(q2, 0x124);
          q1 += DPP_MOV(q1, 0x4E); q2 += DPP_MOV(q2, 0x4E); q1 += DPP_MOV(q1, 0xB1); q2 += DPP_MOV(q2, 0xB1);
          q1 += __shfl_xor(q1, 16); q2 += __shfl_xor(q2, 16);
          if ((F.lane & 31) == 0) { const float mean = q1 * (1.f / DC), var = fmaxf(q2 * (1.f / DC) - mean * mean, 0.f), rs = __builtin_amdgcn_rsqf(var + LN_EPS); tot[F.tid >> 5] = (f32x2){rs, -mean * rs}; } }
        __syncthreads();
        f32x4 tq[CT / 2];
#pragma unroll
        for (int i = 0; i < CT / 2; ++i) tq[i] = ((const LAS f32x4*)tot)[i];
#pragma unroll
        for (int i = 0; i < CT; ++i) {
            const int t = t0 + hb * CT + i;
            const float rs = (i & 1) ? tq[i >> 1].z : tq[i >> 1].x, ms = (i & 1) ? tq[i >> 1].w : tq[i >> 1].y;
            const unsigned zw = hb ? zwq[CT + i] : zwq[i];
            const float n0 = (acc[i].x * rs + ms) * lg.x + lb.x, n1 = (acc[i].y * rs + ms) * lg.y + lb.y;
            const float y0 = n0 * pg8::fsigm(n0) * bflo(zw), y1 = n1 * pg8::fsigm(n1) * bfhi(zw);
            __builtin_amdgcn_raw_buffer_store_b32(pk2(y0, y1), ry, c0 * 2, t * (D * 2), 0);
        }
    }
    __syncthreads();
}
#define DPP_ROW_SHR(x, oldv, d) __builtin_bit_cast(float, __builtin_amdgcn_update_dpp(__builtin_bit_cast(int, (float)(oldv)), __builtin_bit_cast(int, (float)(x)), 0x110 + (d), 0xf, 0xf, false))
#define DPP_ROW_BCAST15(x) __builtin_bit_cast(float, __builtin_amdgcn_update_dpp(0, __builtin_bit_cast(int, (float)(x)), 0x15F, 0xf, 0xf, true))
__device__ __forceinline__ unsigned* lru_flag(Frame& F, int l, int c, int h) { return F.ctl + CW_LRU + 64 * ((l * NLCH + c) * NHEAD + h); }
__device__ __forceinline__ void lru_item(Frame& F, int l, int item) {
    const int c = item >> 3, h = item & 7, t0 = c * LCH, ch0 = h * HD;
    LAS unsigned char* xhi = F.lds; LAS unsigned char* xlo = F.lds + LCH * XROW;
    const int tid = F.tid, lane = F.lane, w = F.wave, fr = lane & 15, fq = lane >> 4;
    const auto ru = MAKE_RSRC(F.U, (size_t)S * UW * 2); const auto ry = MAKE_RSRC(F.Y, (size_t)S * D * 2);
    const int chl = ch0 + 16 * w + 4 * fq;
    const f32x4 vba = *(const f32x4*)(F.ba + l * DL + chl), vbx = *(const f32x4*)(F.bx + l * DL + chl), vlam = *(const f32x4*)(F.lam + l * DL + chl);
    float c8l[4], c8x[4], nba[4], nbx[4], keep[4];
#pragma unroll
    for (int j = 0; j < 4; ++j) { const float c8 = 8.f * log_sigmoid(vlam[j]); c8l[j] = c8 * 1.44269504089f; c8x[j] = 2.f * c8; nba[j] = vba[j] * -1.44269504089f; nbx[j] = vbx[j] * -1.44269504089f; }
    keep[0] = fr < 1 ? 1.f : 0.f; keep[1] = fr < 2 ? 1.f : 0.f; keep[2] = fr < 4 ? 1.f : 0.f; keep[3] = fr < 8 ? 1.f : 0.f;
    bf16x8 br[4], bi[4];
    { const bf16_t* wg = F.WgT + (size_t)((l * NHEAD + h) * 2) * HD * HD + (size_t)(16 * w + fr) * HD + 8 * fq;
#pragma unroll
      for (int kk = 0; kk < 4; ++kk) { br[kk] = *(const bf16x8*)(wg + 32 * kk); bi[kk] = *(const bf16x8*)(wg + HD * HD + 32 * kk); } }
    {
        const int tg = tid >> 4, cg = tid & 15, tb = 8 * tg;
        const float* cw = F.lcw + (size_t)l * LW * DL + ch0 + 8 * cg;
        f32x4 wk[4][2];
#pragma unroll
        for (int k = 0; k < 4; ++k) { wk[k][0] = *(const f32x4*)(cw + (size_t)k * DL); wk[k][1] = *(const f32x4*)(cw + (size_t)k * DL + 4); }
        const f32x4 bb0 = *(const f32x4*)(F.lcb + l * DL + ch0 + 8 * cg), bb1 = *(const f32x4*)(F.lcb + l * DL + ch0 + 8 * cg + 4);
        u32x4 rows[11];
#pragma unroll
        for (int r = 0; r < 11; ++r) { const int sidx = t0 + tb - 3 + r; rows[r] = (u32x4){0u, 0u, 0u, 0u};
            if (sidx >= 0) rows[r] = __builtin_bit_cast(u32x4, __builtin_amdgcn_raw_buffer_load_b128(ru, (2048 + ch0 + 8 * cg) * 2, sidx * (UW * 2), 0)); }
#pragma unroll
        for (int i = 0; i < 8; ++i) {
            f32x4 a0 = bb0, a1 = bb1;
#pragma unroll
            for (int k = 0; k < 4; ++k) { const u32x4 q = rows[i + k];
                a0[0] += wk[k][0][0] * bflo(q.x); a0[1] += wk[k][0][1] * bfhi(q.x); a0[2] += wk[k][0][2] * bflo(q.y); a0[3] += wk[k][0][3] * bfhi(q.y);
                a1[0] += wk[k][1][0] * bflo(q.z); a1[1] += wk[k][1][1] * bfhi(q.z); a1[2] += wk[k][1][2] * bflo(q.w); a1[3] += wk[k][1][3] * bfhi(q.w); }
            u32x4 hi; hi.x = pk2(a0[0], a0[1]); hi.y = pk2(a0[2], a0[3]); hi.z = pk2(a1[0], a1[1]); hi.w = pk2(a1[2], a1[3]);
            u32x4 lo; lo.x = pk2(a0[0] - bflo(hi.x), a0[1] - bfhi(hi.x)); lo.y = pk2(a0[2] - bflo(hi.y), a0[3] - bfhi(hi.y)); lo.z = pk2(a1[0] - bflo(hi.z), a1[1] - bfhi(hi.z)); lo.w = pk2(a1[2] - bflo(hi.w), a1[3] - bfhi(hi.w));
            *(LAS u32x4*)(xhi + (tb + i) * XROW + cg * 16) = hi; *(LAS u32x4*)(xlo + (tb + i) * XROW + cg * 16) = lo; }
    }
    __syncthreads();
    float hl[16][4], pc[16][4], HC[4], PC[4];
#pragma unroll
    for (int j = 0; j < 4; ++j) { HC[j] = 0.f; PC[j] = 1.f; }
#pragma unroll
    for (int m = 0; m < 16; ++m) {
        f32x4 ar = (f32x4){0.f, 0.f, 0.f, 0.f}, ai = (f32x4){0.f, 0.f, 0.f, 0.f};
        const LAS unsigned char* rowp = xhi + (16 * m + fr) * XROW;
#pragma unroll
        for (int kk = 0; kk < 4; ++kk) { const bf16x8 a = *(const LAS bf16x8*)(rowp + (32 * kk + 8 * fq) * 2);
            ar = __builtin_amdgcn_mfma_f32_16x16x32_bf16(br[kk], a, ar, 0, 0, 0); ai = __builtin_amdgcn_mfma_f32_16x16x32_bf16(bi[kk], a, ai, 0, 0, 0); }
        const u32x2 qh = *(const LAS u32x2*)(rowp + (16 * w + 4 * fq) * 2), ql = *(const LAS u32x2*)(rowp + LCH * XROW + (16 * w + 4 * fq) * 2);
        const float xcv[4] = {bflo(qh.x) + bflo(ql.x), bfhi(qh.x) + bfhi(ql.x), bflo(qh.y) + bflo(ql.y), bfhi(qh.y) + bfhi(ql.y)};
        float Aj[4], Bj[4], xq[4];
#pragma unroll
        for (int j = 0; j < 4; ++j) {
            const float r = __builtin_amdgcn_rcpf(1.f + __builtin_amdgcn_exp2f(ar[j] * -1.44269504089f + nba[j])), ig = __builtin_amdgcn_rcpf(1.f + __builtin_amdgcn_exp2f(ai[j] * -1.44269504089f + nbx[j]));
            const float x = c8x[j] * r; xq[j] = x;
            float p = x * (1.f / 5040.f) + (1.f / 720.f); p = p * x + (1.f / 120.f); p = p * x + (1.f / 24.f); p = p * x + (1.f / 6.f); p = p * x + 0.5f; p = p * x + 1.f;
            Aj[j] = __builtin_amdgcn_exp2f(c8l[j] * r); Bj[j] = __builtin_amdgcn_sqrtf(-x * p) * (ig * xcv[j]); }
        if (__builtin_expect(__any(fminf(fminf(xq[0], xq[1]), fminf(xq[2], xq[3])) <= -0.35f), 0)) {
#pragma unroll
            for (int j = 0; j < 4; ++j) if (xq[j] <= -0.35f) { const float r = __builtin_amdgcn_rcpf(1.f + __builtin_amdgcn_exp2f(ar[j] * -1.44269504089f + nba[j])), ig = __builtin_amdgcn_rcpf(1.f + __builtin_amdgcn_exp2f(ai[j] * -1.44269504089f + nbx[j]));
                (void)r; Bj[j] = __builtin_amdgcn_sqrtf(1.f - __builtin_amdgcn_exp2f(xq[j] * 1.44269504089f)) * (ig * xcv[j]); } }
#define LRU_PIN asm volatile("" : "+v"(Aj[0]), "+v"(Aj[1]), "+v"(Aj[2]), "+v"(Aj[3]), "+v"(Bj[0]), "+v"(Bj[1]), "+v"(Bj[2]), "+v"(Bj[3]))
#define DPP_SHR0(x, d) __builtin_bit_cast(float, __builtin_amdgcn_update_dpp(0, __builtin_bit_cast(int, (float)(x)), 0x110 + (d), 0xf, 0xf, true))
#define LRU_SCAN_STEP(d, kd) { \
            _Pragma("unroll") for (int j = 0; j < 4; ++j) { Bj[j] = DPP_SHR0(Bj[j], d) * Aj[j] + Bj[j]; } \
            _Pragma("unroll") for (int j = 0; j < 4; ++j) { const float t = DPP_SHR0(Aj[j], d) + keep[kd]; Aj[j] = Aj[j] * t; } LRU_PIN; }
        LRU_PIN; LRU_SCAN_STEP(1, 0) LRU_SCAN_STEP(2, 1) LRU_SCAN_STEP(4, 2) LRU_SCAN_STEP(8, 3)
#undef LRU_SCAN_STEP
#undef LRU_PIN
#pragma unroll
        for (int j = 0; j < 4; ++j) { hl[m][j] = Bj[j] + Aj[j] * HC[j]; pc[m][j] = Aj[j] * PC[j]; }
#pragma unroll
        for (int j = 0; j < 4; ++j) { HC[j] = DPP_ROW_BCAST15(hl[m][j]); PC[j] = DPP_ROW_BCAST15(pc[m][j]); }
    }
    const int vo_u = (fr * UW + 3072 + chl) * 2, vo_y = (fr * D + DC + chl) * 2;
    u32x2 zq[16];
#pragma unroll
    for (int m = 0; m < 16; ++m) zq[m] = __builtin_bit_cast(u32x2, __builtin_amdgcn_raw_buffer_load_b64(ru, vo_u, (t0 + 16 * m) * (UW * 2), 0));
    if (fr == 15) { unsigned long long* sp = F.SUM + (size_t)(l * NLCH + c) * DL + chl;
#pragma unroll
        for (int j = 0; j < 4; ++j) __hip_atomic_store(sp + j, ((unsigned long long)__builtin_bit_cast(unsigned, HC[j]) << 32) | __builtin_bit_cast(unsigned, PC[j]), __ATOMIC_RELAXED, __HIP_MEMORY_SCOPE_AGENT); }
    asm volatile("s_waitcnt vmcnt(0)" ::: "memory");
    __syncthreads();
    if (tid == 0) __hip_atomic_store(lru_flag(F, l, c, h), 1u, __ATOMIC_RELAXED, __HIP_MEMORY_SCOPE_AGENT);
    float Hin[4] = {0.f, 0.f, 0.f, 0.f};
    if (c > 0) {
        if (w == 0) {
            unsigned* fp = lru_flag(F, l, lane < c ? lane : 0, h); unsigned spins = 0;
            for (;;) { const unsigned v = __hip_atomic_load(fp, __ATOMIC_RELAXED, __HIP_MEMORY_SCOPE_AGENT); if (__all(v != 0u)) break; __builtin_amdgcn_s_sleep(2); if (++spins > (1u << 20)) break; }
            __builtin_amdgcn_fence(__ATOMIC_ACQUIRE, "agent");
            asm volatile("s_waitcnt vmcnt(0)" ::: "memory");
        }
        __syncthreads();
        const unsigned long long* sp = F.SUM + (size_t)(l * NLCH) * DL + chl;
        u32x4 q[2][2];
#pragma unroll
        for (int g = 0; g < 2; ++g) { const int cc = fr + 16 * g; q[g][0] = (u32x4){0x3f800000u, 0u, 0x3f800000u, 0u}; q[g][1] = q[g][0];
            if (cc < c) { q[g][0] = *(const u32x4*)(sp + (size_t)cc * DL); q[g][1] = *(const u32x4*)(sp + (size_t)cc * DL + 2); } }
#pragma unroll
        for (int j = 0; j < 4; ++j) { float Hq[2];
#pragma unroll
            for (int g = 0; g < 2; ++g) { const u32x4 qq = q[g][j >> 1]; float A = (j & 1) ? u2f(qq.z) : u2f(qq.x), B = (j & 1) ? u2f(qq.w) : u2f(qq.y);
#define LRU_SCAN_STEP(d) { const float ap = DPP_ROW_SHR(A, 1.0f, d), bp = DPP_ROW_SHR(B, 0.0f, d); B = A * bp + B; A = ap * A; }
                LRU_SCAN_STEP(1) LRU_SCAN_STEP(2) LRU_SCAN_STEP(4) LRU_SCAN_STEP(8)
#undef LRU_SCAN_STEP
                const float At = DPP_ROW_BCAST15(A), Bt = DPP_ROW_BCAST15(B);
                Hq[g] = g == 0 ? Bt : At * Hq[0] + Bt; }
            Hin[j] = Hq[1]; }
    }
#pragma unroll
    for (int m = 0; m < 16; ++m) { const int trow = t0 + 16 * m; const unsigned zx = zq[m].x, zy = zq[m].y;
        const float y0 = (hl[m][0] + pc[m][0] * Hin[0]) * bflo(zx), y1 = (hl[m][1] + pc[m][1] * Hin[1]) * bfhi(zx), y2 = (hl[m][2] + pc[m][2] * Hin[2]) * bflo(zy), y3 = (hl[m][3] + pc[m][3] * Hin[3]) * bfhi(zy);
        u32x2 o; o.x = pk2(y0, y1); o.y = pk2(y2, y3);
        __builtin_amdgcn_raw_buffer_store_b64(o, ry, vo_y, trow * (D * 2), 0); }
    __syncthreads();
}
__device__ __forceinline__ void p_mix(Frame& F, int l) {
    PHASE_TID(F);
    constexpr int NCONV = S / 32, NLRU = NLCH * NHEAD;
    for (int rep = 0; rep < ((PROBE_DUP & 8) ? 2 : 1); ++rep)
    for (int it = F.bid; it < NLRU; it += F.G) { PHASE_TID(F); lru_item(F, l, it); }
    for (int rep = 0; rep < ((PROBE_DUP & 16) ? 2 : 1); ++rep)
    for (int it = F.bid; it < NCONV; it += F.G) { PHASE_TID(F); conv_item(F, l, it); }
}
__device__ __forceinline__ void p_final(Frame& F) {
    PHASE_TID(F);
    const int gw = F.bid * NWAVES + F.wave, NGW = F.G * NWAVES;
    for (int m = gw; m < S; m += NGW) {
        float ss = 0.f;
#pragma unroll
        for (int p = 0; p < 32; ++p) ss += F.SSQ[p * S + m];
        const float rstd = 1.f / sqrtf(ss * (1.f / D) + RMS_EPS);
        f32x4* orow = (f32x4*)(F.out + (size_t)m * D) + F.lane; const f32x4* gr = (const f32x4*)F.final_g + F.lane;
#pragma unroll
        for (int j = 0; j < 8; ++j) orow[64 * j] = orow[64 * j] * rstd * gr[64 * j];
    }
}

constexpr int PH_PER_LAYER = 3, NPH = 1 + DEPTH * PH_PER_LAYER + 1;
struct Args { const float* in[16]; float* out; unsigned char* ws; int ph_lo, ph_hi; };
__global__ void __launch_bounds__(NTHREADS, 2) mk_fwd(Args a) {
    extern __shared__ __attribute__((aligned(16))) unsigned char lds_raw[];
    Frame F;
    F.lds = (LAS unsigned char*)lds_raw;
    F.wave = __builtin_amdgcn_readfirstlane(threadIdx.x >> 6); F.tid = opaque_tid(F.wave); F.lane = F.tid & 63; F.bid = blockIdx.x; F.G = gridDim.x; F.vc = blockIdx.x;
    F.x = a.in[0]; F.norm_g = a.in[1]; F.w_in = a.in[2]; F.cdw_w = a.in[3]; F.cdw_b = a.in[4]; F.cln_g = a.in[5]; F.cln_b = a.in[6]; F.lcw = a.in[7]; F.lcb = a.in[8];
    F.wa = a.in[9]; F.ba = a.in[10]; F.wx = a.in[11]; F.bx = a.in[12]; F.lam = a.in[13]; F.w_out = a.in[14]; F.final_g = a.in[15]; F.out = a.out;
    unsigned char* ws = a.ws;
    F.WinT = (bf16_t*)(ws + WS_WINT); F.WoutT = (bf16_t*)(ws + WS_WOUTT); F.XB = (bf16_t*)(ws + WS_XB); F.U = (bf16_t*)(ws + WS_U); F.Y = (bf16_t*)(ws + WS_Y);
    F.SSQ = (float*)(ws + WS_SSQ); F.SUM = (unsigned long long*)(ws + WS_SUM); F.WgT = (bf16_t*)(ws + WS_WG); F.ctl = (unsigned*)(ws + WS_CTL);
    volatile LAS unsigned* bst = (volatile LAS unsigned*)(F.lds + LDS_BYTES - 64);
    if (F.tid < 16) bst[F.tid] = 0u;
    __syncthreads();
    XcdBarrier bar; bar.bar = (unsigned*)(ws + WS_CTL) + CW_BAR; bar.x = 0; bar.st = bst;
    if (MK_ONE_LAUNCH) bar = xcd_barrier_post((unsigned*)(ws + WS_CTL) + CW_BAR, bst, F.wave);
    bar.wave = F.wave;
    for (int ph = a.ph_lo; ph < a.ph_hi; ++ph) {
      const int jj = (ph == 0 || ph == NPH - 1) ? -1 : (ph - 1) % PH_PER_LAYER;
      const int reps = ((PROBE_DUP & 1) && ph == 0) || ((PROBE_DUP & 2) && jj == 0) || ((PROBE_DUP & 4) && jj == 1) || ((PROBE_DUP & 1024) && jj == 2) ? 2 : 1;
      for (int rep = 0; rep < reps; ++rep) {
        if (rep) xcd_barrier(bar);
        if (ph == 0) p_prologue(F);
        else if (ph == NPH - 1) p_final(F);
        else { const int l = (ph - 1) / PH_PER_LAYER, j = (ph - 1) % PH_PER_LAYER;
            if (j == 0) { pg8::Gemm g{F.XB, F.WinT + (size_t)l * DIN * D, S, DIN, D}; pg8::OrderRstd Sd; Sd.init(S, DIN, F.G, F.vc); Sd.ssq = F.SSQ; Sd.rtab = (LAS float*)(F.lds + pg8::RTAB_OFF); Sd.wave = F.wave;
                pg8::EpiIn E{F.U, (const LAS float*)(F.lds + pg8::RTAB_OFF)};
                pg8::gemm_phase<pg8::EpiIn, pg8::OrderRstd, true, true>(F.lds, g, Sd, E, F.wave);
                if (F.G == 256 && l + 1 < DEPTH && F.vc >= 128) { PHASE_TID(F); convert_layer(F, l + 1, (F.vc - 128) * NWAVES + F.wave, 128 * NWAVES); } }
            else if (j == 1) p_mix(F, l);
            else { pg8::Gemm g{F.Y, F.WoutT + (size_t)l * D * D, S, D, D}; pg8::StaticOrder Sd; Sd.init(S, D, F.G, F.vc);
                const bool dry = (PROBE_DUP & 1024) && rep == 0;
                pg8::EpiOut E{l == DEPTH - 1 ? (dry ? (float*)(ws + 300 * MiB) : F.out) : nullptr, F.XB, dry ? (float*)(ws + 400 * MiB) : F.SSQ, dry ? (bf16_t*)(ws + 300 * MiB) : F.XB};
                pg8::gemm_phase<pg8::EpiOut, pg8::StaticOrder, true, true>(F.lds, g, Sd, E, F.wave); }
        }
      }
        if (ph + 1 < a.ph_hi) xcd_barrier(bar);
        if (MK_ONE_LAUNCH && ph == 0 && F.G == 256) {
            if (opaque_tid(F.wave) == 0) { bool ok = true;
                for (unsigned j = 0; j < 16; ++j) { const unsigned cnt = xb_ld(&bar.bar[XB_XCNT(j)]); ok = ok && (cnt == (j < 8 ? 32u : 0u)); }
                bst[4] = ok ? (bst[2] * 8u + bar.x) : (unsigned)F.bid; }
            __syncthreads();
            F.vc = __builtin_amdgcn_readfirstlane((int)bst[4]);
        }
    }
}

extern "C" void kernel_launch(void* const* d_in, const int* in_sizes, int n_in, void* d_out, int out_size, void* d_ws, size_t ws_size, hipStream_t stream) {
    static int grid = 0;
    if (grid == 0) {
        if (n_in != 16 || in_sizes[0] != S * D || out_size != S * D || ws_size < WS_END) { fprintf(stderr, "kernel_launch: unexpected shapes (n_in %d, in0 %d, out %d, ws %zu)\n", n_in, n_in > 0 ? in_sizes[0] : -1, out_size, ws_size); grid = -1; return; }
        int dev = 0, cus = 0, per_cu = 0;
        if (hipGetDevice(&dev) != hipSuccess || hipDeviceGetAttribute(&cus, hipDeviceAttributeMultiprocessorCount, dev) != hipSuccess) { grid = -1; return; }
        if (hipFuncSetAttribute((const void*)mk_fwd, hipFuncAttributeMaxDynamicSharedMemorySize, LDS_BYTES) != hipSuccess) { fprintf(stderr, "kernel_launch: hipFuncSetAttribute failed\n"); grid = -1; return; }
        if (hipOccupancyMaxActiveBlocksPerMultiprocessor(&per_cu, (const void*)mk_fwd, NTHREADS, LDS_BYTES) != hipSuccess || per_cu < 1) fprintf(stderr, "kernel_launch: occupancy query says %d per CU\n", per_cu);
        (void)hipGetLastError();
        grid = cus;
    }
    if (grid < 0) return;
    (void)hipMemsetAsync((char*)d_ws + WS_CTL, 0, CTL_ZERO_BYTES, stream);
    Args a{};
    for (int i = 0; i < 16; ++i) a.in[i] = (const float*)d_in[i];
    a.out = (float*)d_out; a.ws = (unsigned char*)d_ws;
#if MK_ONE_LAUNCH
    a.ph_lo = 0; a.ph_hi = NPH;
    hipLaunchKernelGGL(mk_fwd, dim3(grid), dim3(NTHREADS), LDS_BYTES, stream, a);
#else
    for (int ph = 0; ph < NPH; ++ph) { a.ph_lo = ph; a.ph_hi = ph + 1; hipLaunchKernelGGL(mk_fwd, dim3(grid), dim3(NTHREADS), LDS_BYTES, stream, a); }
#endif
}
```
